# Optimizing an MI355X kernel written in HIP

```python
import jax, jax.numpy as jnp
from jax import lax
import numpy as np

D_MODEL = 1024
BATCH = 8
SEQ = 2048
DEPTH = 2

EPS = 1e-6
N_EVEN = (DEPTH + 1) // 2
N_ODD = DEPTH // 2

A_HEADS = 4
A_KDIM = 128
A_VDIM = 128
A_FDIM = A_HEADS * A_KDIM
A_WIDTH = A_HEADS * A_VDIM
CHUNK = 32
B_GROUPS = 4
B_GDIM = 128
B_WIDTH = B_GROUPS * B_GDIM
AB_SPLITS = (A_FDIM, 2 * A_FDIM, 3 * A_FDIM, 3 * A_FDIM + A_WIDTH, 3 * A_FDIM + 2 * A_WIDTH)
AB_IN = 3 * A_FDIM + 2 * A_WIDTH + B_WIDTH
AB_OUT = A_WIDTH + B_WIDTH
C_HEADS = 16
C_KV = 4
C_GROUP = C_HEADS // C_KV
C_HDIM = 64
C_QKV = (C_HEADS + 2 * C_KV) * C_HDIM
WINDOW = 128
QBLOCK = 128
D_FF = -(-8 * D_MODEL // (3 * 256)) * 256

kernel_name = "hybrid_hgrn2_fnet_swa_encoder"


def _rmsnorm(x, gain):
    xf = x.astype(jnp.float32)
    y = xf * lax.rsqrt(jnp.mean(xf * xf, axis=-1, keepdims=True) + EPS)
    return (y * gain.astype(jnp.float32)).astype(x.dtype)


def _gla_chunkwise(q, k, v, logf):
    b, h, t, dk = q.shape
    dv = v.shape[-1]
    n = t // CHUNK
    q, k, v, logf = (a.reshape(b, h, n, CHUNK, a.shape[-1]) for a in (q, k, v, logf))
    g = jnp.cumsum(logf, axis=3)
    g_ref = g[:, :, :, CHUNK // 2 - 1:CHUNK // 2, :]
    g_last = g[:, :, :, -1:, :]
    qr = q * jnp.exp(g - g_ref)
    kr = k * jnp.exp(g_ref - g)
    scores = jnp.einsum('bhnck,bhnsk->bhncs', qr, kr)
    causal_in_chunk = jnp.tril(jnp.ones((CHUNK, CHUNK), dtype=bool))
    scores = jnp.where(causal_in_chunk, scores, 0.0)
    o_intra = jnp.einsum('bhncs,bhnsv->bhncv', scores, v)
    q_in = q * jnp.exp(g)
    k_out = k * jnp.exp(g_last - g)
    decay = jnp.exp(g_last[:, :, :, 0, :])

    def step(state, xs):
        q_c, k_c, v_c, d_c = xs
        o_c = jnp.einsum('bhck,bhkv->bhcv', q_c, state)
        state = d_c[..., None] * state + jnp.einsum('bhck,bhcv->bhkv', k_c, v_c)
        return state, o_c

    xs = tuple(jnp.moveaxis(a, 2, 0) for a in (q_in, k_out, v, decay))
    s0 = jnp.zeros((b, h, dk, dv), jnp.float32)
    _, o_inter = lax.scan(step, s0, xs)
    o = o_intra + jnp.moveaxis(o_inter, 0, 2)
    return o.reshape(b, h, t, dv)


def _hgrn2_fourier_mixer(hn, w_in, lb, out_gain, w_out):
    b, t, _ = hn.shape
    proj = hn @ w_in
    q, zf, zb, iv, gate, u = jnp.split(proj, AB_SPLITS, axis=-1)

    def heads(a, d):
        return a.reshape(b, t, A_HEADS, d).transpose(0, 2, 1, 3).astype(jnp.float32)

    qh = heads(q, A_KDIM) * (A_KDIM ** -0.5)
    vh = heads(iv, A_VDIM)

    def gates(z, lb_dir):
        lb_h = lb_dir.reshape(A_HEADS, 1, A_KDIM)
        f = lb_h + (1.0 - lb_h) * jax.nn.sigmoid(heads(z, A_KDIM))
        return 1.0 - f, jnp.log(f)

    k_f, lf_f = gates(zf, lb[0])
    k_b, lf_b = gates(zb, lb[1])
    o_fwd = _gla_chunkwise(qh, k_f, vh, lf_f)
    flip = lambda a: jnp.flip(a, axis=2)
    o_bwd = flip(_gla_chunkwise(flip(qh), flip(k_b), flip(vh), flip(lf_b)))
    o = o_fwd + o_bwd
    o = o * lax.rsqrt(jnp.mean(o * o, axis=-1, keepdims=True) + EPS) * out_gain.astype(jnp.float32)[:, None, :]
    o = o.transpose(0, 2, 1, 3).reshape(b, t, A_WIDTH).astype(hn.dtype) * jax.nn.silu(gate)
    ug = u.reshape(b, t, B_GROUPS, B_GDIM).astype(jnp.float32)
    fo = jnp.fft.fft2(ug, axes=(1, 3), norm='ortho').real.reshape(b, t, B_WIDTH).astype(hn.dtype)
    return jnp.concatenate([o, fo], axis=-1) @ w_out


def _window_attention_mixer(hn, w_qkv, sink, w_out):
    b, t, _ = hn.shape
    qkv = hn @ w_qkv
    q, k, v = jnp.split(qkv, (C_HEADS * C_HDIM, (C_HEADS + C_KV) * C_HDIM), axis=-1)
    q = q.reshape(b, t, C_KV, C_GROUP, C_HDIM)
    k = k.reshape(b, t, C_KV, C_HDIM)
    v = v.reshape(b, t, C_KV, C_HDIM)
    pad = ((0, 0), (WINDOW, WINDOW), (0, 0), (0, 0))
    kp = jnp.pad(k, pad)
    vp = jnp.pad(v, pad)
    nb = t // QBLOCK
    span = QBLOCK + 2 * WINDOW
    qb = jnp.moveaxis(q.reshape(b, nb, QBLOCK, C_KV, C_GROUP, C_HDIM), 1, 0)
    slopes = (2.0 ** (-8.0 * jnp.arange(1, C_HEADS + 1, dtype=jnp.float32) / C_HEADS)).reshape(C_KV, C_GROUP, 1, 1)
    sink_logit = sink.astype(jnp.float32).reshape(C_KV, C_GROUP, 1, 1)
    scale = C_HDIM ** -0.5

    def block(args):
        j, q_blk = args
        start = j * QBLOCK
        k_blk = lax.dynamic_slice_in_dim(kp, start, span, axis=1)
        v_blk = lax.dynamic_slice_in_dim(vp, start, span, axis=1)
        qpos = start + jnp.arange(QBLOCK)
        kpos = start - WINDOW + jnp.arange(span)
        dist = jnp.abs(qpos[:, None] - kpos[None, :])
        valid = (dist <= WINDOW) & (kpos >= 0)[None, :] & (kpos < t)[None, :]
        s = jnp.einsum('bqkgd,bskd->bkgqs', q_blk, k_blk).astype(jnp.float32) * scale
        s = jnp.where(valid, s - slopes * dist.astype(jnp.float32), -jnp.inf)
        s = jnp.concatenate([s, jnp.broadcast_to(sink_logit, s.shape[:-1] + (1,))], axis=-1)
        p = jax.nn.softmax(s, axis=-1)[..., :-1]
        return jnp.einsum('bkgqs,bskd->bqkgd', p.astype(v_blk.dtype), v_blk)

    o = lax.map(block, (jnp.arange(nb), qb))
    o = jnp.moveaxis(o, 0, 1).reshape(b, t, C_HEADS * C_HDIM)
    return o @ w_out


def _swiglu(hn, w1, w3, w2):
    return (jax.nn.silu(hn @ w1) * (hn @ w3)) @ w2


def setup_inputs(seed: int = 0) -> dict:
    key = jax.random.key(seed)
    ks = jax.random.split(key, 13)
    f32 = jnp.float32
    nrm = lambda k, shape, fan_in: jax.random.normal(k, shape, f32) * (fan_in ** -0.5)
    return {
        "x": jax.random.normal(ks[0], (BATCH, SEQ, D_MODEL), f32),
        "norm_gains": 1.0 + 0.05 * jax.random.normal(ks[1], (DEPTH, 4, D_MODEL), f32),
        "ab_w_in": nrm(ks[2], (N_EVEN, D_MODEL, AB_IN), D_MODEL),
        "ab_lb_table": 0.5 * jax.random.normal(ks[3], (N_EVEN + 1, 2, A_FDIM), f32),
        "ab_out_gain": 1.0 + 0.05 * jax.random.normal(ks[4], (N_EVEN, A_HEADS, A_VDIM), f32),
        "ab_w_out": nrm(ks[5], (N_EVEN, AB_OUT, D_MODEL), AB_OUT),
        "c_w_qkv": nrm(ks[6], (N_ODD, D_MODEL, C_QKV), D_MODEL),
        "c_sink": 0.5 * jax.random.normal(ks[7], (N_ODD, C_HEADS), f32),
        "c_w_out": nrm(ks[8], (N_ODD, C_HEADS * C_HDIM, D_MODEL), C_HEADS * C_HDIM),
        "ffn_w1": nrm(ks[9], (DEPTH, D_MODEL, D_FF), D_MODEL),
        "ffn_w3": nrm(ks[10], (DEPTH, D_MODEL, D_FF), D_MODEL),
        "ffn_w2": nrm(ks[11], (DEPTH, D_FF, D_MODEL), D_FF),
    }


def reference(x, norm_gains, ab_w_in, ab_lb_table, ab_out_gain, ab_w_out, c_w_qkv, c_sink, c_w_out, ffn_w1, ffn_w3, ffn_w2):
    lb_all = jnp.cumsum(jax.nn.softmax(ab_lb_table.astype(jnp.float32), axis=0), axis=0)
    for layer in range(DEPTH):
        gains = norm_gains[layer]
        hn = _rmsnorm(x, gains[0])
        if layer % 2 == 0:
            e = layer // 2
            m = _hgrn2_fourier_mixer(hn, ab_w_in[e], lb_all[e], ab_out_gain[e], ab_w_out[e])
        else:
            o = layer // 2
            m = _window_attention_mixer(hn, c_w_qkv[o], c_sink[o], c_w_out[o])
        x = x + _rmsnorm(m, gains[1])
        hn = _rmsnorm(x, gains[2])
        x = x + _rmsnorm(_swiglu(hn, ffn_w1[layer], ffn_w3[layer], ffn_w2[layer]), gains[3])
    return x
```

```cpp
#include <hip/hip_runtime.h>
#include <hip/hip_cooperative_groups.h>
#include <cstdio>
#include <cstdint>
namespace cg = cooperative_groups;
namespace pg8 {
#define PG8_LAS __attribute__((address_space(3)))
typedef unsigned short bf16_t;
typedef short bf16x8 __attribute__((ext_vector_type(8)));
typedef float f32x4 __attribute__((ext_vector_type(4)));
typedef unsigned u32x4 __attribute__((ext_vector_type(4)));
constexpr int BM = 256, BK = 64, HALF = 128, HTB = HALF * BK * 2  , STAGE_BYTES = 8 * HTB, NXCD = 8, WGM = 8;

__host__ __device__ __forceinline__ int lds_byte(int r, int c) { const int st = (r >> 4) * 2 + (c >> 5), rr = r & 15, cc = c & 31, ob = rr * 64 + cc * 2; return st * 1024 + (ob ^ (((ob >> 9) & 1) << 5)); }
__host__ __device__ __forceinline__ void stage_rc(int b, int& R, int& C) { const int st = b / 1024, sb = b % 1024, swz = sb ^ (((sb >> 9) & 1) << 5); R = (st >> 1) * 16 + swz / 64; C = (st & 1) * 32 + (swz % 64) / 2; }
__host__ __device__ __forceinline__ int perm32(int rho) { const int n = rho >> 4, i = rho & 15; return 8 * (i >> 2) + 4 * n + (i & 3); }

struct Unit { int pm, pn; };
struct Gemm { const bf16_t* A; const bf16_t* Bt; int M, N, K; };

struct StaticOrder {
    int nM, nN, nwg, G, c;
    __host__ __device__ void init(int M, int N, int G_, int c_) { nM = M / BM; nN = N / BM; nwg = nM * nN; G = G_; c = c_; }
    __host__ __device__ bool next(int i, Unit& u) const {
        const long L = (long)i * G + c; if (L >= nwg) return false;
        int wgid = (int)L; { const int q = nwg / NXCD, r = nwg % NXCD, xcd = wgid % NXCD, off = wgid / NXCD; wgid = (xcd < r ? xcd * (q + 1) : r * (q + 1) + (xcd - r) * q) + off; }
        const int nig = WGM * nN, gid = wgid / nig, fm = gid * WGM, gsz = (nM - fm) < WGM ? (nM - fm) : WGM;
        u.pm = fm + ((wgid % nig) % gsz); u.pn = (wgid % nig) / gsz; return true;
    }
    __device__ __forceinline__ void a_ready(const Unit&) const {}
    __device__ __forceinline__ void done(const Unit&) const {}
};

typedef float f32x2_t __attribute__((ext_vector_type(2))); typedef __bf16 bf16x2_t __attribute__((ext_vector_type(2)));
__device__ __forceinline__ unsigned cvt_pk_bf16(float lo, float hi) { f32x2_t v = {lo, hi}; bf16x2_t b = __builtin_convertvector(v, bf16x2_t); return __builtin_bit_cast(unsigned, b); }
template <class Epi, class Sched, bool ALIGN_EPI = false, bool SP2 = false>
__device__ __forceinline__ void gemm_phase(PG8_LAS unsigned char* lds, const Gemm g, const Sched& S, const Epi& E) {
    const int tid = threadIdx.x, wid = __builtin_amdgcn_readfirstlane(tid >> 6), lane = tid & 63, wr = wid >> 2, wc = wid & 3, fr = lane & 15, fq = lane >> 4;
    const int K = g.K, nt = K / BK;
    unsigned voffA[2], voffB[2];
#pragma unroll
    for (int i = 0; i < 2; ++i) { int R, C; stage_rc(tid * 16 + i * 8192, R, C); const int Rb = Epi::PERM ? ((R & ~31) + perm32(R & 31)) : R;
        voffA[i] = (unsigned)(R * K + C) * 2u; voffB[i] = (unsigned)(Rb * K + C) * 2u; }
    const size_t kstep = (size_t)(BK * 2);
    const size_t hstep = (size_t)HALF * K * 2;
    const size_t tstep = 2 * hstep;
    const unsigned ldsw = (unsigned)wid * 1024u;
    const int aoff = lds_byte(wr * 64 + fr, fq * 8), boff = lds_byte(wc * 32 + fr, fq * 8);
#define PG8_SA(b, h) (((b) * 2 + (h)) * HTB)
#define PG8_SB(b, h) ((4 + (b) * 2 + (h)) * HTB)
#define PG8_STAGE(bufoff, gbase, voff) do { _Pragma("unroll") for (int _i = 0; _i < 2; ++_i) \
        __builtin_amdgcn_global_load_lds((const unsigned*)((const char*)(gbase) + (voff)[_i]), (PG8_LAS unsigned*)(lds + (bufoff) + ldsw + _i * 8192), 16, 0, 0); } while (0)
#define PG8_LDA(dst, b, h) do { _Pragma("unroll") for (int m = 0; m < 4; ++m) _Pragma("unroll") for (int k = 0; k < 2; ++k) dst[m][k] = *(const PG8_LAS bf16x8*)(lds + PG8_SA(b, h) + aoff + m * 2048 + k * 1024); } while (0)
#define PG8_LDB(dst, b, h) do { _Pragma("unroll") for (int n = 0; n < 2; ++n) _Pragma("unroll") for (int k = 0; k < 2; ++k) dst[n][k] = *(const PG8_LAS bf16x8*)(lds + PG8_SB(b, h) + boff + n * 2048 + k * 1024); } while (0)
#define PG8_MMA(ai, bj, At, Bt) do { __builtin_amdgcn_s_setprio(1); _Pragma("unroll") for (int m = 0; m < 4; ++m) _Pragma("unroll") for (int n = 0; n < 2; ++n) _Pragma("unroll") for (int k = 0; k < 2; ++k) \
        acc[ai][bj][m][n] = __builtin_amdgcn_mfma_f32_16x16x32_bf16(Bt[n][k], At[m][k], acc[ai][bj][m][n], 0, 0, 0); __builtin_amdgcn_s_setprio(0); } while (0)
#define PG8_WAIT_V(n) asm volatile("s_waitcnt vmcnt(" #n ")" ::: "memory")
#define PG8_WAIT_L(n) asm volatile("s_waitcnt lgkmcnt(" #n ")" ::: "memory")
#define PG8_BAR __builtin_amdgcn_s_barrier()
#define PG8_SCHED __builtin_amdgcn_sched_barrier(0)
    Unit cur, nxt; int ui = 0;
    if (!S.next(0, cur)) return;
    f32x4 acc[2][2][4][2];
#pragma unroll
    for (int a = 0; a < 2; ++a)
#pragma unroll
        for (int b = 0; b < 2; ++b)
#pragma unroll
            for (int m = 0; m < 4; ++m)
#pragma unroll
                for (int n = 0; n < 2; ++n) acc[a][b][m][n] = (f32x4){0.f, 0.f, 0.f, 0.f};
    bf16x8 At[4][2], B0[2][2], B1[2][2];
    const char* cA = (const char*)g.A + (size_t)cur.pm * tstep; const char* cB = (const char*)g.Bt + (size_t)cur.pn * tstep;
    S.a_ready(cur);
    if constexpr (SP2) {
        PG8_STAGE(PG8_SB(0, 0), cB, voffB); PG8_STAGE(PG8_SB(0, 1), cB + hstep, voffB); PG8_STAGE(PG8_SA(0, 0), cA, voffA); PG8_STAGE(PG8_SA(0, 1), cA + hstep, voffA);
        if (wr == 1) PG8_BAR;
        PG8_WAIT_V(2); PG8_BAR;
        PG8_STAGE(PG8_SB(1, 0), cB + kstep, voffB); PG8_STAGE(PG8_SA(1, 0), cA + kstep, voffA); PG8_STAGE(PG8_SB(1, 1), cB + hstep + kstep, voffB);
        PG8_WAIT_V(6); PG8_BAR;
    } else {
        PG8_STAGE(PG8_SB(0, 0), cB, voffB); PG8_STAGE(PG8_SA(0, 0), cA, voffA); PG8_STAGE(PG8_SB(0, 1), cB + hstep, voffB); PG8_STAGE(PG8_SA(0, 1), cA + hstep, voffA);
        if (wr == 1) PG8_BAR;
        PG8_WAIT_V(4); PG8_BAR;
        PG8_STAGE(PG8_SB(1, 0), cB + kstep, voffB); PG8_STAGE(PG8_SA(1, 0), cA + kstep, voffA); PG8_STAGE(PG8_SB(1, 1), cB + hstep + kstep, voffB);
        PG8_WAIT_V(6); PG8_BAR;
    }
    for (;;) {
        const bool has_next = S.next(ui + 1, nxt);
        const char* nA = has_next ? (const char*)g.A + (size_t)nxt.pm * tstep : cA; const char* nB = has_next ? (const char*)g.Bt + (size_t)nxt.pn * tstep : cB;
        for (int t = 0; t < nt; t += 2) {
            const bool last = (t == nt - 2);
            const char* a1 = cA + (size_t)(t + 1) * kstep;
            const char* a2 = last ? nA : cA + (size_t)(t + 2) * kstep; const char* b2 = last ? nB : cB + (size_t)(t + 2) * kstep;
            const char* a3 = a2 + kstep; const char* b3 = b2 + kstep;
            if (last && has_next) S.a_ready(nxt);
            if constexpr (SP2) {
            PG8_LDB(B0, 0, 0); PG8_LDB(B1, 0, 1); PG8_SCHED; PG8_LDA(At, 0, 0); PG8_STAGE(PG8_SA(1, 1), a1 + hstep, voffA);
            PG8_WAIT_V(8); PG8_WAIT_L(0); PG8_BAR; PG8_MMA(0, 0, At, B0); PG8_MMA(0, 1, At, B1); PG8_BAR; PG8_SCHED;
            PG8_LDA(At, 0, 1); PG8_STAGE(PG8_SB(0, 0), b2, voffB); PG8_STAGE(PG8_SB(0, 1), b2 + hstep, voffB); PG8_STAGE(PG8_SA(0, 0), a2, voffA);
            PG8_WAIT_V(8); PG8_WAIT_L(0); PG8_BAR; PG8_MMA(1, 0, At, B0); PG8_MMA(1, 1, At, B1); PG8_BAR; PG8_SCHED;
            PG8_LDB(B0, 1, 0); PG8_LDB(B1, 1, 1); PG8_SCHED; PG8_LDA(At, 1, 0); PG8_STAGE(PG8_SA(0, 1), a2 + hstep, voffA);
            PG8_WAIT_V(8); PG8_WAIT_L(0); PG8_BAR; PG8_MMA(0, 0, At, B0); PG8_MMA(0, 1, At, B1); PG8_BAR; PG8_SCHED;
            PG8_LDA(At, 1, 1); PG8_STAGE(PG8_SB(1, 0), b3, voffB); PG8_STAGE(PG8_SB(1, 1), b3 + hstep, voffB); PG8_STAGE(PG8_SA(1, 0), a3, voffA);
            PG8_WAIT_V(8); PG8_WAIT_L(0); PG8_BAR; PG8_MMA(1, 0, At, B0); PG8_MMA(1, 1, At, B1); PG8_BAR; PG8_SCHED;
            } else {
            PG8_LDB(B0, 0, 0); PG8_SCHED; PG8_LDA(At, 0, 0); PG8_STAGE(PG8_SA(1, 1), a1 + hstep, voffA);
            PG8_WAIT_L(8); PG8_BAR; PG8_WAIT_L(0); PG8_MMA(0, 0, At, B0); PG8_BAR; PG8_SCHED;
            PG8_LDB(B1, 0, 1); PG8_STAGE(PG8_SB(0, 0), b2, voffB);
            PG8_BAR; PG8_WAIT_L(0); PG8_MMA(0, 1, At, B1); PG8_BAR;
            PG8_LDA(At, 0, 1); PG8_STAGE(PG8_SA(0, 0), a2, voffA);
            PG8_BAR; PG8_WAIT_L(0); PG8_MMA(1, 0, At, B0); PG8_BAR; PG8_SCHED;
            PG8_STAGE(PG8_SB(0, 1), b2 + hstep, voffB);
            PG8_WAIT_V(6); PG8_BAR; PG8_MMA(1, 1, At, B1); PG8_BAR;
            PG8_LDB(B0, 1, 0); PG8_SCHED; PG8_LDA(At, 1, 0); PG8_STAGE(PG8_SA(0, 1), a2 + hstep, voffA);
            PG8_WAIT_L(8); PG8_BAR; PG8_WAIT_L(0); PG8_MMA(0, 0, At, B0); PG8_BAR; PG8_SCHED;
            PG8_LDB(B1, 1, 1); PG8_STAGE(PG8_SB(1, 0), b3, voffB);
            PG8_BAR; PG8_WAIT_L(0); PG8_MMA(0, 1, At, B1); PG8_BAR;
            PG8_LDA(At, 1, 1); PG8_STAGE(PG8_SA(1, 0), a3, voffA);
            PG8_BAR; PG8_WAIT_L(0); PG8_MMA(1, 0, At, B0); PG8_BAR; PG8_SCHED;
            PG8_STAGE(PG8_SB(1, 1), b3 + hstep, voffB);
            PG8_WAIT_V(6); PG8_BAR; PG8_MMA(1, 1, At, B1); PG8_BAR;
            }
        }
        if constexpr (ALIGN_EPI) { if (wr == 0) PG8_BAR; }
        if constexpr (!Epi::AFTER_DRAIN) { E(acc, cur, wr, wc, fr, fq); S.done(cur); }
        if (!has_next) break;
#pragma unroll
        for (int a = 0; a < 2; ++a)
#pragma unroll
            for (int b = 0; b < 2; ++b)
#pragma unroll
                for (int m = 0; m < 4; ++m)
#pragma unroll
                    for (int n = 0; n < 2; ++n) acc[a][b][m][n] = (f32x4){0.f, 0.f, 0.f, 0.f};
        cur = nxt; cA = nA; cB = nB; ++ui;
        if constexpr (ALIGN_EPI) { if (wr == 1) PG8_BAR; }
    }
    PG8_WAIT_V(0);
    if constexpr (!ALIGN_EPI) { if (wr == 0) PG8_BAR; }
    PG8_BAR;
    if constexpr (Epi::AFTER_DRAIN) { E.fused(acc, cur, wr, wc, fr, fq, lds, wid, lane); S.done(cur); }
#undef PG8_SA
#undef PG8_SB
#undef PG8_STAGE
#undef PG8_LDA
#undef PG8_LDB
#undef PG8_MMA
#undef PG8_WAIT_V
#undef PG8_WAIT_L
#undef PG8_BAR
#undef PG8_SCHED
}
}

#define LAS __attribute__((address_space(3)))
using pg8::bf16_t; using pg8::bf16x8; using pg8::f32x4; using pg8::u32x4; using pg8::Unit; using pg8::cvt_pk_bf16;
typedef float f32x16 __attribute__((ext_vector_type(16)));
typedef unsigned u32x2 __attribute__((ext_vector_type(2)));
typedef short s16x4 __attribute__((ext_vector_type(4)));
#define MFMA32(a, b, c) __builtin_amdgcn_mfma_f32_32x32x16_bf16((a), (b), (c), 0, 0, 0)

constexpr int NB = 8, T = 2048, D = 1024, M = NB * T, FF = 2816;
constexpr float EPS = 1e-6f;
constexpr float LOG2E = 1.4426950408889634f;
constexpr int LDS_BYTES = 147456;

constexpr size_t MiB = 1u << 20;
constexpr size_t WS_WP = 1 * MiB;
constexpr size_t WS_WCS = 6 * MiB;
constexpr size_t WS_DFT = 8 * MiB;
constexpr size_t WS_WO0 = 24 * MiB;
constexpr size_t WS_WQKV = 26 * MiB;
constexpr size_t WS_WO1 = 29 * MiB;
constexpr size_t WS_W13 = 31 * MiB;
constexpr size_t WS_W2 = 53 * MiB;
constexpr size_t W13_STRIDE = (size_t)5632 * 1024, W2_STRIDE = (size_t)1024 * 2816;
constexpr size_t WS_XN = 66 * MiB;
constexpr size_t WS_MBUF = 98 * MiB;
constexpr size_t WS_YT = 98 * MiB;
constexpr size_t WS_OFB = 130 * MiB;
constexpr size_t WS_Q0 = 162 * MiB;
constexpr size_t WS_V0 = 178 * MiB;
constexpr size_t WS_GATE = 194 * MiB;
constexpr size_t WS_ACAT = 210 * MiB;
constexpr size_t WS_H = 162 * MiB;
constexpr size_t WS_QKV1 = 162 * MiB;
constexpr size_t WS_END = 256 * MiB;

__device__ __forceinline__ unsigned f2bf(float f) { unsigned u = __builtin_bit_cast(unsigned, f); return (u + 0x7fffu + ((u >> 16) & 1u)) >> 16; }
__device__ __forceinline__ float bf2f(unsigned short h) { return __builtin_bit_cast(float, (unsigned)h << 16); }
__device__ __forceinline__ float wave_sum(float v) {
#pragma unroll
    for (int o = 1; o < 64; o <<= 1) v += __shfl_xor(v, o);
    return v;
}
__device__ __forceinline__ int crow(int r, int hi) { return (r & 3) + 8 * (r >> 2) + 4 * hi; }
#define LDS_WAIT() asm volatile("s_waitcnt lgkmcnt(0)" ::: "memory")

struct EpiProj {
    static constexpr bool PERM = true, AFTER_DRAIN = false;
    bf16_t* Q0; float* LOGF; const float* tab;
    __device__ __forceinline__ void operator()(const f32x4 (&acc)[2][2][4][2], const Unit& u, int wr, int wc, int fr, int fq) const {
        const int seg = u.pn >> 1;
        const int cseg = (u.pn & 1) * 256 + wc * 32 + 8 * fq;
        const int row0 = u.pm * 256 + wr * 64 + fr;
        if (seg == 1 || seg == 2) {
            const int dir = seg - 1;
#pragma unroll
            for (int bj = 0; bj < 2; ++bj) {
                const int c = cseg + bj * 128;
                const f32x4 ta0 = *(const f32x4*)(tab + dir * 512 + c), ta1 = *(const f32x4*)(tab + dir * 512 + c + 4);
                const f32x4 tb0 = *(const f32x4*)(tab + 1024 + dir * 512 + c), tb1 = *(const f32x4*)(tab + 1024 + dir * 512 + c + 4);
                f32x4 lb0, lb1;
#pragma unroll
                for (int e = 0; e < 4; ++e) { lb0[e] = 1.0f / (1.0f + __expf(tb0[e] - ta0[e])); lb1[e] = 1.0f / (1.0f + __expf(tb1[e] - ta1[e])); }
#pragma unroll
                for (int ai = 0; ai < 2; ++ai)
#pragma unroll
                    for (int m = 0; m < 4; ++m) {
                        float* dst = LOGF + (size_t)(row0 + ai * 128 + m * 16) * 1024 + dir * 512 + c;
                        const f32x4 z0 = acc[ai][bj][m][0], z1 = acc[ai][bj][m][1]; f32x4 o0, o1;
#pragma unroll
                        for (int e = 0; e < 4; ++e) {
                            const float s0 = 1.0f / (1.0f + __expf(-z0[e])), s1 = 1.0f / (1.0f + __expf(-z1[e]));
                            o0[e] = __logf(lb0[e] + (1.0f - lb0[e]) * s0); o1[e] = __logf(lb1[e] + (1.0f - lb1[e]) * s1);
                        }
                        *(f32x4*)dst = o0; *(f32x4*)(dst + 4) = o1;
                    }
            }
        } else {
            bf16_t* base = Q0 + (size_t)(seg == 0 ? 0 : seg - 2) * ((size_t)M * 512);
            const float sc = seg == 0 ? 0.08838834764831845f : 1.0f;
#pragma unroll
            for (int bj = 0; bj < 2; ++bj) {
                const int c = cseg + bj * 128;
#pragma unroll
                for (int ai = 0; ai < 2; ++ai)
#pragma unroll
                    for (int m = 0; m < 4; ++m) {
                        f32x4 v0 = acc[ai][bj][m][0], v1 = acc[ai][bj][m][1];
                        if (seg == 4) {
#pragma unroll
                            for (int e = 0; e < 4; ++e) { v0[e] = v0[e] / (1.0f + __expf(-v0[e])); v1[e] = v1[e] / (1.0f + __expf(-v1[e])); }
                        } else { v0 = v0 * sc; v1 = v1 * sc; }
                        u32x4 w; w.x = cvt_pk_bf16(v0[0], v0[1]); w.y = cvt_pk_bf16(v0[2], v0[3]); w.z = cvt_pk_bf16(v1[0], v1[1]); w.w = cvt_pk_bf16(v1[2], v1[3]);
                        *(u32x4*)(base + (size_t)(row0 + ai * 128 + m * 16) * 512 + c) = w;
                    }
            }
        }
    }
};
struct EpiYt {
    static constexpr bool PERM = true, AFTER_DRAIN = false;
    bf16_t* Yt;
    __device__ __forceinline__ void operator()(const f32x4 (&acc)[2][2][4][2], const Unit& u, int wr, int wc, int fr, int fq) const {
        const int row0 = u.pm * 256 + wr * 64 + fr, tok0 = u.pn * 256 + wc * 32 + 8 * fq;
#pragma unroll
        for (int ai = 0; ai < 2; ++ai)
#pragma unroll
            for (int m = 0; m < 4; ++m) {
                const int f = row0 + ai * 128 + m * 16, cs = f >> 9, n_ = f & 511;
#pragma unroll
                for (int bj = 0; bj < 2; ++bj) {
                    const int tok = tok0 + bj * 128, b = tok >> 11, t = tok & 2047;
                    const f32x4 v0 = acc[ai][bj][m][0], v1 = acc[ai][bj][m][1];
                    u32x4 w; w.x = cvt_pk_bf16(v0[0], v0[1]); w.y = cvt_pk_bf16(v0[2], v0[3]); w.z = cvt_pk_bf16(v1[0], v1[1]); w.w = cvt_pk_bf16(v1[2], v1[3]);
                    *(u32x4*)(Yt + ((size_t)(b * 512 + n_) * 2 + cs) * 2048 + t) = w;
                }
            }
    }
};
struct EpiFnet {
    static constexpr bool PERM = true, AFTER_DRAIN = false;
    bf16_t* ACAT;
    __device__ __forceinline__ void operator()(const f32x4 (&acc)[2][2][4][2], const Unit& u, int wr, int wc, int fr, int fq) const {
        const int row0 = u.pm * 256 + wr * 64 + fr, col0 = u.pn * 256 + wc * 32 + 8 * fq;
#pragma unroll
        for (int ai = 0; ai < 2; ++ai)
#pragma unroll
            for (int m = 0; m < 4; ++m) {
                const int k1 = row0 + ai * 128 + m * 16;
#pragma unroll
                for (int bj = 0; bj < 2; ++bj) {
                    const int c = col0 + bj * 128, b = c >> 9, n_ = c & 511;
                    const f32x4 v0 = acc[ai][bj][m][0], v1 = acc[ai][bj][m][1];
                    u32x4 w; w.x = cvt_pk_bf16(v0[0], v0[1]); w.y = cvt_pk_bf16(v0[2], v0[3]); w.z = cvt_pk_bf16(v1[0], v1[1]); w.w = cvt_pk_bf16(v1[2], v1[3]);
                    *(u32x4*)(ACAT + (size_t)(b * 2048 + k1) * 1024 + 512 + n_) = w;
                }
            }
    }
};
struct EpiF32 {
    static constexpr bool PERM = false, AFTER_DRAIN = false;
    float* O; int ldc;
    __device__ __forceinline__ void operator()(const f32x4 (&acc)[2][2][4][2], const Unit& u, int wr, int wc, int fr, int fq) const {
        const int row0 = u.pm * 256 + wr * 64 + fr, col0 = u.pn * 256 + wc * 32 + 4 * fq;
#pragma unroll
        for (int ai = 0; ai < 2; ++ai)
#pragma unroll
            for (int m = 0; m < 4; ++m) {
                float* rowp = O + (size_t)(row0 + ai * 128 + m * 16) * ldc + col0;
#pragma unroll
                for (int bj = 0; bj < 2; ++bj)
#pragma unroll
                    for (int n = 0; n < 2; ++n) *(f32x4*)(rowp + bj * 128 + n * 16) = acc[ai][bj][m][n];
            }
    }
};
struct EpiSwiglu {
    static constexpr bool PERM = true, AFTER_DRAIN = false;
    bf16_t* H;
    __device__ __forceinline__ void operator()(const f32x4 (&acc)[2][2][4][2], const Unit& u, int wr, int wc, int fr, int fq) const {
        const int row0 = u.pm * 256 + wr * 64 + fr, col0 = u.pn * 128 + wc * 32 + 8 * fq;
#pragma unroll
        for (int ai = 0; ai < 2; ++ai)
#pragma unroll
            for (int m = 0; m < 4; ++m) {
                float h[8];
#pragma unroll
                for (int n = 0; n < 2; ++n)
#pragma unroll
                    for (int e = 0; e < 4; ++e) { const float a = acc[ai][0][m][n][e], b = acc[ai][1][m][n][e]; h[4 * n + e] = a / (1.0f + __expf(-a)) * b; }
                u32x4 w; w.x = cvt_pk_bf16(h[0], h[1]); w.y = cvt_pk_bf16(h[2], h[3]); w.z = cvt_pk_bf16(h[4], h[5]); w.w = cvt_pk_bf16(h[6], h[7]);
                *(u32x4*)(H + (size_t)(row0 + ai * 128 + m * 16) * FF + col0) = w;
            }
    }
};
struct EpiQKV {
    static constexpr bool PERM = true, AFTER_DRAIN = false;
    bf16_t* O;
    __device__ __forceinline__ void operator()(const f32x4 (&acc)[2][2][4][2], const Unit& u, int wr, int wc, int fr, int fq) const {
        const int row0 = u.pm * 256 + wr * 64 + fr, col0 = u.pn * 256 + wc * 32 + 8 * fq;
        const float sc = u.pn < 4 ? 0.125f * LOG2E : 1.0f;
#pragma unroll
        for (int ai = 0; ai < 2; ++ai)
#pragma unroll
            for (int m = 0; m < 4; ++m)
#pragma unroll
                for (int bj = 0; bj < 2; ++bj) {
                    const f32x4 v0 = acc[ai][bj][m][0] * sc, v1 = acc[ai][bj][m][1] * sc;
                    u32x4 w; w.x = cvt_pk_bf16(v0[0], v0[1]); w.y = cvt_pk_bf16(v0[2], v0[3]); w.z = cvt_pk_bf16(v1[0], v1[1]); w.w = cvt_pk_bf16(v1[2], v1[3]);
                    *(u32x4*)(O + (size_t)(row0 + ai * 128 + m * 16) * 1536 + col0 + bj * 128) = w;
                }
    }
};

__device__ __forceinline__ void transpose_item(const float* W, int ldw, int K, bf16_t* WT, int k0, int n0src, int dst_row0, LAS float* scr, int lane) {
#pragma unroll 8
    for (int i = 0; i < 32; ++i) { const int kk = 2 * i + (lane >> 5); scr[kk * 33 + (lane & 31)] = W[(size_t)(k0 + kk) * ldw + n0src + (lane & 31)]; }
    LDS_WAIT();
    const int c = lane & 7;
#pragma unroll
    for (int j = 0; j < 4; ++j) {
        const int n = (lane >> 3) + 8 * j; const LAS float* s = scr + (8 * c) * 33 + n;
        u32x4 o; o.x = cvt_pk_bf16(s[0 * 33], s[1 * 33]); o.y = cvt_pk_bf16(s[2 * 33], s[3 * 33]); o.z = cvt_pk_bf16(s[4 * 33], s[5 * 33]); o.w = cvt_pk_bf16(s[6 * 33], s[7 * 33]);
        *(u32x4*)(WT + (size_t)(dst_row0 + n) * K + k0 + 8 * c) = o;
    }
    LDS_WAIT();
}
__device__ __forceinline__ void rms_row_to_bf16(const float* xrow, const float* gain, bf16_t* orow, int lane) {
    f32x4 v[4]; float ss = 0.f;
#pragma unroll
    for (int j = 0; j < 4; ++j) { v[j] = ((const f32x4*)xrow)[lane + 64 * j]; ss += (v[j].x * v[j].x + v[j].y * v[j].y) + (v[j].z * v[j].z + v[j].w * v[j].w); }
    const float r = rsqrtf(wave_sum(ss) * (1.0f / D) + EPS);
#pragma unroll
    for (int j = 0; j < 4; ++j) {
        const f32x4 g = ((const f32x4*)gain)[lane + 64 * j]; const f32x4 o = v[j] * r * g;
        u32x2 w; w.x = cvt_pk_bf16(o.x, o.y); w.y = cvt_pk_bf16(o.z, o.w);
        ((u32x2*)orow)[lane + 64 * j] = w;
    }
}
__device__ __forceinline__ void postnorm_rows(const float* xin, float* xout, const float* mbuf, const float* g_post, const float* g_pre, bf16_t* XN, int gw, int ngw, int lane) {
    for (int row = gw; row < M; row += ngw) {
        const f32x4* mr = (const f32x4*)(mbuf + (size_t)row * D); const f32x4* xr = (const f32x4*)(xin + (size_t)row * D);
        f32x4 mv[4], xv[4]; float ss = 0.f;
#pragma unroll
        for (int j = 0; j < 4; ++j) { mv[j] = mr[lane + 64 * j]; xv[j] = xr[lane + 64 * j]; ss += (mv[j].x * mv[j].x + mv[j].y * mv[j].y) + (mv[j].z * mv[j].z + mv[j].w * mv[j].w); }
        const float r = rsqrtf(wave_sum(ss) * (1.0f / D) + EPS);
        float ss2 = 0.f;
#pragma unroll
        for (int j = 0; j < 4; ++j) {
            const f32x4 g = ((const f32x4*)g_post)[lane + 64 * j];
            xv[j] = xv[j] + mv[j] * r * g;
            ((f32x4*)(xout + (size_t)row * D))[lane + 64 * j] = xv[j];
            ss2 += (xv[j].x * xv[j].x + xv[j].y * xv[j].y) + (xv[j].z * xv[j].z + xv[j].w * xv[j].w);
        }
        if (g_pre) {
            const float r2 = rsqrtf(wave_sum(ss2) * (1.0f / D) + EPS);
#pragma unroll
            for (int j = 0; j < 4; ++j) {
                const f32x4 g = ((const f32x4*)g_pre)[lane + 64 * j]; const f32x4 o = xv[j] * r2 * g;
                u32x2 w; w.x = cvt_pk_bf16(o.x, o.y); w.y = cvt_pk_bf16(o.z, o.w);
                ((u32x2*)(XN + (size_t)row * D))[lane + 64 * j] = w;
            }
        }
    }
}

constexpr int HG_G = 0, HG_QR = 16384, HG_KR = HG_QR + 8704, HG_QIN = HG_KR + 8704, HG_KO = HG_QIN + 8704, HG_V = HG_KO + 8704, HG_STB = HG_V + 32 * 72 * 2, HG_END = HG_STB + 2 * 64 * 136 * 2;
static_assert(HG_END <= 131072, "hgrn lds");
__device__ __forceinline__ bf16x8 gather8(const LAS bf16_t* p, int stride) {
    unsigned a0 = p[0], a1 = p[stride], a2 = p[2 * stride], a3 = p[3 * stride], a4 = p[4 * stride], a5 = p[5 * stride], a6 = p[6 * stride], a7 = p[7 * stride];
    u32x4 w; w.x = a0 | (a1 << 16); w.y = a2 | (a3 << 16); w.z = a4 | (a5 << 16); w.w = a6 | (a7 << 16);
    return __builtin_bit_cast(bf16x8, w);
}
__device__ __forceinline__ bf16x8 gather8p(const LAS bf16_t* p, int stride) {
    unsigned a0 = p[0], a1 = p[stride], a2 = p[2 * stride], a3 = p[3 * stride], a4 = p[8 * stride], a5 = p[9 * stride], a6 = p[10 * stride], a7 = p[11 * stride];
    u32x4 w; w.x = a0 | (a1 << 16); w.y = a2 | (a3 << 16); w.z = a4 | (a5 << 16); w.w = a6 | (a7 << 16);
    return __builtin_bit_cast(bf16x8, w);
}
__device__ __forceinline__ bf16x8 pack8(const f32x16& p, int s) {
    u32x4 w;
    if (s == 0) { w.x = cvt_pk_bf16(p[0], p[1]); w.y = cvt_pk_bf16(p[2], p[3]); w.z = cvt_pk_bf16(p[4], p[5]); w.w = cvt_pk_bf16(p[6], p[7]); }
    else        { w.x = cvt_pk_bf16(p[8], p[9]); w.y = cvt_pk_bf16(p[10], p[11]); w.z = cvt_pk_bf16(p[12], p[13]); w.w = cvt_pk_bf16(p[14], p[15]); }
    return __builtin_bit_cast(bf16x8, w);
}

__device__ __forceinline__ void hgrn_unit(LAS unsigned char* lds, int unit, const bf16_t* Q0, const float* LOGF, const bf16_t* V0, bf16_t* OFB) {
    const int vs = unit & 1, dir = (unit >> 1) & 1, h = (unit >> 2) & 3, b = unit >> 4;
    const int tid = threadIdx.x, lane = tid & 63, wave = __builtin_amdgcn_readfirstlane(tid >> 6), l31 = lane & 31, hi = lane >> 5;
    LAS float* G = (LAS float*)(lds + HG_G);
    LAS bf16_t* QR = (LAS bf16_t*)(lds + HG_QR);
    LAS bf16_t* KR = (LAS bf16_t*)(lds + HG_KR);
    LAS bf16_t* QIN = (LAS bf16_t*)(lds + HG_QIN);
    LAS bf16_t* KO = (LAS bf16_t*)(lds + HG_KO);
    LAS bf16_t* VL = (LAS bf16_t*)(lds + HG_V);
    LAS bf16_t* STB = (LAS bf16_t*)(lds + HG_STB);
    const int r = tid >> 4, k0 = (tid & 15) * 8, v0 = (tid & 15) * 4;
    const int vt = wave >> 2, kt = wave & 3;
    for (int i = tid; i < 64 * 136 / 2; i += 512) ((LAS unsigned*)STB)[i] = 0u;
    f32x16 ST;
#pragma unroll
    for (int i = 0; i < 16; ++i) ST[i] = 0.f;
    const size_t tokb = (size_t)b * T;
    f32x4 nlf0, nlf1; u32x4 nq; u32x2 nv;
    {
        const int c = dir ? 63 : 0; const size_t tok = tokb + c * 32 + (dir ? 31 - r : r);
        const float* lp = LOGF + tok * 1024 + dir * 512 + h * 128 + k0; nlf0 = *(const f32x4*)lp; nlf1 = *(const f32x4*)(lp + 4);
        nq = *(const u32x4*)(Q0 + tok * 512 + h * 128 + k0);
        nv = *(const u32x2*)(V0 + tok * 512 + h * 128 + vs * 64 + v0);
    }
    int cur = 0;
    for (int ci = 0; ci < 64; ++ci) {
        const int c = dir ? 63 - ci : ci;
        const size_t base = tokb + (size_t)c * 32;
        float lf[8] = {nlf0.x, nlf0.y, nlf0.z, nlf0.w, nlf1.x, nlf1.y, nlf1.z, nlf1.w};
        const u32x4 qraw = nq;
        float kk[8];
#pragma unroll
        for (int j = 0; j < 8; ++j) kk[j] = 1.0f - __expf(lf[j]);
        *(LAS f32x4*)(G + r * 128 + k0) = nlf0; *(LAS f32x4*)(G + r * 128 + k0 + 4) = nlf1;
        *(LAS u32x2*)(VL + r * 72 + v0) = nv;
        if (ci + 1 < 64) {
            const int c2 = dir ? 62 - ci : ci + 1; const size_t tok = tokb + c2 * 32 + (dir ? 31 - r : r);
            const float* lp = LOGF + tok * 1024 + dir * 512 + h * 128 + k0; nlf0 = *(const f32x4*)lp; nlf1 = *(const f32x4*)(lp + 4);
            nq = *(const u32x4*)(Q0 + tok * 512 + h * 128 + k0);
            nv = *(const u32x2*)(V0 + tok * 512 + h * 128 + vs * 64 + v0);
        }
        __syncthreads();
        if (tid < 128) {
            float a = 0.f;
#pragma unroll
            for (int t = 0; t < 32; ++t) { a += G[t * 128 + tid]; G[t * 128 + tid] = a; }
        }
        __syncthreads();
        {
            float g[8], gr[8], gl[8];
            { const f32x4 a0 = *(LAS f32x4*)(G + r * 128 + k0), a1 = *(LAS f32x4*)(G + r * 128 + k0 + 4);
              const f32x4 b0 = *(LAS f32x4*)(G + 15 * 128 + k0), b1 = *(LAS f32x4*)(G + 15 * 128 + k0 + 4);
              const f32x4 c0 = *(LAS f32x4*)(G + 31 * 128 + k0), c1 = *(LAS f32x4*)(G + 31 * 128 + k0 + 4);
#pragma unroll
              for (int j = 0; j < 4; ++j) { g[j] = a0[j]; g[4 + j] = a1[j]; gr[j] = b0[j]; gr[4 + j] = b1[j]; gl[j] = c0[j]; gl[4 + j] = c1[j]; } }
            float q[8];
            q[0] = bf2f((unsigned short)(qraw.x & 0xffff)); q[1] = bf2f((unsigned short)(qraw.x >> 16));
            q[2] = bf2f((unsigned short)(qraw.y & 0xffff)); q[3] = bf2f((unsigned short)(qraw.y >> 16));
            q[4] = bf2f((unsigned short)(qraw.z & 0xffff)); q[5] = bf2f((unsigned short)(qraw.z >> 16));
            q[6] = bf2f((unsigned short)(qraw.w & 0xffff)); q[7] = bf2f((unsigned short)(qraw.w >> 16));
            float qr[8], kr[8], qi[8], ko[8];
#pragma unroll
            for (int j = 0; j < 8; ++j) {
                qr[j] = q[j] * __expf(g[j] - gr[j]); kr[j] = kk[j] * __expf(gr[j] - g[j]);
                qi[j] = q[j] * __expf(g[j]);         ko[j] = kk[j] * __expf(gl[j] - g[j]);
            }
            u32x4 w;
            w.x = cvt_pk_bf16(qr[0], qr[1]); w.y = cvt_pk_bf16(qr[2], qr[3]); w.z = cvt_pk_bf16(qr[4], qr[5]); w.w = cvt_pk_bf16(qr[6], qr[7]); *(LAS u32x4*)(QR + r * 136 + k0) = w;
            w.x = cvt_pk_bf16(kr[0], kr[1]); w.y = cvt_pk_bf16(kr[2], kr[3]); w.z = cvt_pk_bf16(kr[4], kr[5]); w.w = cvt_pk_bf16(kr[6], kr[7]); *(LAS u32x4*)(KR + r * 136 + k0) = w;
            w.x = cvt_pk_bf16(qi[0], qi[1]); w.y = cvt_pk_bf16(qi[2], qi[3]); w.z = cvt_pk_bf16(qi[4], qi[5]); w.w = cvt_pk_bf16(qi[6], qi[7]); *(LAS u32x4*)(QIN + r * 136 + k0) = w;
            w.x = cvt_pk_bf16(ko[0], ko[1]); w.y = cvt_pk_bf16(ko[2], ko[3]); w.z = cvt_pk_bf16(ko[4], ko[5]); w.w = cvt_pk_bf16(ko[6], ko[7]); *(LAS u32x4*)(KO + r * 136 + k0) = w;
        }
        __syncthreads();
        if (wave < 2) {
            const int ot = wave;
            f32x16 p;
#pragma unroll
            for (int i = 0; i < 16; ++i) p[i] = 0.f;
#pragma unroll
            for (int ks = 0; ks < 8; ++ks) {
                const bf16x8 a = *(const LAS bf16x8*)(KR + l31 * 136 + 16 * ks + 8 * hi);
                const bf16x8 bq = *(const LAS bf16x8*)(QR + l31 * 136 + 16 * ks + 8 * hi);
                p = MFMA32(a, bq, p);
            }
#pragma unroll
            for (int i = 0; i < 16; ++i) { if (crow(i, hi) > l31) p[i] = 0.f; }
            const bf16x8 pf0 = pack8(p, 0), pf1 = pack8(p, 1);
            f32x16 o;
#pragma unroll
            for (int i = 0; i < 16; ++i) o[i] = 0.f;
            { const bf16x8 a0 = gather8p(VL + (4 * hi) * 72 + ot * 32 + l31, 72); o = MFMA32(a0, pf0, o);
              const bf16x8 a1 = gather8p(VL + (16 + 4 * hi) * 72 + ot * 32 + l31, 72); o = MFMA32(a1, pf1, o); }
            const LAS bf16_t* stb = STB + cur * (64 * 136);
#pragma unroll
            for (int ks = 0; ks < 8; ++ks) {
                const bf16x8 a = *(const LAS bf16x8*)(stb + (ot * 32 + l31) * 136 + 16 * ks + 8 * hi);
                const bf16x8 bq = *(const LAS bf16x8*)(QIN + l31 * 136 + 16 * ks + 8 * hi);
                o = MFMA32(a, bq, o);
            }
            const size_t tok = base + (dir ? 31 - l31 : l31);
            bf16_t* op = OFB + ((size_t)dir * M + tok) * 512 + h * 128 + vs * 64 + ot * 32 + 4 * hi;
#pragma unroll
            for (int g4 = 0; g4 < 4; ++g4) { u32x2 w; w.x = cvt_pk_bf16(o[4 * g4], o[4 * g4 + 1]); w.y = cvt_pk_bf16(o[4 * g4 + 2], o[4 * g4 + 3]); *(u32x2*)(op + 8 * g4) = w; }
        }
        {
            const float dec = __expf(G[31 * 128 + kt * 32 + l31]);
#pragma unroll
            for (int i = 0; i < 16; ++i) ST[i] *= dec;
#pragma unroll
            for (int st = 0; st < 2; ++st) {
                const bf16x8 a = gather8(VL + (16 * st + 8 * hi) * 72 + vt * 32 + l31, 72);
                const bf16x8 bk = gather8(KO + (16 * st + 8 * hi) * 136 + kt * 32 + l31, 136);
                ST = MFMA32(a, bk, ST);
            }
            LAS bf16_t* stn = STB + (cur ^ 1) * (64 * 136);
#pragma unroll
            for (int i = 0; i < 16; ++i) stn[(vt * 32 + crow(i, hi)) * 136 + kt * 32 + l31] = (bf16_t)f2bf(ST[i]);
        }
        __syncthreads();
        cur ^= 1;
    }
}

constexpr int AT_K = 0, AT_V = 384 * 72 * 2, AT_END = 2 * 384 * 72 * 2;
static_assert(AT_END <= 131072, "attn lds");
__device__ __forceinline__ void attn_unit(LAS unsigned char* lds, int unit, const bf16_t* QKV, const float* sink, bf16_t* OUT) {
    const int qb = unit & 15, kv = (unit >> 4) & 3, b = unit >> 6;
    const int tid = threadIdx.x, lane = tid & 63, wave = __builtin_amdgcn_readfirstlane(tid >> 6), l31 = lane & 31, hi = lane >> 5;
    LAS bf16_t* KL = (LAS bf16_t*)(lds + AT_K);
    LAS bf16_t* VL = (LAS bf16_t*)(lds + AT_V);
    const int Q0p = qb * 128, kbase = Q0p - 128;
    const size_t tokb = (size_t)b * T;
#pragma unroll
    for (int it = 0; it < 6; ++it) {
        const int idx = tid + it * 512, row = idx >> 3, c8 = idx & 7, pos = kbase + row;
        u32x4 kx = {0u, 0u, 0u, 0u}, vx = {0u, 0u, 0u, 0u};
        if (pos >= 0 && pos < T) {
            const bf16_t* p = QKV + (tokb + pos) * 1536 + kv * 64 + c8 * 8;
            kx = *(const u32x4*)(p + 1024); vx = *(const u32x4*)(p + 1280);
        }
        *(LAS u32x4*)(KL + row * 72 + c8 * 8) = kx; *(LAS u32x4*)(VL + row * 72 + c8 * 8) = vx;
    }
    __syncthreads();
    const int g = wave >> 1, hh = kv * 4 + g, half = wave & 1;
    const float slope2 = exp2f(-0.5f * (float)(hh + 1)) * LOG2E, sink2 = sink[hh] * LOG2E;
    for (int qt = 0; qt < 2; ++qt) {
        const int q0l = half * 64 + qt * 32, qpos = Q0p + q0l + l31;
        bf16x8 qf[4];
        { const bf16_t* qp = QKV + (tokb + qpos) * 1536 + hh * 64 + 8 * hi;
#pragma unroll
          for (int s = 0; s < 4; ++s) qf[s] = *(const bf16x8*)(qp + 16 * s); }
        float mrun = sink2, lsum = hi == 0 ? 1.0f : 0.0f;
        f32x16 o0, o1;
#pragma unroll
        for (int i = 0; i < 16; ++i) { o0[i] = 0.f; o1[i] = 0.f; }
        for (int kt = 0; kt < 9; ++kt) {
            const int krow0 = q0l + 32 * kt, kpos0 = kbase + krow0;
            if (kpos0 + 31 < 0 || kpos0 >= T) continue;
            f32x16 s;
#pragma unroll
            for (int i = 0; i < 16; ++i) s[i] = 0.f;
#pragma unroll
            for (int ks = 0; ks < 4; ++ks) {
                const bf16x8 a = *(const LAS bf16x8*)(KL + (krow0 + l31) * 72 + 16 * ks + 8 * hi);
                s = MFMA32(a, qf[ks], s);
            }
            float tmax = -INFINITY;
#pragma unroll
            for (int i = 0; i < 16; ++i) {
                const int kpos = kpos0 + crow(i, hi); const int dist = qpos > kpos ? qpos - kpos : kpos - qpos;
                const bool valid = dist <= 128 && kpos >= 0 && kpos < T;
                const float sv = valid ? s[i] - slope2 * (float)dist : -INFINITY;
                s[i] = sv; tmax = fmaxf(tmax, sv);
            }
            tmax = fmaxf(tmax, __shfl_xor(tmax, 32));
            const float mnew = fmaxf(mrun, tmax), alpha = exp2f(mrun - mnew);
            mrun = mnew; lsum *= alpha;
#pragma unroll
            for (int i = 0; i < 16; ++i) { o0[i] *= alpha; o1[i] *= alpha; }
            float ps = 0.f;
#pragma unroll
            for (int i = 0; i < 16; ++i) { const float pe = exp2f(s[i] - mnew); s[i] = pe; ps += pe; }
            lsum += ps;
            const bf16x8 pf0 = pack8(s, 0), pf1 = pack8(s, 1);
            { const bf16x8 a = gather8p(VL + (krow0 + 4 * hi) * 72 + l31, 72); o0 = MFMA32(a, pf0, o0); }
            { const bf16x8 a = gather8p(VL + (krow0 + 4 * hi) * 72 + 32 + l31, 72); o1 = MFMA32(a, pf0, o1); }
            { const bf16x8 a = gather8p(VL + (krow0 + 16 + 4 * hi) * 72 + l31, 72); o0 = MFMA32(a, pf1, o0); }
            { const bf16x8 a = gather8p(VL + (krow0 + 16 + 4 * hi) * 72 + 32 + l31, 72); o1 = MFMA32(a, pf1, o1); }
        }
        const float ltot = lsum + __shfl_xor(lsum, 32), inv = 1.0f / ltot;
        bf16_t* op = OUT + (tokb + qpos) * 1024 + hh * 64 + 4 * hi;
#pragma unroll
        for (int g4 = 0; g4 < 4; ++g4) {
            u32x2 w; w.x = cvt_pk_bf16(o0[4 * g4] * inv, o0[4 * g4 + 1] * inv); w.y = cvt_pk_bf16(o0[4 * g4 + 2] * inv, o0[4 * g4 + 3] * inv); *(u32x2*)(op + 8 * g4) = w;
            u32x2 w2; w2.x = cvt_pk_bf16(o1[4 * g4] * inv, o1[4 * g4 + 1] * inv); w2.y = cvt_pk_bf16(o1[4 * g4 + 2] * inv, o1[4 * g4 + 3] * inv); *(u32x2*)(op + 32 + 8 * g4) = w2;
        }
    }
    __syncthreads();
}

struct Args { const float* in[12]; float* out; unsigned char* ws; };

__device__ __forceinline__ void prologue(const Args& a, LAS unsigned char* lds, int gw, int ngw, int wave, int lane) {
    unsigned char* ws = a.ws;
    LAS float* scr = (LAS float*)(lds + wave * 16384);
    const float* w_in = a.in[2];
    constexpr int I_WCS = 256, I_DFT = 2048, I_T1 = 16 * 80, I_T2 = 16 * 32, I_T3 = 16 * 48, I_T4 = 16 * 32, I_T5 = 2 * 16 * 88, I_T6 = I_T5, I_T7 = 2 * 44 * 32;
    constexpr int NITEMS = I_WCS + I_DFT + I_T1 + I_T2 + I_T3 + I_T4 + I_T5 + I_T6 + I_T7;
    for (int it0 = gw; it0 < NITEMS; it0 += ngw) {
        int it = it0;
        if (it < I_WCS) {
            const int g = it >> 6, k0 = (it & 63) * 16;
#pragma unroll 4
            for (int i = 0; i < 32; ++i) { const int idx = i * 64 + lane, kk = idx >> 7, c = idx & 127; scr[kk * 128 + c] = w_in[(size_t)(k0 + kk) * 3072 + 2560 + g * 128 + c]; }
            LDS_WAIT();
            bf16_t* Wcs = (bf16_t*)(ws + WS_WCS);
            for (int pass = 0; pass < 2; ++pass) {
                const int k2 = lane + 64 * pass;
                float ac[16], as[16];
#pragma unroll
                for (int kk = 0; kk < 16; ++kk) { ac[kk] = 0.f; as[kk] = 0.f; }
                for (int c = 0; c < 128; ++c) {
                    const float ph = (float)((k2 * c) & 127) * (1.0f / 128.0f);
                    const float cc = __builtin_amdgcn_cosf(ph), sn = __builtin_amdgcn_sinf(ph);
#pragma unroll
                    for (int kk = 0; kk < 16; ++kk) { const float w = scr[kk * 128 + c]; ac[kk] += w * cc; as[kk] += w * sn; }
                }
                u32x4 o0, o1;
                o0.x = cvt_pk_bf16(ac[0], ac[1]); o0.y = cvt_pk_bf16(ac[2], ac[3]); o0.z = cvt_pk_bf16(ac[4], ac[5]); o0.w = cvt_pk_bf16(ac[6], ac[7]);
                o1.x = cvt_pk_bf16(ac[8], ac[9]); o1.y = cvt_pk_bf16(ac[10], ac[11]); o1.z = cvt_pk_bf16(ac[12], ac[13]); o1.w = cvt_pk_bf16(ac[14], ac[15]);
                bf16_t* d0 = Wcs + (size_t)(g * 128 + k2) * 1024 + k0; *(u32x4*)d0 = o0; *(u32x4*)(d0 + 8) = o1;
                o0.x = cvt_pk_bf16(as[0], as[1]); o0.y = cvt_pk_bf16(as[2], as[3]); o0.z = cvt_pk_bf16(as[4], as[5]); o0.w = cvt_pk_bf16(as[6], as[7]);
                o1.x = cvt_pk_bf16(as[8], as[9]); o1.y = cvt_pk_bf16(as[10], as[11]); o1.z = cvt_pk_bf16(as[12], as[13]); o1.w = cvt_pk_bf16(as[14], as[15]);
                bf16_t* d1 = Wcs + (size_t)(512 + g * 128 + k2) * 1024 + k0; *(u32x4*)d1 = o0; *(u32x4*)(d1 + 8) = o1;
            }
            LDS_WAIT();
            continue;
        }
        it -= I_WCS;
        if (it < I_DFT) {
            const int k1 = it; bf16_t* dr = (bf16_t*)(ws + WS_DFT) + (size_t)k1 * 4096;
#pragma unroll 2
            for (int i = 0; i < 8; ++i) {
                const int col0 = (i * 64 + lane) * 8, cs = col0 >> 11;
                float v[8];
#pragma unroll
                for (int j = 0; j < 8; ++j) {
                    const int t = (col0 + j) & 2047; const float ph = (float)((k1 * t) & 2047) * (1.0f / 2048.0f);
                    v[j] = (cs ? -__builtin_amdgcn_sinf(ph) : __builtin_amdgcn_cosf(ph)) * (1.0f / 512.0f);
                }
                u32x4 o; o.x = cvt_pk_bf16(v[0], v[1]); o.y = cvt_pk_bf16(v[2], v[3]); o.z = cvt_pk_bf16(v[4], v[5]); o.w = cvt_pk_bf16(v[6], v[7]);
                *(u32x4*)(dr + col0) = o;
            }
            continue;
        }
        it -= I_DFT;
        if (it < I_T1) { const int kb = it / 80, nb = it % 80; transpose_item(w_in, 3072, 1024, (bf16_t*)(ws + WS_WP), kb * 64, nb * 32, nb * 32, scr, lane); continue; }
        it -= I_T1;
        if (it < I_T2) { const int kb = it / 32, nb = it % 32; transpose_item(a.in[5], 1024, 1024, (bf16_t*)(ws + WS_WO0), kb * 64, nb * 32, nb * 32, scr, lane); continue; }
        it -= I_T2;
        if (it < I_T3) { const int kb = it / 48, nb = it % 48; transpose_item(a.in[6], 1536, 1024, (bf16_t*)(ws + WS_WQKV), kb * 64, nb * 32, nb * 32, scr, lane); continue; }
        it -= I_T3;
        if (it < I_T4) { const int kb = it / 32, nb = it % 32; transpose_item(a.in[8], 1024, 1024, (bf16_t*)(ws + WS_WO1), kb * 64, nb * 32, nb * 32, scr, lane); continue; }
        it -= I_T4;
        if (it < I_T5 + I_T6) {
            const int which = it >= I_T5; if (which) it -= I_T5;
            const int layer = it / (16 * 88); it -= layer * (16 * 88);
            const int kb = it / 88, nb = it % 88, n0 = nb * 32;
            const float* src = (which ? a.in[10] : a.in[9]) + (size_t)layer * 1024 * FF;
            transpose_item(src, FF, 1024, (bf16_t*)(ws + WS_W13) + (size_t)layer * W13_STRIDE, kb * 64, n0, 256 * (n0 >> 7) + 128 * which + (n0 & 127), scr, lane); continue;
        }
        it -= I_T5 + I_T6;
        { const int layer = it / (44 * 32); it -= layer * (44 * 32);
          const int kb = it / 32, nb = it % 32;
          transpose_item(a.in[11] + (size_t)layer * FF * 1024, 1024, FF, (bf16_t*)(ws + WS_W2) + (size_t)layer * W2_STRIDE, kb * 64, nb * 32, nb * 32, scr, lane); }
    }
    for (int row = gw; row < M; row += ngw) rms_row_to_bf16(a.in[0] + (size_t)row * D, a.in[1], (bf16_t*)(ws + WS_XN) + (size_t)row * D, lane);
}

#ifndef PHMASK
#define PHMASK 0xffff
#endif

__global__ void __launch_bounds__(512, 2) fwd_megakernel(Args a) {
    extern __shared__ __attribute__((aligned(16))) unsigned char lds_raw[];
    LAS unsigned char* lds = (LAS unsigned char*)lds_raw;
    cg::grid_group grid = cg::this_grid();
    const int tid = threadIdx.x, lane = tid & 63, wave = __builtin_amdgcn_readfirstlane(tid >> 6);
    const int G = gridDim.x, bid = blockIdx.x, gw = bid * 8 + wave, ngw = G * 8;
    unsigned char* ws = a.ws;
    bf16_t* XN = (bf16_t*)(ws + WS_XN); float* MBUF = (float*)(ws + WS_MBUF);
    bf16_t* ACAT = (bf16_t*)(ws + WS_ACAT); bf16_t* HB = (bf16_t*)(ws + WS_H);
    float* LOGF = a.out;
    const float* gains = a.in[1];

#if PHMASK & 1
    prologue(a, lds, gw, ngw, wave, lane);
#endif
    grid.sync();

#if PHMASK & 2
    {
        pg8::Gemm g{XN, (const bf16_t*)(ws + WS_WP), M, 2560, 1024}; pg8::StaticOrder S; S.init(M, 2560, G, bid);
        EpiProj E{(bf16_t*)(ws + WS_Q0), LOGF, a.in[3]};
        static_assert(WS_V0 == WS_Q0 + (size_t)M * 512 * 2 && WS_GATE == WS_V0 + (size_t)M * 512 * 2, "Q0 | V0 | GATE consecutive");
        pg8::gemm_phase<EpiProj, pg8::StaticOrder, true, true>(lds, g, S, E);
    }
#endif
#if PHMASK & 4
    {
        pg8::Gemm g{(const bf16_t*)(ws + WS_WCS), XN, 1024, M, 1024}; pg8::StaticOrder S; S.init(1024, M, G, bid);
        EpiYt E{(bf16_t*)(ws + WS_YT)};
        pg8::gemm_phase<EpiYt, pg8::StaticOrder, true, true>(lds, g, S, E);
    }
#endif
    grid.sync();

    {
        const bool split = (G % 16) == 0;
        const bool do_f = !split || (((bid >> 3) & 1) == 0), do_h = !split || (((bid >> 3) & 1) == 1);
        const int gsz = split ? G / 2 : G, gidx = split ? (bid >> 4) * 8 + (bid & 7) : bid;
#if PHMASK & 8
        if (do_f) {
            pg8::Gemm g{(const bf16_t*)(ws + WS_DFT), (const bf16_t*)(ws + WS_YT), 2048, 4096, 4096}; pg8::StaticOrder S; S.init(2048, 4096, gsz, gidx);
            EpiFnet E{ACAT};
            pg8::gemm_phase<EpiFnet, pg8::StaticOrder, true, true>(lds, g, S, E);
        }
#endif
#if PHMASK & 16
        if (do_h) {
            for (int u = gidx; u < 128; u += gsz) hgrn_unit(lds, u, (const bf16_t*)(ws + WS_Q0), LOGF, (const bf16_t*)(ws + WS_V0), (bf16_t*)(ws + WS_OFB));
        }
#endif
    }
    grid.sync();

    {
        const bf16_t* OFB = (const bf16_t*)(ws + WS_OFB); const bf16_t* GATE = (const bf16_t*)(ws + WS_GATE); const float* og = a.in[4];
        for (int row = gw; row < M; row += ngw) {
            const u32x4 f = *(const u32x4*)(OFB + (size_t)row * 512 + lane * 8), bw = *(const u32x4*)(OFB + ((size_t)M + row) * 512 + lane * 8), gt = *(const u32x4*)(GATE + (size_t)row * 512 + lane * 8);
            float o[8]; float ss = 0.f;
#pragma unroll
            for (int j = 0; j < 4; ++j) {
                o[2 * j] = bf2f((unsigned short)(f[j] & 0xffff)) + bf2f((unsigned short)(bw[j] & 0xffff));
                o[2 * j + 1] = bf2f((unsigned short)(f[j] >> 16)) + bf2f((unsigned short)(bw[j] >> 16));
                ss += o[2 * j] * o[2 * j] + o[2 * j + 1] * o[2 * j + 1];
            }
            ss += __shfl_xor(ss, 1); ss += __shfl_xor(ss, 2); ss += __shfl_xor(ss, 4); ss += __shfl_xor(ss, 8);
            const float r = rsqrtf(ss * (1.0f / 128.0f) + EPS);
            const f32x4 g0 = *(const f32x4*)(og + lane * 8), g1 = *(const f32x4*)(og + lane * 8 + 4);
            float res[8];
#pragma unroll
            for (int j = 0; j < 4; ++j) {
                res[2 * j] = o[2 * j] * r * (2 * j < 4 ? g0[2 * j] : g1[2 * j - 4]) * bf2f((unsigned short)(gt[j] & 0xffff));
                res[2 * j + 1] = o[2 * j + 1] * r * (2 * j + 1 < 4 ? g0[2 * j + 1] : g1[2 * j + 1 - 4]) * bf2f((unsigned short)(gt[j] >> 16));
            }
            u32x4 w; w.x = cvt_pk_bf16(res[0], res[1]); w.y = cvt_pk_bf16(res[2], res[3]); w.z = cvt_pk_bf16(res[4], res[5]); w.w = cvt_pk_bf16(res[6], res[7]);
            *(u32x4*)(ACAT + (size_t)row * 1024 + lane * 8) = w;
        }
    }
    grid.sync();

#pragma unroll
    for (int layer = 0; layer < 2; ++layer) {
        const float* gl = gains + (size_t)layer * 4 * D;
        if (layer == 1) {
            {
                pg8::Gemm g{XN, (const bf16_t*)(ws + WS_WQKV), M, 1536, 1024}; pg8::StaticOrder S; S.init(M, 1536, G, bid);
                EpiQKV E{(bf16_t*)(ws + WS_QKV1)};
                pg8::gemm_phase<EpiQKV, pg8::StaticOrder, true, true>(lds, g, S, E);
            }
            grid.sync();
#if PHMASK & 32
            for (int u = bid; u < 512; u += G) attn_unit(lds, u, (const bf16_t*)(ws + WS_QKV1), a.in[7], ACAT);
#endif
            grid.sync();
        }
        {
            pg8::Gemm g{ACAT, (const bf16_t*)(ws + (layer == 0 ? WS_WO0 : WS_WO1)), M, 1024, 1024}; pg8::StaticOrder S; S.init(M, 1024, G, bid);
            EpiF32 E{MBUF, 1024};
            pg8::gemm_phase<EpiF32, pg8::StaticOrder, true, true>(lds, g, S, E);
        }
        grid.sync();
        postnorm_rows(layer == 0 ? a.in[0] : a.out, a.out, MBUF, gl + D, gl + 2 * D, XN, gw, ngw, lane);
        grid.sync();
        {
            pg8::Gemm g{XN, (const bf16_t*)(ws + WS_W13) + (size_t)layer * W13_STRIDE, M, 5632, 1024}; pg8::StaticOrder S; S.init(M, 5632, G, bid);
            EpiSwiglu E{HB};
            pg8::gemm_phase<EpiSwiglu, pg8::StaticOrder, true, true>(lds, g, S, E);
        }
        grid.sync();
        {
            pg8::Gemm g{HB, (const bf16_t*)(ws + WS_W2) + (size_t)layer * W2_STRIDE, M, 1024, FF}; pg8::StaticOrder S; S.init(M, 1024, G, bid);
            EpiF32 E{MBUF, 1024};
            pg8::gemm_phase<EpiF32, pg8::StaticOrder, true, true>(lds, g, S, E);
        }
        grid.sync();
        postnorm_rows(a.out, a.out, MBUF, gl + 3 * D, layer == 0 ? gains + 4 * D : nullptr, XN, gw, ngw, lane);
        if (layer == 0) grid.sync();
    }
}

extern "C" void kernel_launch(void* const* d_in, const int* in_sizes, int n_in, void* d_out, int out_size, void* d_ws, size_t ws_size, hipStream_t stream) {
    static int grid = 0;
    if (grid == 0) {
        if (n_in != 12 || out_size != M * D || ws_size < WS_END) { fprintf(stderr, "kernel_launch: unexpected shapes (n_in %d out %d ws %zu)\n", n_in, out_size, ws_size); grid = -1; return; }
        int dev = 0, cus = 0, per_cu = 0;
        hipGetDevice(&dev); hipDeviceGetAttribute(&cus, hipDeviceAttributeMultiprocessorCount, dev);
        if (hipFuncSetAttribute((const void*)fwd_megakernel, hipFuncAttributeMaxDynamicSharedMemorySize, LDS_BYTES) != hipSuccess) { fprintf(stderr, "kernel_launch: hipFuncSetAttribute failed\n"); grid = -1; return; }
        if (hipOccupancyMaxActiveBlocksPerMultiprocessor(&per_cu, (const void*)fwd_megakernel, 512, LDS_BYTES) != hipSuccess || per_cu < 1) { fprintf(stderr, "kernel_launch: occupancy query gave %d\n", per_cu); per_cu = 1; }
        (void)hipGetLastError();
        grid = cus;
    }
    if (grid < 0) return;
    Args a{};
    for (int i = 0; i < 12; ++i) a.in[i] = (const float*)d_in[i];
    a.out = (float*)d_out; a.ws = (unsigned char*)d_ws;
    void* args[] = {&a};
    hipError_t e = hipLaunchCooperativeKernel((const void*)fwd_megakernel, dim3(grid), dim3(512), args, LDS_BYTES, stream);
    if (e != hipSuccess) fprintf(stderr, "cooperative launch failed: %s (grid %d)\n", hipGetErrorString(e), grid);
}
```

```cpp
#include <hip/hip_runtime.h>
#include <hip/hip_cooperative_groups.h>
#include <cstdio>
#include <cstdint>
namespace cg = cooperative_groups;
namespace pg8 {
#define PG8_LAS __attribute__((address_space(3)))
typedef unsigned short bf16_t;
typedef short bf16x8 __attribute__((ext_vector_type(8)));
typedef float f32x4 __attribute__((ext_vector_type(4)));
typedef unsigned u32x4 __attribute__((ext_vector_type(4)));
constexpr int BM = 256, BK = 64, HALF = 128, HTB = HALF * BK * 2  , STAGE_BYTES = 8 * HTB, NXCD = 8, WGM = 8;

__host__ __device__ __forceinline__ int lds_byte(int r, int c) { const int st = (r >> 4) * 2 + (c >> 5), rr = r & 15, cc = c & 31, ob = rr * 64 + cc * 2; return st * 1024 + (ob ^ (((ob >> 9) & 1) << 5)); }
__host__ __device__ __forceinline__ void stage_rc(int b, int& R, int& C) { const int st = b / 1024, sb = b % 1024, swz = sb ^ (((sb >> 9) & 1) << 5); R = (st >> 1) * 16 + swz / 64; C = (st & 1) * 32 + (swz % 64) / 2; }
__host__ __device__ __forceinline__ int perm32(int rho) { const int n = rho >> 4, i = rho & 15; return 8 * (i >> 2) + 4 * n + (i & 3); }

struct Unit { int pm, pn; };
struct Gemm { const bf16_t* A; const bf16_t* Bt; int M, N, K; };

struct StaticOrder {
    int nM, nN, nwg, G, c;
    __host__ __device__ void init(int M, int N, int G_, int c_) { nM = M / BM; nN = N / BM; nwg = nM * nN; G = G_; c = c_; }
    __host__ __device__ bool next(int i, Unit& u) const {
        const long L = (long)i * G + c; if (L >= nwg) return false;
        int wgid = (int)L; { const int q = nwg / NXCD, r = nwg % NXCD, xcd = wgid % NXCD, off = wgid / NXCD; wgid = (xcd < r ? xcd * (q + 1) : r * (q + 1) + (xcd - r) * q) + off; }
        const int nig = WGM * nN, gid = wgid / nig, fm = gid * WGM, gsz = (nM - fm) < WGM ? (nM - fm) : WGM;
        u.pm = fm + ((wgid % nig) % gsz); u.pn = (wgid % nig) / gsz; return true;
    }
    __device__ __forceinline__ void a_ready(const Unit&) const {}
    __device__ __forceinline__ void done(const Unit&) const {}
};

typedef float f32x2_t __attribute__((ext_vector_type(2))); typedef __bf16 bf16x2_t __attribute__((ext_vector_type(2)));
__device__ __forceinline__ unsigned cvt_pk_bf16(float lo, float hi) { f32x2_t v = {lo, hi}; bf16x2_t b = __builtin_convertvector(v, bf16x2_t); return __builtin_bit_cast(unsigned, b); }
template <class Epi, class Sched, bool ALIGN_EPI = false, bool SP2 = false>
__device__ __forceinline__ void gemm_phase(PG8_LAS unsigned char* lds, const Gemm g, const Sched& S, const Epi& E) {
    const int tid = threadIdx.x, wid = __builtin_amdgcn_readfirstlane(tid >> 6), lane = tid & 63, wr = wid >> 2, wc = wid & 3, fr = lane & 15, fq = lane >> 4;
    const int K = g.K, nt = K / BK;
    unsigned voffA[2], voffB[2];
#pragma unroll
    for (int i = 0; i < 2; ++i) { int R, C; stage_rc(tid * 16 + i * 8192, R, C); const int Rb = Epi::PERM ? ((R & ~31) + perm32(R & 31)) : R;
        voffA[i] = (unsigned)(R * K + C) * 2u; voffB[i] = (unsigned)(Rb * K + C) * 2u; }
    const size_t kstep = (size_t)(BK * 2);
    const size_t hstep = (size_t)HALF * K * 2;
    const size_t tstep = 2 * hstep;
    const unsigned ldsw = (unsigned)wid * 1024u;
    const int aoff = lds_byte(wr * 64 + fr, fq * 8), boff = lds_byte(wc * 32 + fr, fq * 8);
#define PG8_SA(b, h) (((b) * 2 + (h)) * HTB)
#define PG8_SB(b, h) ((4 + (b) * 2 + (h)) * HTB)
#define PG8_STAGE(bufoff, gbase, voff) do { _Pragma("unroll") for (int _i = 0; _i < 2; ++_i) \
        __builtin_amdgcn_global_load_lds((const unsigned*)((const char*)(gbase) + (voff)[_i]), (PG8_LAS unsigned*)(lds + (bufoff) + ldsw + _i * 8192), 16, 0, 0); } while (0)
#define PG8_LDA(dst, b, h) do { _Pragma("unroll") for (int m = 0; m < 4; ++m) _Pragma("unroll") for (int k = 0; k < 2; ++k) dst[m][k] = *(const PG8_LAS bf16x8*)(lds + PG8_SA(b, h) + aoff + m * 2048 + k * 1024); } while (0)
#define PG8_LDB(dst, b, h) do { _Pragma("unroll") for (int n = 0; n < 2; ++n) _Pragma("unroll") for (int k = 0; k < 2; ++k) dst[n][k] = *(const PG8_LAS bf16x8*)(lds + PG8_SB(b, h) + boff + n * 2048 + k * 1024); } while (0)
#define PG8_MMA(ai, bj, At, Bt) do { __builtin_amdgcn_s_setprio(1); _Pragma("unroll") for (int m = 0; m < 4; ++m) _Pragma("unroll") for (int n = 0; n < 2; ++n) _Pragma("unroll") for (int k = 0; k < 2; ++k) \
        acc[ai][bj][m][n] = __builtin_amdgcn_mfma_f32_16x16x32_bf16(Bt[n][k], At[m][k], acc[ai][bj][m][n], 0, 0, 0); __builtin_amdgcn_s_setprio(0); } while (0)
#define PG8_WAIT_V(n) asm volatile("s_waitcnt vmcnt(" #n ")" ::: "memory")
#define PG8_WAIT_L(n) asm volatile("s_waitcnt lgkmcnt(" #n ")" ::: "memory")
#define PG8_BAR __builtin_amdgcn_s_barrier()
#define PG8_SCHED __builtin_amdgcn_sched_barrier(0)
    Unit cur, nxt; int ui = 0;
    if (!S.next(0, cur)) return;
    f32x4 acc[2][2][4][2];
#pragma unroll
    for (int a = 0; a < 2; ++a)
#pragma unroll
        for (int b = 0; b < 2; ++b)
#pragma unroll
            for (int m = 0; m < 4; ++m)
#pragma unroll
                for (int n = 0; n < 2; ++n) acc[a][b][m][n] = (f32x4){0.f, 0.f, 0.f, 0.f};
    bf16x8 At[4][2], B0[2][2], B1[2][2];
    const char* cA = (const char*)g.A + (size_t)cur.pm * tstep; const char* cB = (const char*)g.Bt + (size_t)cur.pn * tstep;
    S.a_ready(cur);
    if constexpr (SP2) {
        PG8_STAGE(PG8_SB(0, 0), cB, voffB); PG8_STAGE(PG8_SB(0, 1), cB + hstep, voffB); PG8_STAGE(PG8_SA(0, 0), cA, voffA); PG8_STAGE(PG8_SA(0, 1), cA + hstep, voffA);
        if (wr == 1) PG8_BAR;
        PG8_WAIT_V(2); PG8_BAR;
        PG8_STAGE(PG8_SB(1, 0), cB + kstep, voffB); PG8_STAGE(PG8_SA(1, 0), cA + kstep, voffA); PG8_STAGE(PG8_SB(1, 1), cB + hstep + kstep, voffB);
        PG8_WAIT_V(6); PG8_BAR;
    } else {
        PG8_STAGE(PG8_SB(0, 0), cB, voffB); PG8_STAGE(PG8_SA(0, 0), cA, voffA); PG8_STAGE(PG8_SB(0, 1), cB + hstep, voffB); PG8_STAGE(PG8_SA(0, 1), cA + hstep, voffA);
        if (wr == 1) PG8_BAR;
        PG8_WAIT_V(4); PG8_BAR;
        PG8_STAGE(PG8_SB(1, 0), cB + kstep, voffB); PG8_STAGE(PG8_SA(1, 0), cA + kstep, voffA); PG8_STAGE(PG8_SB(1, 1), cB + hstep + kstep, voffB);
        PG8_WAIT_V(6); PG8_BAR;
    }
    for (;;) {
        const bool has_next = S.next(ui + 1, nxt);
        const char* nA = has_next ? (const char*)g.A + (size_t)nxt.pm * tstep : cA; const char* nB = has_next ? (const char*)g.Bt + (size_t)nxt.pn * tstep : cB;
        for (int t = 0; t < nt; t += 2) {
            const bool last = (t == nt - 2);
            const char* a1 = cA + (size_t)(t + 1) * kstep;
            const char* a2 = last ? nA : cA + (size_t)(t + 2) * kstep; const char* b2 = last ? nB : cB + (size_t)(t + 2) * kstep;
            const char* a3 = a2 + kstep; const char* b3 = b2 + kstep;
            if (last && has_next) S.a_ready(nxt);
            if constexpr (SP2) {
            PG8_LDB(B0, 0, 0); PG8_LDB(B1, 0, 1); PG8_SCHED; PG8_LDA(At, 0, 0); PG8_STAGE(PG8_SA(1, 1), a1 + hstep, voffA);
            PG8_WAIT_V(8); PG8_WAIT_L(0); PG8_BAR; PG8_MMA(0, 0, At, B0); PG8_MMA(0, 1, At, B1); PG8_BAR; PG8_SCHED;
            PG8_LDA(At, 0, 1); PG8_STAGE(PG8_SB(0, 0), b2, voffB); PG8_STAGE(PG8_SB(0, 1), b2 + hstep, voffB); PG8_STAGE(PG8_SA(0, 0), a2, voffA);
            PG8_WAIT_V(8); PG8_WAIT_L(0); PG8_BAR; PG8_MMA(1, 0, At, B0); PG8_MMA(1, 1, At, B1); PG8_BAR; PG8_SCHED;
            PG8_LDB(B0, 1, 0); PG8_LDB(B1, 1, 1); PG8_SCHED; PG8_LDA(At, 1, 0); PG8_STAGE(PG8_SA(0, 1), a2 + hstep, voffA);
            PG8_WAIT_V(8); PG8_WAIT_L(0); PG8_BAR; PG8_MMA(0, 0, At, B0); PG8_MMA(0, 1, At, B1); PG8_BAR; PG8_SCHED;
            PG8_LDA(At, 1, 1); PG8_STAGE(PG8_SB(1, 0), b3, voffB); PG8_STAGE(PG8_SB(1, 1), b3 + hstep, voffB); PG8_STAGE(PG8_SA(1, 0), a3, voffA);
            PG8_WAIT_V(8); PG8_WAIT_L(0); PG8_BAR; PG8_MMA(1, 0, At, B0); PG8_MMA(1, 1, At, B1); PG8_BAR; PG8_SCHED;
            } else {
            PG8_LDB(B0, 0, 0); PG8_SCHED; PG8_LDA(At, 0, 0); PG8_STAGE(PG8_SA(1, 1), a1 + hstep, voffA);
            PG8_WAIT_L(8); PG8_BAR; PG8_WAIT_L(0); PG8_MMA(0, 0, At, B0); PG8_BAR; PG8_SCHED;
            PG8_LDB(B1, 0, 1); PG8_STAGE(PG8_SB(0, 0), b2, voffB);
            PG8_BAR; PG8_WAIT_L(0); PG8_MMA(0, 1, At, B1); PG8_BAR;
            PG8_LDA(At, 0, 1); PG8_STAGE(PG8_SA(0, 0), a2, voffA);
            PG8_BAR; PG8_WAIT_L(0); PG8_MMA(1, 0, At, B0); PG8_BAR; PG8_SCHED;
            PG8_STAGE(PG8_SB(0, 1), b2 + hstep, voffB);
            PG8_WAIT_V(6); PG8_BAR; PG8_MMA(1, 1, At, B1); PG8_BAR;
            PG8_LDB(B0, 1, 0); PG8_SCHED; PG8_LDA(At, 1, 0); PG8_STAGE(PG8_SA(0, 1), a2 + hstep, voffA);
            PG8_WAIT_L(8); PG8_BAR; PG8_WAIT_L(0); PG8_MMA(0, 0, At, B0); PG8_BAR; PG8_SCHED;
            PG8_LDB(B1, 1, 1); PG8_STAGE(PG8_SB(1, 0), b3, voffB);
            PG8_BAR; PG8_WAIT_L(0); PG8_MMA(0, 1, At, B1); PG8_BAR;
            PG8_LDA(At, 1, 1); PG8_STAGE(PG8_SA(1, 0), a3, voffA);
            PG8_BAR; PG8_WAIT_L(0); PG8_MMA(1, 0, At, B0); PG8_BAR; PG8_SCHED;
            PG8_STAGE(PG8_SB(1, 1), b3 + hstep, voffB);
            PG8_WAIT_V(6); PG8_BAR; PG8_MMA(1, 1, At, B1); PG8_BAR;
            }
        }
        if constexpr (ALIGN_EPI) { if (wr == 0) PG8_BAR; }
        if constexpr (!Epi::AFTER_DRAIN) { E(acc, cur, wr, wc, fr, fq); S.done(cur); }
        if (!has_next) break;
#pragma unroll
        for (int a = 0; a < 2; ++a)
#pragma unroll
            for (int b = 0; b < 2; ++b)
#pragma unroll
                for (int m = 0; m < 4; ++m)
#pragma unroll
                    for (int n = 0; n < 2; ++n) acc[a][b][m][n] = (f32x4){0.f, 0.f, 0.f, 0.f};
        cur = nxt; cA = nA; cB = nB; ++ui;
        if constexpr (ALIGN_EPI) { if (wr == 1) PG8_BAR; }
    }
    PG8_WAIT_V(0);
    if constexpr (!ALIGN_EPI) { if (wr == 0) PG8_BAR; }
    PG8_BAR;
    if constexpr (Epi::AFTER_DRAIN) { E.fused(acc, cur, wr, wc, fr, fq, lds, wid, lane); S.done(cur); }
#undef PG8_SA
#undef PG8_SB
#undef PG8_STAGE
#undef PG8_LDA
#undef PG8_LDB
#undef PG8_MMA
#undef PG8_WAIT_V
#undef PG8_WAIT_L
#undef PG8_BAR
#undef PG8_SCHED
}
}

#define LAS __attribute__((address_space(3)))
using pg8::bf16_t; using pg8::bf16x8; using pg8::f32x4; using pg8::u32x4; using pg8::Unit; using pg8::cvt_pk_bf16;
typedef float f32x16 __attribute__((ext_vector_type(16)));
typedef unsigned u32x2 __attribute__((ext_vector_type(2)));
typedef short s16x4 __attribute__((ext_vector_type(4)));
#define MFMA32(a, b, c) __builtin_amdgcn_mfma_f32_32x32x16_bf16((a), (b), (c), 0, 0, 0)

constexpr int NB = 8, T = 2048, D = 1024, M = NB * T, FF = 2816;
constexpr float EPS = 1e-6f;
constexpr float LOG2E = 1.4426950408889634f;
constexpr int LDS_BYTES = 147456;

constexpr size_t MiB = 1u << 20;
constexpr size_t WS_WP = 1 * MiB;
constexpr size_t WS_WCS = 6 * MiB;
constexpr size_t WS_DFT = 8 * MiB;
constexpr size_t WS_WO0 = 24 * MiB;
constexpr size_t WS_WQKV = 26 * MiB;
constexpr size_t WS_WO1 = 29 * MiB;
constexpr size_t WS_W13 = 31 * MiB;
constexpr size_t WS_W2 = 53 * MiB;
constexpr size_t W13_STRIDE = (size_t)5632 * 1024, W2_STRIDE = (size_t)1024 * 2816;
constexpr size_t WS_XN = 66 * MiB;
constexpr size_t WS_MBUF = 98 * MiB;
constexpr size_t WS_YT = 98 * MiB;
constexpr size_t WS_OFB = 130 * MiB;
constexpr size_t WS_Q0 = 162 * MiB;
constexpr size_t WS_V0 = 178 * MiB;
constexpr size_t WS_GATE = 194 * MiB;
constexpr size_t WS_ACAT = 210 * MiB;
constexpr size_t WS_H = 162 * MiB;
constexpr size_t WS_QKV1 = 162 * MiB;
constexpr size_t WS_END = 256 * MiB;

__device__ __forceinline__ unsigned f2bf(float f) { unsigned u = __builtin_bit_cast(unsigned, f); return (u + 0x7fffu + ((u >> 16) & 1u)) >> 16; }
__device__ __forceinline__ float bf2f(unsigned short h) { return __builtin_bit_cast(float, (unsigned)h << 16); }
__device__ __forceinline__ float wave_sum(float v) {
#pragma unroll
    for (int o = 1; o < 64; o <<= 1) v += __shfl_xor(v, o);
    return v;
}
__device__ __forceinline__ int crow(int r, int hi) { return (r & 3) + 8 * (r >> 2) + 4 * hi; }
#define LDS_WAIT() asm volatile("s_waitcnt lgkmcnt(0)" ::: "memory")
#define XB_TMO      128
#define XB_XCNT(j)  (256  + 64 * (j))
#define XB_XSUB(j)  (1280 + 64 * (j))
#define XB_XGEN(j)  (2304 + 64 * (j))
#define XB_TOP      3328
#define XB_TOPGEN   3392
#define XCD_BAR_WORDS 3456
#define XB_SPIN_CAP (1u << 18)

__device__ __forceinline__ unsigned xb_ld(unsigned* p)              { return __hip_atomic_load(p, __ATOMIC_RELAXED, __HIP_MEMORY_SCOPE_AGENT); }
__device__ __forceinline__ unsigned xb_add(unsigned* p, unsigned v) { return __hip_atomic_fetch_add(p, v, __ATOMIC_RELAXED, __HIP_MEMORY_SCOPE_AGENT); }
__device__ __forceinline__ unsigned xb_xcc_id() { return (unsigned)__builtin_amdgcn_s_getreg((3 << 11) | 20) & 0xFu; }
#define XB_SPIN(cond, bar) do { unsigned _sp = 0; while (cond) { __builtin_amdgcn_s_sleep(1); \
    if ((++_sp & 255u) == 0u) { if (xb_ld(&(bar)[XB_TMO])) break; if (_sp > XB_SPIN_CAP) { atomicAdd(&(bar)[XB_TMO], 1u); break; } } } } while (0)

struct XcdBarrier {
    unsigned* bar; unsigned x;
    volatile LAS unsigned* st;
};

__device__ __forceinline__ XcdBarrier xcd_barrier_post(unsigned* bar, volatile LAS unsigned* st) {
    XcdBarrier b; b.bar = bar; b.x = xb_xcc_id(); b.st = st;
    if (threadIdx.x == 0) (void)xb_add(&bar[XB_XCNT(b.x)], 1u);
    return b;
}
__device__ __forceinline__ void xcd_barrier_complete(unsigned* bar, unsigned x, unsigned& nloc, unsigned& nx) {
    const unsigned G = gridDim.x * gridDim.y * gridDim.z;
    unsigned sum, cnt, mine, sp = 0u;
    for (;;) {
        sum = 0u; cnt = 0u; mine = 0u;
#pragma unroll
        for (unsigned j = 0; j < 16; ++j) { const unsigned c = xb_ld(&bar[XB_XCNT(j)]); sum += c; cnt += (c > 0u) ? 1u : 0u; mine = (j == x) ? c : mine; }
        if (sum == G) break;
        __builtin_amdgcn_s_sleep(1);
        if ((++sp & 255u) == 0u) { if (xb_ld(&bar[XB_TMO])) break; if (sp > XB_SPIN_CAP) { atomicAdd(&bar[XB_TMO], 1u); break; } }
    }
    nloc = mine > 0u ? mine : 1u; nx = cnt > 0u ? cnt : 1u;
}

__device__ __forceinline__ void xcd_barrier(const XcdBarrier& b) {
    asm volatile("s_waitcnt vmcnt(0)" ::: "memory");
    __syncthreads();
    if (threadIdx.x == 0) {
        unsigned* bar = b.bar;
        __builtin_amdgcn_s_waitcnt(0);
        unsigned nloc = b.st[0], nx = b.st[1];
        if (nloc == 0u) { xcd_barrier_complete(bar, b.x, nloc, nx); b.st[0] = nloc; b.st[1] = nx; }
        const unsigned old = xb_add(&bar[XB_XSUB(b.x)], 1u);
        const unsigned gen = old / nloc;
        if (old + 1u == (gen + 1u) * nloc) {
            __builtin_amdgcn_fence(__ATOMIC_RELEASE, "agent");
            asm volatile("s_waitcnt vmcnt(0)" ::: "memory");
            const unsigned og = xb_add(&bar[XB_TOP], 1u);
            const unsigned tg = og / nx;
            if (og + 1u == (tg + 1u) * nx) xb_add(&bar[XB_TOPGEN], 1u);
            else XB_SPIN(xb_ld(&bar[XB_TOPGEN]) == tg, bar);
            __builtin_amdgcn_fence(__ATOMIC_ACQUIRE, "agent");
            xb_add(&bar[XB_XGEN(b.x)], 1u);
            asm volatile("s_waitcnt vmcnt(0)" ::: "memory");
        } else {
            XB_SPIN(xb_ld(&bar[XB_XGEN(b.x)]) == gen, bar);
            __builtin_amdgcn_fence(__ATOMIC_ACQUIRE, "agent");
            asm volatile("s_waitcnt vmcnt(0)" ::: "memory");
        }
    }
    __syncthreads();
}

struct EpiProj {
    static constexpr bool PERM = true, AFTER_DRAIN = false;
    bf16_t* Q0; float* LOGF; const float* tab;
    __device__ __forceinline__ void operator()(const f32x4 (&acc)[2][2][4][2], const Unit& u, int wr, int wc, int fr, int fq) const {
        const int seg = u.pn >> 1;
        const int cseg = (u.pn & 1) * 256 + wc * 32 + 8 * fq;
        const int row0 = u.pm * 256 + wr * 64 + fr;
        if (seg == 1 || seg == 2) {
            const int dir = seg - 1;
#pragma unroll
            for (int bj = 0; bj < 2; ++bj) {
                const int c = cseg + bj * 128;
                const f32x4 ta0 = *(const f32x4*)(tab + dir * 512 + c), ta1 = *(const f32x4*)(tab + dir * 512 + c + 4);
                const f32x4 tb0 = *(const f32x4*)(tab + 1024 + dir * 512 + c), tb1 = *(const f32x4*)(tab + 1024 + dir * 512 + c + 4);
                f32x4 lb0, lb1;
#pragma unroll
                for (int e = 0; e < 4; ++e) { lb0[e] = 1.0f / (1.0f + __expf(tb0[e] - ta0[e])); lb1[e] = 1.0f / (1.0f + __expf(tb1[e] - ta1[e])); }
#pragma unroll
                for (int ai = 0; ai < 2; ++ai)
#pragma unroll
                    for (int m = 0; m < 4; ++m) {
                        float* dst = LOGF + (size_t)(row0 + ai * 128 + m * 16) * 1024 + dir * 512 + c;
                        const f32x4 z0 = acc[ai][bj][m][0], z1 = acc[ai][bj][m][1]; f32x4 o0, o1;
#pragma unroll
                        for (int e = 0; e < 4; ++e) {
                            const float s0 = 1.0f / (1.0f + __expf(-z0[e])), s1 = 1.0f / (1.0f + __expf(-z1[e]));
                            o0[e] = __logf(lb0[e] + (1.0f - lb0[e]) * s0); o1[e] = __logf(lb1[e] + (1.0f - lb1[e]) * s1);
                        }
                        *(f32x4*)dst = o0; *(f32x4*)(dst + 4) = o1;
                    }
            }
        } else {
            bf16_t* base = Q0 + (size_t)(seg == 0 ? 0 : seg - 2) * ((size_t)M * 512);
            const float sc = seg == 0 ? 0.08838834764831845f : 1.0f;
#pragma unroll
            for (int bj = 0; bj < 2; ++bj) {
                const int c = cseg + bj * 128;
#pragma unroll
                for (int ai = 0; ai < 2; ++ai)
#pragma unroll
                    for (int m = 0; m < 4; ++m) {
                        f32x4 v0 = acc[ai][bj][m][0], v1 = acc[ai][bj][m][1];
                        if (seg == 4) {
#pragma unroll
                            for (int e = 0; e < 4; ++e) { v0[e] = v0[e] / (1.0f + __expf(-v0[e])); v1[e] = v1[e] / (1.0f + __expf(-v1[e])); }
                        } else { v0 = v0 * sc; v1 = v1 * sc; }
                        u32x4 w; w.x = cvt_pk_bf16(v0[0], v0[1]); w.y = cvt_pk_bf16(v0[2], v0[3]); w.z = cvt_pk_bf16(v1[0], v1[1]); w.w = cvt_pk_bf16(v1[2], v1[3]);
                        *(u32x4*)(base + (size_t)(row0 + ai * 128 + m * 16) * 512 + c) = w;
                    }
            }
        }
    }
};
struct EpiYt {
    static constexpr bool PERM = true, AFTER_DRAIN = false;
    bf16_t* Yt;
    __device__ __forceinline__ void operator()(const f32x4 (&acc)[2][2][4][2], const Unit& u, int wr, int wc, int fr, int fq) const {
        const int row0 = u.pm * 256 + wr * 64 + fr, tok0 = u.pn * 256 + wc * 32 + 8 * fq;
#pragma unroll
        for (int ai = 0; ai < 2; ++ai)
#pragma unroll
            for (int m = 0; m < 4; ++m) {
                const int f = row0 + ai * 128 + m * 16, cs = f >> 9, n_ = f & 511;
#pragma unroll
                for (int bj = 0; bj < 2; ++bj) {
                    const int tok = tok0 + bj * 128, b = tok >> 11, t = tok & 2047;
                    const f32x4 v0 = acc[ai][bj][m][0], v1 = acc[ai][bj][m][1];
                    u32x4 w; w.x = cvt_pk_bf16(v0[0], v0[1]); w.y = cvt_pk_bf16(v0[2], v0[3]); w.z = cvt_pk_bf16(v1[0], v1[1]); w.w = cvt_pk_bf16(v1[2], v1[3]);
                    *(u32x4*)(Yt + ((size_t)(b * 512 + n_) * 2 + cs) * 2048 + t) = w;
                }
            }
    }
};
struct EpiFnet {
    static constexpr bool PERM = true, AFTER_DRAIN = false;
    bf16_t* ACAT;
    __device__ __forceinline__ void operator()(const f32x4 (&acc)[2][2][4][2], const Unit& u, int wr, int wc, int fr, int fq) const {
        const int row0 = u.pm * 256 + wr * 64 + fr, col0 = u.pn * 256 + wc * 32 + 8 * fq;
#pragma unroll
        for (int ai = 0; ai < 2; ++ai)
#pragma unroll
            for (int m = 0; m < 4; ++m) {
                const int k1 = row0 + ai * 128 + m * 16;
#pragma unroll
                for (int bj = 0; bj < 2; ++bj) {
                    const int c = col0 + bj * 128, b = c >> 9, n_ = c & 511;
                    const f32x4 v0 = acc[ai][bj][m][0], v1 = acc[ai][bj][m][1];
                    u32x4 w; w.x = cvt_pk_bf16(v0[0], v0[1]); w.y = cvt_pk_bf16(v0[2], v0[3]); w.z = cvt_pk_bf16(v1[0], v1[1]); w.w = cvt_pk_bf16(v1[2], v1[3]);
                    *(u32x4*)(ACAT + (size_t)(b * 2048 + k1) * 1024 + 512 + n_) = w;
                }
            }
    }
};
struct EpiF32 {
    static constexpr bool PERM = false, AFTER_DRAIN = false;
    float* O; int ldc;
    __device__ __forceinline__ void operator()(const f32x4 (&acc)[2][2][4][2], const Unit& u, int wr, int wc, int fr, int fq) const {
        const int row0 = u.pm * 256 + wr * 64 + fr, col0 = u.pn * 256 + wc * 32 + 4 * fq;
#pragma unroll
        for (int ai = 0; ai < 2; ++ai)
#pragma unroll
            for (int m = 0; m < 4; ++m) {
                float* rowp = O + (size_t)(row0 + ai * 128 + m * 16) * ldc + col0;
#pragma unroll
                for (int bj = 0; bj < 2; ++bj)
#pragma unroll
                    for (int n = 0; n < 2; ++n) *(f32x4*)(rowp + bj * 128 + n * 16) = acc[ai][bj][m][n];
            }
    }
};
struct EpiSwiglu {
    static constexpr bool PERM = true, AFTER_DRAIN = false;
    bf16_t* H;
    __device__ __forceinline__ void operator()(const f32x4 (&acc)[2][2][4][2], const Unit& u, int wr, int wc, int fr, int fq) const {
        const int row0 = u.pm * 256 + wr * 64 + fr, col0 = u.pn * 128 + wc * 32 + 8 * fq;
#pragma unroll
        for (int ai = 0; ai < 2; ++ai)
#pragma unroll
            for (int m = 0; m < 4; ++m) {
                float h[8];
#pragma unroll
                for (int n = 0; n < 2; ++n)
#pragma unroll
                    for (int e = 0; e < 4; ++e) { const float a = acc[ai][0][m][n][e], b = acc[ai][1][m][n][e]; h[4 * n + e] = a / (1.0f + __expf(-a)) * b; }
                u32x4 w; w.x = cvt_pk_bf16(h[0], h[1]); w.y = cvt_pk_bf16(h[2], h[3]); w.z = cvt_pk_bf16(h[4], h[5]); w.w = cvt_pk_bf16(h[6], h[7]);
                *(u32x4*)(H + (size_t)(row0 + ai * 128 + m * 16) * FF + col0) = w;
            }
    }
};
struct EpiQKV {
    static constexpr bool PERM = true, AFTER_DRAIN = false;
    bf16_t* O;
    __device__ __forceinline__ void operator()(const f32x4 (&acc)[2][2][4][2], const Unit& u, int wr, int wc, int fr, int fq) const {
        const int row0 = u.pm * 256 + wr * 64 + fr, col0 = u.pn * 256 + wc * 32 + 8 * fq;
        const float sc = u.pn < 4 ? 0.125f * LOG2E : 1.0f;
#pragma unroll
        for (int ai = 0; ai < 2; ++ai)
#pragma unroll
            for (int m = 0; m < 4; ++m)
#pragma unroll
                for (int bj = 0; bj < 2; ++bj) {
                    const f32x4 v0 = acc[ai][bj][m][0] * sc, v1 = acc[ai][bj][m][1] * sc;
                    u32x4 w; w.x = cvt_pk_bf16(v0[0], v0[1]); w.y = cvt_pk_bf16(v0[2], v0[3]); w.z = cvt_pk_bf16(v1[0], v1[1]); w.w = cvt_pk_bf16(v1[2], v1[3]);
                    *(u32x4*)(O + (size_t)(row0 + ai * 128 + m * 16) * 1536 + col0 + bj * 128) = w;
                }
    }
};

__device__ __forceinline__ void transpose_item(const float* W, int ldw, int K, bf16_t* WT, int k0, int n0src, int dst_row0, LAS float* scr, int lane) {
#pragma unroll 8
    for (int i = 0; i < 32; ++i) { const int kk = 2 * i + (lane >> 5); scr[kk * 33 + (lane & 31)] = W[(size_t)(k0 + kk) * ldw + n0src + (lane & 31)]; }
    LDS_WAIT();
    const int c = lane & 7;
#pragma unroll
    for (int j = 0; j < 4; ++j) {
        const int n = (lane >> 3) + 8 * j; const LAS float* s = scr + (8 * c) * 33 + n;
        u32x4 o; o.x = cvt_pk_bf16(s[0 * 33], s[1 * 33]); o.y = cvt_pk_bf16(s[2 * 33], s[3 * 33]); o.z = cvt_pk_bf16(s[4 * 33], s[5 * 33]); o.w = cvt_pk_bf16(s[6 * 33], s[7 * 33]);
        *(u32x4*)(WT + (size_t)(dst_row0 + n) * K + k0 + 8 * c) = o;
    }
    LDS_WAIT();
}
__device__ __forceinline__ void rms_row_to_bf16(const float* xrow, const float* gain, bf16_t* orow, int lane) {
    f32x4 v[4]; float ss = 0.f;
#pragma unroll
    for (int j = 0; j < 4; ++j) { v[j] = ((const f32x4*)xrow)[lane + 64 * j]; ss += (v[j].x * v[j].x + v[j].y * v[j].y) + (v[j].z * v[j].z + v[j].w * v[j].w); }
    const float r = rsqrtf(wave_sum(ss) * (1.0f / D) + EPS);
#pragma unroll
    for (int j = 0; j < 4; ++j) {
        const f32x4 g = ((const f32x4*)gain)[lane + 64 * j]; const f32x4 o = v[j] * r * g;
        u32x2 w; w.x = cvt_pk_bf16(o.x, o.y); w.y = cvt_pk_bf16(o.z, o.w);
        ((u32x2*)orow)[lane + 64 * j] = w;
    }
}
__device__ __forceinline__ void postnorm_rows(const float* xin, float* xout, const float* mbuf, const float* g_post, const float* g_pre, bf16_t* XN, int gw, int ngw, int lane) {
    for (int row = gw; row < M; row += ngw) {
        const f32x4* mr = (const f32x4*)(mbuf + (size_t)row * D); const f32x4* xr = (const f32x4*)(xin + (size_t)row * D);
        f32x4 mv[4], xv[4]; float ss = 0.f;
#pragma unroll
        for (int j = 0; j < 4; ++j) { mv[j] = mr[lane + 64 * j]; xv[j] = xr[lane + 64 * j]; ss += (mv[j].x * mv[j].x + mv[j].y * mv[j].y) + (mv[j].z * mv[j].z + mv[j].w * mv[j].w); }
        const float r = rsqrtf(wave_sum(ss) * (1.0f / D) + EPS);
        float ss2 = 0.f;
#pragma unroll
        for (int j = 0; j < 4; ++j) {
            const f32x4 g = ((const f32x4*)g_post)[lane + 64 * j];
            xv[j] = xv[j] + mv[j] * r * g;
            ((f32x4*)(xout + (size_t)row * D))[lane + 64 * j] = xv[j];
            ss2 += (xv[j].x * xv[j].x + xv[j].y * xv[j].y) + (xv[j].z * xv[j].z + xv[j].w * xv[j].w);
        }
        if (g_pre) {
            const float r2 = rsqrtf(wave_sum(ss2) * (1.0f / D) + EPS);
#pragma unroll
            for (int j = 0; j < 4; ++j) {
                const f32x4 g = ((const f32x4*)g_pre)[lane + 64 * j]; const f32x4 o = xv[j] * r2 * g;
                u32x2 w; w.x = cvt_pk_bf16(o.x, o.y); w.y = cvt_pk_bf16(o.z, o.w);
                ((u32x2*)(XN + (size_t)row * D))[lane + 64 * j] = w;
            }
        }
    }
}

constexpr int HG_G = 0, HG_QR = 16384, HG_KR = HG_QR + 8704, HG_QIN = HG_KR + 8704, HG_KO = HG_QIN + 8704, HG_V = HG_KO + 8704, HG_STB = HG_V + 32 * 72 * 2, HG_END = HG_STB + 2 * 64 * 136 * 2;
static_assert(HG_END <= 131072, "hgrn lds");
__device__ __forceinline__ bf16x8 gather8(const LAS bf16_t* p, int stride) {
    unsigned a0 = p[0], a1 = p[stride], a2 = p[2 * stride], a3 = p[3 * stride], a4 = p[4 * stride], a5 = p[5 * stride], a6 = p[6 * stride], a7 = p[7 * stride];
    u32x4 w; w.x = a0 | (a1 << 16); w.y = a2 | (a3 << 16); w.z = a4 | (a5 << 16); w.w = a6 | (a7 << 16);
    return __builtin_bit_cast(bf16x8, w);
}
__device__ __forceinline__ bf16x8 gather8p(const LAS bf16_t* p, int stride) {
    unsigned a0 = p[0], a1 = p[stride], a2 = p[2 * stride], a3 = p[3 * stride], a4 = p[8 * stride], a5 = p[9 * stride], a6 = p[10 * stride], a7 = p[11 * stride];
    u32x4 w; w.x = a0 | (a1 << 16); w.y = a2 | (a3 << 16); w.z = a4 | (a5 << 16); w.w = a6 | (a7 << 16);
    return __builtin_bit_cast(bf16x8, w);
}
__device__ __forceinline__ bf16x8 pack8(const f32x16& p, int s) {
    u32x4 w;
    if (s == 0) { w.x = cvt_pk_bf16(p[0], p[1]); w.y = cvt_pk_bf16(p[2], p[3]); w.z = cvt_pk_bf16(p[4], p[5]); w.w = cvt_pk_bf16(p[6], p[7]); }
    else        { w.x = cvt_pk_bf16(p[8], p[9]); w.y = cvt_pk_bf16(p[10], p[11]); w.z = cvt_pk_bf16(p[12], p[13]); w.w = cvt_pk_bf16(p[14], p[15]); }
    return __builtin_bit_cast(bf16x8, w);
}

__device__ __forceinline__ void hgrn_unit(LAS unsigned char* lds, int unit, const bf16_t* Q0, const float* LOGF, const bf16_t* V0, bf16_t* OFB) {
    const int vs = unit & 1, dir = (unit >> 1) & 1, h = (unit >> 2) & 3, b = unit >> 4;
    const int tid = threadIdx.x, lane = tid & 63, wave = __builtin_amdgcn_readfirstlane(tid >> 6), l31 = lane & 31, hi = lane >> 5;
    LAS float* G = (LAS float*)(lds + HG_G);
    LAS bf16_t* QR = (LAS bf16_t*)(lds + HG_QR);
    LAS bf16_t* KR = (LAS bf16_t*)(lds + HG_KR);
    LAS bf16_t* QIN = (LAS bf16_t*)(lds + HG_QIN);
    LAS bf16_t* KO = (LAS bf16_t*)(lds + HG_KO);
    LAS bf16_t* VL = (LAS bf16_t*)(lds + HG_V);
    LAS bf16_t* STB = (LAS bf16_t*)(lds + HG_STB);
    const int r = tid >> 4, k0 = (tid & 15) * 8, v0 = (tid & 15) * 4;
    const int vt = wave >> 2, kt = wave & 3;
    for (int i = tid; i < 64 * 136 / 2; i += 512) ((LAS unsigned*)STB)[i] = 0u;
    f32x16 ST;
#pragma unroll
    for (int i = 0; i < 16; ++i) ST[i] = 0.f;
    const size_t tokb = (size_t)b * T;
    f32x4 nlf0, nlf1; u32x4 nq; u32x2 nv;
    {
        const int c = dir ? 63 : 0; const size_t tok = tokb + c * 32 + (dir ? 31 - r : r);
        const float* lp = LOGF + tok * 1024 + dir * 512 + h * 128 + k0; nlf0 = *(const f32x4*)lp; nlf1 = *(const f32x4*)(lp + 4);
        nq = *(const u32x4*)(Q0 + tok * 512 + h * 128 + k0);
        nv = *(const u32x2*)(V0 + tok * 512 + h * 128 + vs * 64 + v0);
    }
    int cur = 0;
    for (int ci = 0; ci < 64; ++ci) {
        const int c = dir ? 63 - ci : ci;
        const size_t base = tokb + (size_t)c * 32;
        float lf[8] = {nlf0.x, nlf0.y, nlf0.z, nlf0.w, nlf1.x, nlf1.y, nlf1.z, nlf1.w};
        const u32x4 qraw = nq;
        float kk[8];
#pragma unroll
        for (int j = 0; j < 8; ++j) kk[j] = 1.0f - __expf(lf[j]);
        *(LAS f32x4*)(G + r * 128 + k0) = nlf0; *(LAS f32x4*)(G + r * 128 + k0 + 4) = nlf1;
        *(LAS u32x2*)(VL + r * 72 + v0) = nv;
        if (ci + 1 < 64) {
            const int c2 = dir ? 62 - ci : ci + 1; const size_t tok = tokb + c2 * 32 + (dir ? 31 - r : r);
            const float* lp = LOGF + tok * 1024 + dir * 512 + h * 128 + k0; nlf0 = *(const f32x4*)lp; nlf1 = *(const f32x4*)(lp + 4);
            nq = *(const u32x4*)(Q0 + tok * 512 + h * 128 + k0);
            nv = *(const u32x2*)(V0 + tok * 512 + h * 128 + vs * 64 + v0);
        }
        __syncthreads();
        if (tid < 128) {
            float a = 0.f;
#pragma unroll
            for (int t = 0; t < 32; ++t) { a += G[t * 128 + tid]; G[t * 128 + tid] = a; }
        }
        __syncthreads();
        {
            float g[8], gr[8], gl[8];
            { const f32x4 a0 = *(LAS f32x4*)(G + r * 128 + k0), a1 = *(LAS f32x4*)(G + r * 128 + k0 + 4);
              const f32x4 b0 = *(LAS f32x4*)(G + 15 * 128 + k0), b1 = *(LAS f32x4*)(G + 15 * 128 + k0 + 4);
              const f32x4 c0 = *(LAS f32x4*)(G + 31 * 128 + k0), c1 = *(LAS f32x4*)(G + 31 * 128 + k0 + 4);
#pragma unroll
              for (int j = 0; j < 4; ++j) { g[j] = a0[j]; g[4 + j] = a1[j]; gr[j] = b0[j]; gr[4 + j] = b1[j]; gl[j] = c0[j]; gl[4 + j] = c1[j]; } }
            float q[8];
            q[0] = bf2f((unsigned short)(qraw.x & 0xffff)); q[1] = bf2f((unsigned short)(qraw.x >> 16));
            q[2] = bf2f((unsigned short)(qraw.y & 0xffff)); q[3] = bf2f((unsigned short)(qraw.y >> 16));
            q[4] = bf2f((unsigned short)(qraw.z & 0xffff)); q[5] = bf2f((unsigned short)(qraw.z >> 16));
            q[6] = bf2f((unsigned short)(qraw.w & 0xffff)); q[7] = bf2f((unsigned short)(qraw.w >> 16));
            float qr[8], kr[8], qi[8], ko[8];
#pragma unroll
            for (int j = 0; j < 8; ++j) {
                qr[j] = q[j] * __expf(g[j] - gr[j]); kr[j] = kk[j] * __expf(gr[j] - g[j]);
                qi[j] = q[j] * __expf(g[j]);         ko[j] = kk[j] * __expf(gl[j] - g[j]);
            }
            u32x4 w;
            w.x = cvt_pk_bf16(qr[0], qr[1]); w.y = cvt_pk_bf16(qr[2], qr[3]); w.z = cvt_pk_bf16(qr[4], qr[5]); w.w = cvt_pk_bf16(qr[6], qr[7]); *(LAS u32x4*)(QR + r * 136 + k0) = w;
            w.x = cvt_pk_bf16(kr[0], kr[1]); w.y = cvt_pk_bf16(kr[2], kr[3]); w.z = cvt_pk_bf16(kr[4], kr[5]); w.w = cvt_pk_bf16(kr[6], kr[7]); *(LAS u32x4*)(KR + r * 136 + k0) = w;
            w.x = cvt_pk_bf16(qi[0], qi[1]); w.y = cvt_pk_bf16(qi[2], qi[3]); w.z = cvt_pk_bf16(qi[4], qi[5]); w.w = cvt_pk_bf16(qi[6], qi[7]); *(LAS u32x4*)(QIN + r * 136 + k0) = w;
            w.x = cvt_pk_bf16(ko[0], ko[1]); w.y = cvt_pk_bf16(ko[2], ko[3]); w.z = cvt_pk_bf16(ko[4], ko[5]); w.w = cvt_pk_bf16(ko[6], ko[7]); *(LAS u32x4*)(KO + r * 136 + k0) = w;
        }
        __syncthreads();
        if (wave < 2) {
            const int ot = wave;
            f32x16 p;
#pragma unroll
            for (int i = 0; i < 16; ++i) p[i] = 0.f;
#pragma unroll
            for (int ks = 0; ks < 8; ++ks) {
                const bf16x8 a = *(const LAS bf16x8*)(KR + l31 * 136 + 16 * ks + 8 * hi);
                const bf16x8 bq = *(const LAS bf16x8*)(QR + l31 * 136 + 16 * ks + 8 * hi);
                p = MFMA32(a, bq, p);
            }
#pragma unroll
            for (int i = 0; i < 16; ++i) { if (crow(i, hi) > l31) p[i] = 0.f; }
            const bf16x8 pf0 = pack8(p, 0), pf1 = pack8(p, 1);
            f32x16 o;
#pragma unroll
            for (int i = 0; i < 16; ++i) o[i] = 0.f;
            { const bf16x8 a0 = gather8p(VL + (4 * hi) * 72 + ot * 32 + l31, 72); o = MFMA32(a0, pf0, o);
              const bf16x8 a1 = gather8p(VL + (16 + 4 * hi) * 72 + ot * 32 + l31, 72); o = MFMA32(a1, pf1, o); }
            const LAS bf16_t* stb = STB + cur * (64 * 136);
#pragma unroll
            for (int ks = 0; ks < 8; ++ks) {
                const bf16x8 a = *(const LAS bf16x8*)(stb + (ot * 32 + l31) * 136 + 16 * ks + 8 * hi);
                const bf16x8 bq = *(const LAS bf16x8*)(QIN + l31 * 136 + 16 * ks + 8 * hi);
                o = MFMA32(a, bq, o);
            }
            const size_t tok = base + (dir ? 31 - l31 : l31);
            bf16_t* op = OFB + ((size_t)dir * M + tok) * 512 + h * 128 + vs * 64 + ot * 32 + 4 * hi;
#pragma unroll
            for (int g4 = 0; g4 < 4; ++g4) { u32x2 w; w.x = cvt_pk_bf16(o[4 * g4], o[4 * g4 + 1]); w.y = cvt_pk_bf16(o[4 * g4 + 2], o[4 * g4 + 3]); *(u32x2*)(op + 8 * g4) = w; }
        }
        {
            const float dec = __expf(G[31 * 128 + kt * 32 + l31]);
#pragma unroll
            for (int i = 0; i < 16; ++i) ST[i] *= dec;
#pragma unroll
            for (int st = 0; st < 2; ++st) {
                const bf16x8 a = gather8(VL + (16 * st + 8 * hi) * 72 + vt * 32 + l31, 72);
                const bf16x8 bk = gather8(KO + (16 * st + 8 * hi) * 136 + kt * 32 + l31, 136);
                ST = MFMA32(a, bk, ST);
            }
            LAS bf16_t* stn = STB + (cur ^ 1) * (64 * 136);
#pragma unroll
            for (int i = 0; i < 16; ++i) stn[(vt * 32 + crow(i, hi)) * 136 + kt * 32 + l31] = (bf16_t)f2bf(ST[i]);
        }
        __syncthreads();
        cur ^= 1;
    }
}

constexpr int AT_K = 0, AT_V = 384 * 72 * 2, AT_END = 2 * 384 * 72 * 2;
static_assert(AT_END <= 131072, "attn lds");
__device__ __forceinline__ void attn_unit(LAS unsigned char* lds, int unit, const bf16_t* QKV, const float* sink, bf16_t* OUT) {
    const int qb = unit & 15, kv = (unit >> 4) & 3, b = unit >> 6;
    const int tid = threadIdx.x, lane = tid & 63, wave = __builtin_amdgcn_readfirstlane(tid >> 6), l31 = lane & 31, hi = lane >> 5;
    LAS bf16_t* KL = (LAS bf16_t*)(lds + AT_K);
    LAS bf16_t* VL = (LAS bf16_t*)(lds + AT_V);
    const int Q0p = qb * 128, kbase = Q0p - 128;
    const size_t tokb = (size_t)b * T;
#pragma unroll
    for (int it = 0; it < 6; ++it) {
        const int idx = tid + it * 512, row = idx >> 3, c8 = idx & 7, pos = kbase + row;
        u32x4 kx = {0u, 0u, 0u, 0u}, vx = {0u, 0u, 0u, 0u};
        if (pos >= 0 && pos < T) {
            const bf16_t* p = QKV + (tokb + pos) * 1536 + kv * 64 + c8 * 8;
            kx = *(const u32x4*)(p + 1024); vx = *(const u32x4*)(p + 1280);
        }
        *(LAS u32x4*)(KL + row * 72 + c8 * 8) = kx; *(LAS u32x4*)(VL + row * 72 + c8 * 8) = vx;
    }
    __syncthreads();
    const int g = wave >> 1, hh = kv * 4 + g, half = wave & 1;
    const float slope2 = exp2f(-0.5f * (float)(hh + 1)) * LOG2E, sink2 = sink[hh] * LOG2E;
    for (int qt = 0; qt < 2; ++qt) {
        const int q0l = half * 64 + qt * 32, qpos = Q0p + q0l + l31;
        bf16x8 qf[4];
        { const bf16_t* qp = QKV + (tokb + qpos) * 1536 + hh * 64 + 8 * hi;
#pragma unroll
          for (int s = 0; s < 4; ++s) qf[s] = *(const bf16x8*)(qp + 16 * s); }
        float mrun = sink2, lsum = hi == 0 ? 1.0f : 0.0f;
        f32x16 o0, o1;
#pragma unroll
        for (int i = 0; i < 16; ++i) { o0[i] = 0.f; o1[i] = 0.f; }
        for (int kt = 0; kt < 9; ++kt) {
            const int krow0 = q0l + 32 * kt, kpos0 = kbase + krow0;
            if (kpos0 + 31 < 0 || kpos0 >= T) continue;
            f32x16 s;
#pragma unroll
            for (int i = 0; i < 16; ++i) s[i] = 0.f;
#pragma unroll
            for (int ks = 0; ks < 4; ++ks) {
                const bf16x8 a = *(const LAS bf16x8*)(KL + (krow0 + l31) * 72 + 16 * ks + 8 * hi);
                s = MFMA32(a, qf[ks], s);
            }
            float tmax = -INFINITY;
#pragma unroll
            for (int i = 0; i < 16; ++i) {
                const int kpos = kpos0 + crow(i, hi); const int dist = qpos > kpos ? qpos - kpos : kpos - qpos;
                const bool valid = dist <= 128 && kpos >= 0 && kpos < T;
                const float sv = valid ? s[i] - slope2 * (float)dist : -INFINITY;
                s[i] = sv; tmax = fmaxf(tmax, sv);
            }
            tmax = fmaxf(tmax, __shfl_xor(tmax, 32));
            const float mnew = fmaxf(mrun, tmax), alpha = exp2f(mrun - mnew);
            mrun = mnew; lsum *= alpha;
#pragma unroll
            for (int i = 0; i < 16; ++i) { o0[i] *= alpha; o1[i] *= alpha; }
            float ps = 0.f;
#pragma unroll
            for (int i = 0; i < 16; ++i) { const float pe = exp2f(s[i] - mnew); s[i] = pe; ps += pe; }
            lsum += ps;
            const bf16x8 pf0 = pack8(s, 0), pf1 = pack8(s, 1);
            { const bf16x8 a = gather8p(VL + (krow0 + 4 * hi) * 72 + l31, 72); o0 = MFMA32(a, pf0, o0); }
            { const bf16x8 a = gather8p(VL + (krow0 + 4 * hi) * 72 + 32 + l31, 72); o1 = MFMA32(a, pf0, o1); }
            { const bf16x8 a = gather8p(VL + (krow0 + 16 + 4 * hi) * 72 + l31, 72); o0 = MFMA32(a, pf1, o0); }
            { const bf16x8 a = gather8p(VL + (krow0 + 16 + 4 * hi) * 72 + 32 + l31, 72); o1 = MFMA32(a, pf1, o1); }
        }
        const float ltot = lsum + __shfl_xor(lsum, 32), inv = 1.0f / ltot;
        bf16_t* op = OUT + (tokb + qpos) * 1024 + hh * 64 + 4 * hi;
#pragma unroll
        for (int g4 = 0; g4 < 4; ++g4) {
            u32x2 w; w.x = cvt_pk_bf16(o0[4 * g4] * inv, o0[4 * g4 + 1] * inv); w.y = cvt_pk_bf16(o0[4 * g4 + 2] * inv, o0[4 * g4 + 3] * inv); *(u32x2*)(op + 8 * g4) = w;
            u32x2 w2; w2.x = cvt_pk_bf16(o1[4 * g4] * inv, o1[4 * g4 + 1] * inv); w2.y = cvt_pk_bf16(o1[4 * g4 + 2] * inv, o1[4 * g4 + 3] * inv); *(u32x2*)(op + 32 + 8 * g4) = w2;
        }
    }
    __syncthreads();
}

struct Args { const float* in[12]; float* out; unsigned char* ws; };

__device__ __forceinline__ void prologue(const Args& a, LAS unsigned char* lds, int gw, int ngw, int wave, int lane) {
    unsigned char* ws = a.ws;
    LAS float* scr = (LAS float*)(lds + wave * 16384);
    const float* w_in = a.in[2];
    constexpr int I_WCS = 256, I_DFT = 2048, I_T1 = 16 * 80, I_T2 = 16 * 32, I_T3 = 16 * 48, I_T4 = 16 * 32, I_T5 = 2 * 16 * 88, I_T6 = I_T5, I_T7 = 2 * 44 * 32;
    constexpr int NITEMS = I_WCS + I_DFT + I_T1 + I_T2 + I_T3 + I_T4 + I_T5 + I_T6 + I_T7;
    for (int it0 = gw; it0 < NITEMS; it0 += ngw) {
        int it = it0;
        if (it < I_WCS) {
            const int g = it >> 6, k0 = (it & 63) * 16;
#pragma unroll 4
            for (int i = 0; i < 32; ++i) { const int idx = i * 64 + lane, kk = idx >> 7, c = idx & 127; scr[kk * 128 + c] = w_in[(size_t)(k0 + kk) * 3072 + 2560 + g * 128 + c]; }
            LDS_WAIT();
            bf16_t* Wcs = (bf16_t*)(ws + WS_WCS);
            for (int pass = 0; pass < 2; ++pass) {
                const int k2 = lane + 64 * pass;
                float ac[16], as[16];
#pragma unroll
                for (int kk = 0; kk < 16; ++kk) { ac[kk] = 0.f; as[kk] = 0.f; }
                for (int c = 0; c < 128; ++c) {
                    const float ph = (float)((k2 * c) & 127) * (1.0f / 128.0f);
                    const float cc = __builtin_amdgcn_cosf(ph), sn = __builtin_amdgcn_sinf(ph);
#pragma unroll
                    for (int kk = 0; kk < 16; ++kk) { const float w = scr[kk * 128 + c]; ac[kk] += w * cc; as[kk] += w * sn; }
                }
                u32x4 o0, o1;
                o0.x = cvt_pk_bf16(ac[0], ac[1]); o0.y = cvt_pk_bf16(ac[2], ac[3]); o0.z = cvt_pk_bf16(ac[4], ac[5]); o0.w = cvt_pk_bf16(ac[6], ac[7]);
                o1.x = cvt_pk_bf16(ac[8], ac[9]); o1.y = cvt_pk_bf16(ac[10], ac[11]); o1.z = cvt_pk_bf16(ac[12], ac[13]); o1.w = cvt_pk_bf16(ac[14], ac[15]);
                bf16_t* d0 = Wcs + (size_t)(g * 128 + k2) * 1024 + k0; *(u32x4*)d0 = o0; *(u32x4*)(d0 + 8) = o1;
                o0.x = cvt_pk_bf16(as[0], as[1]); o0.y = cvt_pk_bf16(as[2], as[3]); o0.z = cvt_pk_bf16(as[4], as[5]); o0.w = cvt_pk_bf16(as[6], as[7]);
                o1.x = cvt_pk_bf16(as[8], as[9]); o1.y = cvt_pk_bf16(as[10], as[11]); o1.z = cvt_pk_bf16(as[12], as[13]); o1.w = cvt_pk_bf16(as[14], as[15]);
                bf16_t* d1 = Wcs + (size_t)(512 + g * 128 + k2) * 1024 + k0; *(u32x4*)d1 = o0; *(u32x4*)(d1 + 8) = o1;
            }
            LDS_WAIT();
            continue;
        }
        it -= I_WCS;
        if (it < I_DFT) {
            const int k1 = it; bf16_t* dr = (bf16_t*)(ws + WS_DFT) + (size_t)k1 * 4096;
#pragma unroll 2
            for (int i = 0; i < 8; ++i) {
                const int col0 = (i * 64 + lane) * 8, cs = col0 >> 11;
                float v[8];
#pragma unroll
                for (int j = 0; j < 8; ++j) {
                    const int t = (col0 + j) & 2047; const float ph = (float)((k1 * t) & 2047) * (1.0f / 2048.0f);
                    v[j] = (cs ? -__builtin_amdgcn_sinf(ph) : __builtin_amdgcn_cosf(ph)) * (1.0f / 512.0f);
                }
                u32x4 o; o.x = cvt_pk_bf16(v[0], v[1]); o.y = cvt_pk_bf16(v[2], v[3]); o.z = cvt_pk_bf16(v[4], v[5]); o.w = cvt_pk_bf16(v[6], v[7]);
                *(u32x4*)(dr + col0) = o;
            }
            continue;
        }
        it -= I_DFT;
        if (it < I_T1) { const int kb = it / 80, nb = it % 80; transpose_item(w_in, 3072, 1024, (bf16_t*)(ws + WS_WP), kb * 64, nb * 32, nb * 32, scr, lane); continue; }
        it -= I_T1;
        if (it < I_T2) { const int kb = it / 32, nb = it % 32; transpose_item(a.in[5], 1024, 1024, (bf16_t*)(ws + WS_WO0), kb * 64, nb * 32, nb * 32, scr, lane); continue; }
        it -= I_T2;
        if (it < I_T3) { const int kb = it / 48, nb = it % 48; transpose_item(a.in[6], 1536, 1024, (bf16_t*)(ws + WS_WQKV), kb * 64, nb * 32, nb * 32, scr, lane); continue; }
        it -= I_T3;
        if (it < I_T4) { const int kb = it / 32, nb = it % 32; transpose_item(a.in[8], 1024, 1024, (bf16_t*)(ws + WS_WO1), kb * 64, nb * 32, nb * 32, scr, lane); continue; }
        it -= I_T4;
        if (it < I_T5 + I_T6) {
            const int which = it >= I_T5; if (which) it -= I_T5;
            const int layer = it / (16 * 88); it -= layer * (16 * 88);
            const int kb = it / 88, nb = it % 88, n0 = nb * 32;
            const float* src = (which ? a.in[10] : a.in[9]) + (size_t)layer * 1024 * FF;
            transpose_item(src, FF, 1024, (bf16_t*)(ws + WS_W13) + (size_t)layer * W13_STRIDE, kb * 64, n0, 256 * (n0 >> 7) + 128 * which + (n0 & 127), scr, lane); continue;
        }
        it -= I_T5 + I_T6;
        { const int layer = it / (44 * 32); it -= layer * (44 * 32);
          const int kb = it / 32, nb = it % 32;
          transpose_item(a.in[11] + (size_t)layer * FF * 1024, 1024, FF, (bf16_t*)(ws + WS_W2) + (size_t)layer * W2_STRIDE, kb * 64, nb * 32, nb * 32, scr, lane); }
    }
    for (int row = gw; row < M; row += ngw) rms_row_to_bf16(a.in[0] + (size_t)row * D, a.in[1], (bf16_t*)(ws + WS_XN) + (size_t)row * D, lane);
}

#ifndef PHMASK
#define PHMASK 0xffff
#endif
#ifndef REP_HGRN
#define REP_HGRN 1
#endif
#ifndef REP_SYNC
#define REP_SYNC 1
#endif
#ifndef REP_PRO
#define REP_PRO 1
#endif
#ifndef REP_ATTN
#define REP_ATTN 1
#endif
#ifndef REP_FNET
#define REP_FNET 1
#endif
#define GSYNC() do { for (int r_ = 0; r_ < REP_SYNC; ++r_) xcd_barrier(xbar); } while (0)

__global__ void __launch_bounds__(512, 2) fwd_megakernel(Args a) {
    extern __shared__ __attribute__((aligned(16))) unsigned char lds_raw[];
    LAS unsigned char* lds = (LAS unsigned char*)lds_raw;
    cg::grid_group grid = cg::this_grid();
    const int tid = threadIdx.x, lane = tid & 63, wave = __builtin_amdgcn_readfirstlane(tid >> 6);
    const int G = gridDim.x, bid = blockIdx.x, gw = bid * 8 + wave, ngw = G * 8;
    unsigned char* ws = a.ws;
    bf16_t* XN = (bf16_t*)(ws + WS_XN); float* MBUF = (float*)(ws + WS_MBUF);
    bf16_t* ACAT = (bf16_t*)(ws + WS_ACAT); bf16_t* HB = (bf16_t*)(ws + WS_H);
    float* LOGF = a.out;
    const float* gains = a.in[1];
    if (tid < 64) ((LAS unsigned*)(lds + 131072))[tid] = 0u;
    __syncthreads();
    XcdBarrier xbar = xcd_barrier_post((unsigned*)ws, (volatile LAS unsigned*)(lds + 131072 + 32));

#if PHMASK & 1
    for (int rp = 0; rp < REP_PRO; ++rp) prologue(a, lds, gw, ngw, wave, lane);
#endif
    grid.sync();

#if PHMASK & 2
    {
        pg8::Gemm g{XN, (const bf16_t*)(ws + WS_WP), M, 2560, 1024}; pg8::StaticOrder S; S.init(M, 2560, G, bid);
        EpiProj E{(bf16_t*)(ws + WS_Q0), LOGF, a.in[3]};
        static_assert(WS_V0 == WS_Q0 + (size_t)M * 512 * 2 && WS_GATE == WS_V0 + (size_t)M * 512 * 2, "Q0 | V0 | GATE consecutive");
        pg8::gemm_phase<EpiProj, pg8::StaticOrder, true, true>(lds, g, S, E);
    }
#endif
#if PHMASK & 4
    {
        pg8::Gemm g{(const bf16_t*)(ws + WS_WCS), XN, 1024, M, 1024}; pg8::StaticOrder S; S.init(1024, M, G, bid);
        EpiYt E{(bf16_t*)(ws + WS_YT)};
        pg8::gemm_phase<EpiYt, pg8::StaticOrder, true, true>(lds, g, S, E);
    }
#endif
    GSYNC();

    {
        const bool split = (G % 16) == 0;
        const bool do_f = !split || (((bid >> 3) & 1) == 0), do_h = !split || (((bid >> 3) & 1) == 1);
        const int gsz = split ? G / 2 : G, gidx = split ? (bid >> 4) * 8 + (bid & 7) : bid;
#if PHMASK & 8
        if (do_f) for (int rp = 0; rp < REP_FNET; ++rp) {
            pg8::Gemm g{(const bf16_t*)(ws + WS_DFT), (const bf16_t*)(ws + WS_YT), 2048, 4096, 4096}; pg8::StaticOrder S; S.init(2048, 4096, gsz, gidx);
            EpiFnet E{ACAT};
            pg8::gemm_phase<EpiFnet, pg8::StaticOrder, true, true>(lds, g, S, E);
        }
#endif
#if PHMASK & 16
        if (do_h) {
            for (int rp = 0; rp < REP_HGRN; ++rp) for (int u = gidx; u < 128; u += gsz) hgrn_unit(lds, u, (const bf16_t*)(ws + WS_Q0), LOGF, (const bf16_t*)(ws + WS_V0), (bf16_t*)(ws + WS_OFB));
        }
#endif
    }
    GSYNC();

    {
        const bf16_t* OFB = (const bf16_t*)(ws + WS_OFB); const bf16_t* GATE = (const bf16_t*)(ws + WS_GATE); const float* og = a.in[4];
        for (int row = gw; row < M; row += ngw) {
            const u32x4 f = *(const u32x4*)(OFB + (size_t)row * 512 + lane * 8), bw = *(const u32x4*)(OFB + ((size_t)M + row) * 512 + lane * 8), gt = *(const u32x4*)(GATE + (size_t)row * 512 + lane * 8);
            float o[8]; float ss = 0.f;
#pragma unroll
            for (int j = 0; j < 4; ++j) {
                o[2 * j] = bf2f((unsigned short)(f[j] & 0xffff)) + bf2f((unsigned short)(bw[j] & 0xffff));
                o[2 * j + 1] = bf2f((unsigned short)(f[j] >> 16)) + bf2f((unsigned short)(bw[j] >> 16));
                ss += o[2 * j] * o[2 * j] + o[2 * j + 1] * o[2 * j + 1];
            }
            ss += __shfl_xor(ss, 1); ss += __shfl_xor(ss, 2); ss += __shfl_xor(ss, 4); ss += __shfl_xor(ss, 8);
            const float r = rsqrtf(ss * (1.0f / 128.0f) + EPS);
            const f32x4 g0 = *(const f32x4*)(og + lane * 8), g1 = *(const f32x4*)(og + lane * 8 + 4);
            float res[8];
#pragma unroll
            for (int j = 0; j < 4; ++j) {
                res[2 * j] = o[2 * j] * r * (2 * j < 4 ? g0[2 * j] : g1[2 * j - 4]) * bf2f((unsigned short)(gt[j] & 0xffff));
                res[2 * j + 1] = o[2 * j + 1] * r * (2 * j + 1 < 4 ? g0[2 * j + 1] : g1[2 * j + 1 - 4]) * bf2f((unsigned short)(gt[j] >> 16));
            }
            u32x4 w; w.x = cvt_pk_bf16(res[0], res[1]); w.y = cvt_pk_bf16(res[2], res[3]); w.z = cvt_pk_bf16(res[4], res[5]); w.w = cvt_pk_bf16(res[6], res[7]);
            *(u32x4*)(ACAT + (size_t)row * 1024 + lane * 8) = w;
        }
    }
    GSYNC();

#pragma unroll
    for (int layer = 0; layer < 2; ++layer) {
        const float* gl = gains + (size_t)layer * 4 * D;
        if (layer == 1) {
            {
                pg8::Gemm g{XN, (const bf16_t*)(ws + WS_WQKV), M, 1536, 1024}; pg8::StaticOrder S; S.init(M, 1536, G, bid);
                EpiQKV E{(bf16_t*)(ws + WS_QKV1)};
                pg8::gemm_phase<EpiQKV, pg8::StaticOrder, true, true>(lds, g, S, E);
            }
            GSYNC();
#if PHMASK & 32
            for (int rp = 0; rp < REP_ATTN; ++rp) for (int u = bid; u < 512; u += G) attn_unit(lds, u, (const bf16_t*)(ws + WS_QKV1), a.in[7], ACAT);
#endif
            GSYNC();
        }
        {
            pg8::Gemm g{ACAT, (const bf16_t*)(ws + (layer == 0 ? WS_WO0 : WS_WO1)), M, 1024, 1024}; pg8::StaticOrder S; S.init(M, 1024, G, bid);
            EpiF32 E{MBUF, 1024};
            pg8::gemm_phase<EpiF32, pg8::StaticOrder, true, true>(lds, g, S, E);
        }
        GSYNC();
        postnorm_rows(layer == 0 ? a.in[0] : a.out, a.out, MBUF, gl + D, gl + 2 * D, XN, gw, ngw, lane);
        GSYNC();
        {
            pg8::Gemm g{XN, (const bf16_t*)(ws + WS_W13) + (size_t)layer * W13_STRIDE, M, 5632, 1024}; pg8::StaticOrder S; S.init(M, 5632, G, bid);
            EpiSwiglu E{HB};
            pg8::gemm_phase<EpiSwiglu, pg8::StaticOrder, true, true>(lds, g, S, E);
        }
        GSYNC();
        {
            pg8::Gemm g{HB, (const bf16_t*)(ws + WS_W2) + (size_t)layer * W2_STRIDE, M, 1024, FF}; pg8::StaticOrder S; S.init(M, 1024, G, bid);
            EpiF32 E{MBUF, 1024};
            pg8::gemm_phase<EpiF32, pg8::StaticOrder, true, true>(lds, g, S, E);
        }
        GSYNC();
        postnorm_rows(a.out, a.out, MBUF, gl + 3 * D, layer == 0 ? gains + 4 * D : nullptr, XN, gw, ngw, lane);
        if (layer == 0) GSYNC();
    }
}

extern "C" void kernel_launch(void* const* d_in, const int* in_sizes, int n_in, void* d_out, int out_size, void* d_ws, size_t ws_size, hipStream_t stream) {
    static int grid = 0;
    if (grid == 0) {
        if (n_in != 12 || out_size != M * D || ws_size < WS_END) { fprintf(stderr, "kernel_launch: unexpected shapes (n_in %d out %d ws %zu)\n", n_in, out_size, ws_size); grid = -1; return; }
        int dev = 0, cus = 0, per_cu = 0;
        hipGetDevice(&dev); hipDeviceGetAttribute(&cus, hipDeviceAttributeMultiprocessorCount, dev);
        if (hipFuncSetAttribute((const void*)fwd_megakernel, hipFuncAttributeMaxDynamicSharedMemorySize, LDS_BYTES) != hipSuccess) { fprintf(stderr, "kernel_launch: hipFuncSetAttribute failed\n"); grid = -1; return; }
        if (hipOccupancyMaxActiveBlocksPerMultiprocessor(&per_cu, (const void*)fwd_megakernel, 512, LDS_BYTES) != hipSuccess || per_cu < 1) { fprintf(stderr, "kernel_launch: occupancy query gave %d\n", per_cu); per_cu = 1; }
        (void)hipGetLastError();
        grid = cus;
    }
    if (grid < 0) return;
    Args a{};
    for (int i = 0; i < 12; ++i) a.in[i] = (const float*)d_in[i];
    a.out = (float*)d_out; a.ws = (unsigned char*)d_ws;
    if (hipMemsetAsync(d_ws, 0, 16384, stream) != hipSuccess) { fprintf(stderr, "kernel_launch: memset failed\n"); return; }
    void* args[] = {&a};
    hipError_t e = hipLaunchCooperativeKernel((const void*)fwd_megakernel, dim3(grid), dim3(512), args, LDS_BYTES, stream);
    if (e != hipSuccess) fprintf(stderr, "cooperative launch failed: %s (grid %d)\n", hipGetErrorString(e), grid);
}
```

```cpp
#include <hip/hip_runtime.h>
#include <hip/hip_cooperative_groups.h>
#include <cstdio>
#include <cstdint>
namespace cg = cooperative_groups;
namespace pg8 {
#define PG8_LAS __attribute__((address_space(3)))
typedef unsigned short bf16_t;
typedef short bf16x8 __attribute__((ext_vector_type(8)));
typedef float f32x4 __attribute__((ext_vector_type(4)));
typedef unsigned u32x4 __attribute__((ext_vector_type(4)));
constexpr int BM = 256, BK = 64, HALF = 128, HTB = HALF * BK * 2  , STAGE_BYTES = 8 * HTB, NXCD = 8, WGM = 8;

__host__ __device__ __forceinline__ int lds_byte(int r, int c) { const int st = (r >> 4) * 2 + (c >> 5), rr = r & 15, cc = c & 31, ob = rr * 64 + cc * 2; return st * 1024 + (ob ^ (((ob >> 9) & 1) << 5)); }
__host__ __device__ __forceinline__ void stage_rc(int b, int& R, int& C) { const int st = b / 1024, sb = b % 1024, swz = sb ^ (((sb >> 9) & 1) << 5); R = (st >> 1) * 16 + swz / 64; C = (st & 1) * 32 + (swz % 64) / 2; }
__host__ __device__ __forceinline__ int perm32(int rho) { const int n = rho >> 4, i = rho & 15; return 8 * (i >> 2) + 4 * n + (i & 3); }

struct Unit { int pm, pn; };
struct Gemm { const bf16_t* A; const bf16_t* Bt; int M, N, K; };

struct StaticOrder {
    int nM, nN, nwg, G, c;
    __host__ __device__ void init(int M, int N, int G_, int c_) { nM = M / BM; nN = N / BM; nwg = nM * nN; G = G_; c = c_; }
    __host__ __device__ bool next(int i, Unit& u) const {
        const long L = (long)i * G + c; if (L >= nwg) return false;
        int wgid = (int)L; { const int q = nwg / NXCD, r = nwg % NXCD, xcd = wgid % NXCD, off = wgid / NXCD; wgid = (xcd < r ? xcd * (q + 1) : r * (q + 1) + (xcd - r) * q) + off; }
        const int nig = WGM * nN, gid = wgid / nig, fm = gid * WGM, gsz = (nM - fm) < WGM ? (nM - fm) : WGM;
        u.pm = fm + ((wgid % nig) % gsz); u.pn = (wgid % nig) / gsz; return true;
    }
    __device__ __forceinline__ void a_ready(const Unit&) const {}
    __device__ __forceinline__ void done(const Unit&) const {}
};

typedef float f32x2_t __attribute__((ext_vector_type(2))); typedef __bf16 bf16x2_t __attribute__((ext_vector_type(2)));
__device__ __forceinline__ unsigned cvt_pk_bf16(float lo, float hi) { f32x2_t v = {lo, hi}; bf16x2_t b = __builtin_convertvector(v, bf16x2_t); return __builtin_bit_cast(unsigned, b); }
template <class Epi, class Sched, bool ALIGN_EPI = false, bool SP2 = false>
__device__ __forceinline__ void gemm_phase(PG8_LAS unsigned char* lds, const Gemm g, const Sched& S, const Epi& E) {
    int tid_ = threadIdx.x; asm volatile("" : "+v"(tid_));
    const int tid = tid_, wid = __builtin_amdgcn_readfirstlane(tid >> 6), lane = tid & 63, wr = wid >> 2, wc = wid & 3, fr = lane & 15, fq = lane >> 4;
    const int K = g.K, nt = K / BK;
    unsigned voffA[2], voffB[2];
#pragma unroll
    for (int i = 0; i < 2; ++i) { int R, C; stage_rc(tid * 16 + i * 8192, R, C); const int Rb = Epi::PERM ? ((R & ~31) + perm32(R & 31)) : R;
        voffA[i] = (unsigned)(R * K + C) * 2u; voffB[i] = (unsigned)(Rb * K + C) * 2u; }
    const size_t kstep = (size_t)(BK * 2);
    const size_t hstep = (size_t)HALF * K * 2;
    const size_t tstep = 2 * hstep;
    const unsigned ldsw = (unsigned)wid * 1024u;
    const int aoff = lds_byte(wr * 64 + fr, fq * 8), boff = lds_byte(wc * 32 + fr, fq * 8);
#define PG8_SA(b, h) (((b) * 2 + (h)) * HTB)
#define PG8_SB(b, h) ((4 + (b) * 2 + (h)) * HTB)
#define PG8_STAGE(bufoff, gbase, voff) do { _Pragma("unroll") for (int _i = 0; _i < 2; ++_i) \
        __builtin_amdgcn_global_load_lds((const unsigned*)((const char*)(gbase) + (voff)[_i]), (PG8_LAS unsigned*)(lds + (bufoff) + ldsw + _i * 8192), 16, 0, 0); } while (0)
#define PG8_LDA(dst, b, h) do { _Pragma("unroll") for (int m = 0; m < 4; ++m) _Pragma("unroll") for (int k = 0; k < 2; ++k) dst[m][k] = *(const PG8_LAS bf16x8*)(lds + PG8_SA(b, h) + aoff + m * 2048 + k * 1024); } while (0)
#define PG8_LDB(dst, b, h) do { _Pragma("unroll") for (int n = 0; n < 2; ++n) _Pragma("unroll") for (int k = 0; k < 2; ++k) dst[n][k] = *(const PG8_LAS bf16x8*)(lds + PG8_SB(b, h) + boff + n * 2048 + k * 1024); } while (0)
#define PG8_MMA(ai, bj, At, Bt) do { __builtin_amdgcn_s_setprio(1); _Pragma("unroll") for (int m = 0; m < 4; ++m) _Pragma("unroll") for (int n = 0; n < 2; ++n) _Pragma("unroll") for (int k = 0; k < 2; ++k) \
        acc[ai][bj][m][n] = __builtin_amdgcn_mfma_f32_16x16x32_bf16(Bt[n][k], At[m][k], acc[ai][bj][m][n], 0, 0, 0); __builtin_amdgcn_s_setprio(0); } while (0)
#define PG8_WAIT_V(n) asm volatile("s_waitcnt vmcnt(" #n ")" ::: "memory")
#define PG8_WAIT_L(n) asm volatile("s_waitcnt lgkmcnt(" #n ")" ::: "memory")
#define PG8_BAR __builtin_amdgcn_s_barrier()
#define PG8_SCHED __builtin_amdgcn_sched_barrier(0)
    Unit cur, nxt; int ui = 0;
    if (!S.next(0, cur)) return;
    f32x4 acc[2][2][4][2];
#pragma unroll
    for (int a = 0; a < 2; ++a)
#pragma unroll
        for (int b = 0; b < 2; ++b)
#pragma unroll
            for (int m = 0; m < 4; ++m)
#pragma unroll
                for (int n = 0; n < 2; ++n) acc[a][b][m][n] = (f32x4){0.f, 0.f, 0.f, 0.f};
    bf16x8 At[4][2], B0[2][2], B1[2][2];
    const char* cA = (const char*)g.A + (size_t)cur.pm * tstep; const char* cB = (const char*)g.Bt + (size_t)cur.pn * tstep;
    S.a_ready(cur);
    if constexpr (SP2) {
        PG8_STAGE(PG8_SB(0, 0), cB, voffB); PG8_STAGE(PG8_SB(0, 1), cB + hstep, voffB); PG8_STAGE(PG8_SA(0, 0), cA, voffA); PG8_STAGE(PG8_SA(0, 1), cA + hstep, voffA);
        if (wr == 1) PG8_BAR;
        PG8_WAIT_V(2); PG8_BAR;
        PG8_STAGE(PG8_SB(1, 0), cB + kstep, voffB); PG8_STAGE(PG8_SA(1, 0), cA + kstep, voffA); PG8_STAGE(PG8_SB(1, 1), cB + hstep + kstep, voffB);
        PG8_WAIT_V(6); PG8_BAR;
    } else {
        PG8_STAGE(PG8_SB(0, 0), cB, voffB); PG8_STAGE(PG8_SA(0, 0), cA, voffA); PG8_STAGE(PG8_SB(0, 1), cB + hstep, voffB); PG8_STAGE(PG8_SA(0, 1), cA + hstep, voffA);
        if (wr == 1) PG8_BAR;
        PG8_WAIT_V(4); PG8_BAR;
        PG8_STAGE(PG8_SB(1, 0), cB + kstep, voffB); PG8_STAGE(PG8_SA(1, 0), cA + kstep, voffA); PG8_STAGE(PG8_SB(1, 1), cB + hstep + kstep, voffB);
        PG8_WAIT_V(6); PG8_BAR;
    }
    for (;;) {
        const bool has_next = S.next(ui + 1, nxt);
        const char* nA = has_next ? (const char*)g.A + (size_t)nxt.pm * tstep : cA; const char* nB = has_next ? (const char*)g.Bt + (size_t)nxt.pn * tstep : cB;
        for (int t = 0; t < nt; t += 2) {
            const bool last = (t == nt - 2);
            const char* a1 = cA + (size_t)(t + 1) * kstep;
            const char* a2 = last ? nA : cA + (size_t)(t + 2) * kstep; const char* b2 = last ? nB : cB + (size_t)(t + 2) * kstep;
            const char* a3 = a2 + kstep; const char* b3 = b2 + kstep;
            if (last && has_next) S.a_ready(nxt);
            if constexpr (SP2) {
            PG8_LDB(B0, 0, 0); PG8_LDB(B1, 0, 1); PG8_SCHED; PG8_LDA(At, 0, 0); PG8_STAGE(PG8_SA(1, 1), a1 + hstep, voffA);
            PG8_WAIT_V(8); PG8_WAIT_L(0); PG8_BAR; PG8_MMA(0, 0, At, B0); PG8_MMA(0, 1, At, B1); PG8_BAR; PG8_SCHED;
            PG8_LDA(At, 0, 1); PG8_STAGE(PG8_SB(0, 0), b2, voffB); PG8_STAGE(PG8_SB(0, 1), b2 + hstep, voffB); PG8_STAGE(PG8_SA(0, 0), a2, voffA);
            PG8_WAIT_V(8); PG8_WAIT_L(0); PG8_BAR; PG8_MMA(1, 0, At, B0); PG8_MMA(1, 1, At, B1); PG8_BAR; PG8_SCHED;
            PG8_LDB(B0, 1, 0); PG8_LDB(B1, 1, 1); PG8_SCHED; PG8_LDA(At, 1, 0); PG8_STAGE(PG8_SA(0, 1), a2 + hstep, voffA);
            PG8_WAIT_V(8); PG8_WAIT_L(0); PG8_BAR; PG8_MMA(0, 0, At, B0); PG8_MMA(0, 1, At, B1); PG8_BAR; PG8_SCHED;
            PG8_LDA(At, 1, 1); PG8_STAGE(PG8_SB(1, 0), b3, voffB); PG8_STAGE(PG8_SB(1, 1), b3 + hstep, voffB); PG8_STAGE(PG8_SA(1, 0), a3, voffA);
            PG8_WAIT_V(8); PG8_WAIT_L(0); PG8_BAR; PG8_MMA(1, 0, At, B0); PG8_MMA(1, 1, At, B1); PG8_BAR; PG8_SCHED;
            } else {
            PG8_LDB(B0, 0, 0); PG8_SCHED; PG8_LDA(At, 0, 0); PG8_STAGE(PG8_SA(1, 1), a1 + hstep, voffA);
            PG8_WAIT_L(8); PG8_BAR; PG8_WAIT_L(0); PG8_MMA(0, 0, At, B0); PG8_BAR; PG8_SCHED;
            PG8_LDB(B1, 0, 1); PG8_STAGE(PG8_SB(0, 0), b2, voffB);
            PG8_BAR; PG8_WAIT_L(0); PG8_MMA(0, 1, At, B1); PG8_BAR;
            PG8_LDA(At, 0, 1); PG8_STAGE(PG8_SA(0, 0), a2, voffA);
            PG8_BAR; PG8_WAIT_L(0); PG8_MMA(1, 0, At, B0); PG8_BAR; PG8_SCHED;
            PG8_STAGE(PG8_SB(0, 1), b2 + hstep, voffB);
            PG8_WAIT_V(6); PG8_BAR; PG8_MMA(1, 1, At, B1); PG8_BAR;
            PG8_LDB(B0, 1, 0); PG8_SCHED; PG8_LDA(At, 1, 0); PG8_STAGE(PG8_SA(0, 1), a2 + hstep, voffA);
            PG8_WAIT_L(8); PG8_BAR; PG8_WAIT_L(0); PG8_MMA(0, 0, At, B0); PG8_BAR; PG8_SCHED;
            PG8_LDB(B1, 1, 1); PG8_STAGE(PG8_SB(1, 0), b3, voffB);
            PG8_BAR; PG8_WAIT_L(0); PG8_MMA(0, 1, At, B1); PG8_BAR;
            PG8_LDA(At, 1, 1); PG8_STAGE(PG8_SA(1, 0), a3, voffA);
            PG8_BAR; PG8_WAIT_L(0); PG8_MMA(1, 0, At, B0); PG8_BAR; PG8_SCHED;
            PG8_STAGE(PG8_SB(1, 1), b3 + hstep, voffB);
            PG8_WAIT_V(6); PG8_BAR; PG8_MMA(1, 1, At, B1); PG8_BAR;
            }
        }
        if constexpr (ALIGN_EPI) { if (wr == 0) PG8_BAR; }
        if constexpr (!Epi::AFTER_DRAIN) { E(acc, cur, wr, wc, fr, fq); S.done(cur); }
        if (!has_next) break;
#pragma unroll
        for (int a = 0; a < 2; ++a)
#pragma unroll
            for (int b = 0; b < 2; ++b)
#pragma unroll
                for (int m = 0; m < 4; ++m)
#pragma unroll
                    for (int n = 0; n < 2; ++n) acc[a][b][m][n] = (f32x4){0.f, 0.f, 0.f, 0.f};
        cur = nxt; cA = nA; cB = nB; ++ui;
        if constexpr (ALIGN_EPI) { if (wr == 1) PG8_BAR; }
    }
    PG8_WAIT_V(0);
    if constexpr (!ALIGN_EPI) { if (wr == 0) PG8_BAR; }
    PG8_BAR;
    if constexpr (Epi::AFTER_DRAIN) { E.fused(acc, cur, wr, wc, fr, fq, lds, wid, lane); S.done(cur); }
#undef PG8_SA
#undef PG8_SB
#undef PG8_STAGE
#undef PG8_LDA
#undef PG8_LDB
#undef PG8_MMA
#undef PG8_WAIT_V
#undef PG8_WAIT_L
#undef PG8_BAR
#undef PG8_SCHED
}
}

#define LAS __attribute__((address_space(3)))
using pg8::bf16_t; using pg8::bf16x8; using pg8::f32x4; using pg8::u32x4; using pg8::Unit; using pg8::cvt_pk_bf16;
typedef float f32x16 __attribute__((ext_vector_type(16)));
typedef unsigned u32x2 __attribute__((ext_vector_type(2)));
typedef short s16x4 __attribute__((ext_vector_type(4)));
#define MFMA32(a, b, c) __builtin_amdgcn_mfma_f32_32x32x16_bf16((a), (b), (c), 0, 0, 0)

constexpr int NB = 8, T = 2048, D = 1024, M = NB * T, FF = 2816;
constexpr float EPS = 1e-6f;
constexpr float LOG2E = 1.4426950408889634f;
constexpr int LDS_BYTES = 147456;

constexpr size_t MiB = 1u << 20;
constexpr size_t WS_WP = 1 * MiB;
constexpr size_t WS_WCS = 6 * MiB;
constexpr size_t WS_DFT = 8 * MiB;
constexpr size_t WS_WO0 = 24 * MiB;
constexpr size_t WS_WQKV = 26 * MiB;
constexpr size_t WS_WO1 = 29 * MiB;
constexpr size_t WS_W13 = 31 * MiB;
constexpr size_t WS_W2 = 53 * MiB;
constexpr size_t W13_STRIDE = (size_t)5632 * 1024, W2_STRIDE = (size_t)1024 * 2816;
constexpr size_t WS_CNT = 65536;
constexpr size_t WS_XBUF = 64 * MiB;
constexpr size_t WS_XN = 66 * MiB;
constexpr size_t WS_MBUF = 98 * MiB;
constexpr size_t WS_YT = 98 * MiB;
constexpr size_t WS_OFB = 130 * MiB;
constexpr size_t WS_Q0 = 162 * MiB;
constexpr size_t WS_V0 = 178 * MiB;
constexpr size_t WS_GATE = 194 * MiB;
constexpr size_t WS_ACAT = 210 * MiB;
constexpr size_t WS_H = 162 * MiB;
constexpr size_t WS_QKV1 = 162 * MiB;
constexpr size_t WS_END = 256 * MiB;

__device__ __forceinline__ unsigned f2bf(float f) { unsigned u = __builtin_bit_cast(unsigned, f); return (u + 0x7fffu + ((u >> 16) & 1u)) >> 16; }
__device__ __forceinline__ float bf2f(unsigned short h) { return __builtin_bit_cast(float, (unsigned)h << 16); }
__device__ __forceinline__ float wave_sum(float v) {
#pragma unroll
    for (int o = 1; o < 64; o <<= 1) v += __shfl_xor(v, o);
    return v;
}
__device__ __forceinline__ int crow(int r, int hi) { return (r & 3) + 8 * (r >> 2) + 4 * hi; }
#define LDS_WAIT() asm volatile("s_waitcnt lgkmcnt(0)" ::: "memory")
#define XB_TMO      128
#define XB_XCNT(j)  (256  + 64 * (j))
#define XB_XSUB(j)  (1280 + 64 * (j))
#define XB_XGEN(j)  (2304 + 64 * (j))
#define XB_TOP      3328
#define XB_TOPGEN   3392
#define XCD_BAR_WORDS 3456
#define XB_SPIN_CAP (1u << 18)

__device__ __forceinline__ unsigned xb_ld(unsigned* p)              { return __hip_atomic_load(p, __ATOMIC_RELAXED, __HIP_MEMORY_SCOPE_AGENT); }
__device__ __forceinline__ unsigned xb_add(unsigned* p, unsigned v) { return __hip_atomic_fetch_add(p, v, __ATOMIC_RELAXED, __HIP_MEMORY_SCOPE_AGENT); }
__device__ __forceinline__ unsigned xb_xcc_id() { return (unsigned)__builtin_amdgcn_s_getreg((3 << 11) | 20) & 0xFu; }
#define XB_SPIN(cond, bar) do { unsigned _sp = 0; while (cond) { __builtin_amdgcn_s_sleep(1); \
    if ((++_sp & 255u) == 0u) { if (xb_ld(&(bar)[XB_TMO])) break; if (_sp > XB_SPIN_CAP) { atomicAdd(&(bar)[XB_TMO], 1u); break; } } } } while (0)

struct XcdBarrier {
    unsigned* bar; unsigned x;
    volatile LAS unsigned* st;
};

__device__ __forceinline__ XcdBarrier xcd_barrier_post(unsigned* bar, volatile LAS unsigned* st) {
    XcdBarrier b; b.bar = bar; b.x = xb_xcc_id(); b.st = st;
    if (threadIdx.x == 0) (void)xb_add(&bar[XB_XCNT(b.x)], 1u);
    return b;
}
__device__ __forceinline__ void xcd_barrier_complete(unsigned* bar, unsigned x, unsigned& nloc, unsigned& nx) {
    const unsigned G = gridDim.x * gridDim.y * gridDim.z;
    unsigned sum, cnt, mine, sp = 0u;
    for (;;) {
        sum = 0u; cnt = 0u; mine = 0u;
#pragma unroll
        for (unsigned j = 0; j < 16; ++j) { const unsigned c = xb_ld(&bar[XB_XCNT(j)]); sum += c; cnt += (c > 0u) ? 1u : 0u; mine = (j == x) ? c : mine; }
        if (sum == G) break;
        __builtin_amdgcn_s_sleep(1);
        if ((++sp & 255u) == 0u) { if (xb_ld(&bar[XB_TMO])) break; if (sp > XB_SPIN_CAP) { atomicAdd(&bar[XB_TMO], 1u); break; } }
    }
    nloc = mine > 0u ? mine : 1u; nx = cnt > 0u ? cnt : 1u;
}

__device__ __forceinline__ void xcd_barrier(const XcdBarrier& b) {
    asm volatile("s_waitcnt vmcnt(0)" ::: "memory");
    __syncthreads();
    if (threadIdx.x == 0) {
        unsigned* bar = b.bar;
        __builtin_amdgcn_s_waitcnt(0);
        unsigned nloc = b.st[0], nx = b.st[1];
        if (nloc == 0u) { xcd_barrier_complete(bar, b.x, nloc, nx); b.st[0] = nloc; b.st[1] = nx; }
        const unsigned old = xb_add(&bar[XB_XSUB(b.x)], 1u);
        const unsigned gen = old / nloc;
        if (old + 1u == (gen + 1u) * nloc) {
            __builtin_amdgcn_fence(__ATOMIC_RELEASE, "agent");
            asm volatile("s_waitcnt vmcnt(0)" ::: "memory");
            const unsigned og = xb_add(&bar[XB_TOP], 1u);
            const unsigned tg = og / nx;
            if (og + 1u == (tg + 1u) * nx) xb_add(&bar[XB_TOPGEN], 1u);
            else XB_SPIN(xb_ld(&bar[XB_TOPGEN]) == tg, bar);
            __builtin_amdgcn_fence(__ATOMIC_ACQUIRE, "agent");
            xb_add(&bar[XB_XGEN(b.x)], 1u);
            asm volatile("s_waitcnt vmcnt(0)" ::: "memory");
        } else {
            XB_SPIN(xb_ld(&bar[XB_XGEN(b.x)]) == gen, bar);
            __builtin_amdgcn_fence(__ATOMIC_ACQUIRE, "agent");
            asm volatile("s_waitcnt vmcnt(0)" ::: "memory");
        }
    }
    __syncthreads();
}

struct EpiProj {
    static constexpr bool PERM = true, AFTER_DRAIN = false;
    bf16_t* Q0; float* LOGF; const float* tab;
    __device__ __forceinline__ void operator()(const f32x4 (&acc)[2][2][4][2], const Unit& u, int wr, int wc, int fr, int fq) const {
        const int seg = u.pn >> 1;
        const int cseg = (u.pn & 1) * 256 + wc * 32 + 8 * fq;
        const int row0 = u.pm * 256 + wr * 64 + fr;
        if (seg == 1 || seg == 2) {
            const int dir = seg - 1;
#pragma unroll
            for (int bj = 0; bj < 2; ++bj) {
                const int c = cseg + bj * 128;
                const f32x4 ta0 = *(const f32x4*)(tab + dir * 512 + c), ta1 = *(const f32x4*)(tab + dir * 512 + c + 4);
                const f32x4 tb0 = *(const f32x4*)(tab + 1024 + dir * 512 + c), tb1 = *(const f32x4*)(tab + 1024 + dir * 512 + c + 4);
                f32x4 lb0, lb1;
#pragma unroll
                for (int e = 0; e < 4; ++e) { lb0[e] = 1.0f / (1.0f + __expf(tb0[e] - ta0[e])); lb1[e] = 1.0f / (1.0f + __expf(tb1[e] - ta1[e])); }
#pragma unroll
                for (int ai = 0; ai < 2; ++ai)
#pragma unroll
                    for (int m = 0; m < 4; ++m) {
                        float* dst = LOGF + (size_t)(row0 + ai * 128 + m * 16) * 1024 + dir * 512 + c;
                        const f32x4 z0 = acc[ai][bj][m][0], z1 = acc[ai][bj][m][1]; f32x4 o0, o1;
#pragma unroll
                        for (int e = 0; e < 4; ++e) {
                            const float s0 = 1.0f / (1.0f + __expf(-z0[e])), s1 = 1.0f / (1.0f + __expf(-z1[e]));
                            o0[e] = __logf(lb0[e] + (1.0f - lb0[e]) * s0); o1[e] = __logf(lb1[e] + (1.0f - lb1[e]) * s1);
                        }
                        *(f32x4*)dst = o0; *(f32x4*)(dst + 4) = o1;
                    }
            }
        } else {
            bf16_t* base = Q0 + (size_t)(seg == 0 ? 0 : seg - 2) * ((size_t)M * 512);
            const float sc = seg == 0 ? 0.08838834764831845f : 1.0f;
#pragma unroll
            for (int bj = 0; bj < 2; ++bj) {
                const int c = cseg + bj * 128;
#pragma unroll
                for (int ai = 0; ai < 2; ++ai)
#pragma unroll
                    for (int m = 0; m < 4; ++m) {
                        f32x4 v0 = acc[ai][bj][m][0], v1 = acc[ai][bj][m][1];
                        if (seg == 4) {
#pragma unroll
                            for (int e = 0; e < 4; ++e) { v0[e] = v0[e] / (1.0f + __expf(-v0[e])); v1[e] = v1[e] / (1.0f + __expf(-v1[e])); }
                        } else { v0 = v0 * sc; v1 = v1 * sc; }
                        u32x4 w; w.x = cvt_pk_bf16(v0[0], v0[1]); w.y = cvt_pk_bf16(v0[2], v0[3]); w.z = cvt_pk_bf16(v1[0], v1[1]); w.w = cvt_pk_bf16(v1[2], v1[3]);
                        *(u32x4*)(base + (size_t)(row0 + ai * 128 + m * 16) * 512 + c) = w;
                    }
            }
        }
    }
};
struct EpiYt {
    static constexpr bool PERM = true, AFTER_DRAIN = false;
    bf16_t* Yt;
    __device__ __forceinline__ void operator()(const f32x4 (&acc)[2][2][4][2], const Unit& u, int wr, int wc, int fr, int fq) const {
        const int row0 = u.pm * 256 + wr * 64 + fr, tok0 = u.pn * 256 + wc * 32 + 8 * fq;
#pragma unroll
        for (int ai = 0; ai < 2; ++ai)
#pragma unroll
            for (int m = 0; m < 4; ++m) {
                const int f = row0 + ai * 128 + m * 16, cs = f >> 9, n_ = f & 511;
#pragma unroll
                for (int bj = 0; bj < 2; ++bj) {
                    const int tok = tok0 + bj * 128, b = tok >> 11, t = tok & 2047;
                    const f32x4 v0 = acc[ai][bj][m][0], v1 = acc[ai][bj][m][1];
                    u32x4 w; w.x = cvt_pk_bf16(v0[0], v0[1]); w.y = cvt_pk_bf16(v0[2], v0[3]); w.z = cvt_pk_bf16(v1[0], v1[1]); w.w = cvt_pk_bf16(v1[2], v1[3]);
                    *(u32x4*)(Yt + ((size_t)(b * 512 + n_) * 2 + cs) * 2048 + t) = w;
                }
            }
    }
};
struct EpiFnet {
    static constexpr bool PERM = true, AFTER_DRAIN = false;
    bf16_t* ACAT;
    __device__ __forceinline__ void operator()(const f32x4 (&acc)[2][2][4][2], const Unit& u, int wr, int wc, int fr, int fq) const {
        const int row0 = u.pm * 256 + wr * 64 + fr, col0 = u.pn * 256 + wc * 32 + 8 * fq;
#pragma unroll
        for (int ai = 0; ai < 2; ++ai)
#pragma unroll
            for (int m = 0; m < 4; ++m) {
                const int k1 = row0 + ai * 128 + m * 16;
#pragma unroll
                for (int bj = 0; bj < 2; ++bj) {
                    const int c = col0 + bj * 128, b = c >> 9, n_ = c & 511;
                    const f32x4 v0 = acc[ai][bj][m][0], v1 = acc[ai][bj][m][1];
                    u32x4 w; w.x = cvt_pk_bf16(v0[0], v0[1]); w.y = cvt_pk_bf16(v0[2], v0[3]); w.z = cvt_pk_bf16(v1[0], v1[1]); w.w = cvt_pk_bf16(v1[2], v1[3]);
                    *(u32x4*)(ACAT + (size_t)(b * 2048 + k1) * 1024 + 512 + n_) = w;
                }
            }
    }
};
struct EpiF32 {
    static constexpr bool PERM = false, AFTER_DRAIN = false;
    float* O; int ldc;
    __device__ __forceinline__ void operator()(const f32x4 (&acc)[2][2][4][2], const Unit& u, int wr, int wc, int fr, int fq) const {
        const int row0 = u.pm * 256 + wr * 64 + fr, col0 = u.pn * 256 + wc * 32 + 4 * fq;
#pragma unroll
        for (int ai = 0; ai < 2; ++ai)
#pragma unroll
            for (int m = 0; m < 4; ++m) {
                float* rowp = O + (size_t)(row0 + ai * 128 + m * 16) * ldc + col0;
#pragma unroll
                for (int bj = 0; bj < 2; ++bj)
#pragma unroll
                    for (int n = 0; n < 2; ++n) *(f32x4*)(rowp + bj * 128 + n * 16) = acc[ai][bj][m][n];
            }
    }
};
struct RowSsq {
    unsigned* xbuf;
    unsigned* cnt;
    __device__ __forceinline__ void run(const f32x4 (&v)[2][2][4][2], const Unit& u, int wr, int wc, int fr, int fq, LAS unsigned char* lds, int wid, int lane) const {
        LAS float* P = (LAS float*)lds;
        LAS float* S = (LAS float*)(lds + 8192);
#pragma unroll
        for (int ai = 0; ai < 2; ++ai)
#pragma unroll
            for (int m = 0; m < 4; ++m) {
                float q = 0.f;
#pragma unroll
                for (int bj = 0; bj < 2; ++bj)
#pragma unroll
                    for (int n = 0; n < 2; ++n) { const f32x4 x = v[ai][bj][m][n]; q += (x[0] * x[0] + x[1] * x[1]) + (x[2] * x[2] + x[3] * x[3]); }
                q += __shfl_xor(q, 16); q += __shfl_xor(q, 32);
                if (fq == 0) P[(ai * 128 + wr * 64 + m * 16 + fr) * 4 + wc] = q;
            }
        asm volatile("s_waitcnt lgkmcnt(0)" ::: "memory"); __builtin_amdgcn_s_barrier(); asm volatile("" ::: "memory");
        const int row = wid * 32 + (lane & 31);
        if (lane < 32) {
            const float tot = (P[row * 4 + 0] + P[row * 4 + 1]) + (P[row * 4 + 2] + P[row * 4 + 3]);
            __hip_atomic_store(xbuf + ((size_t)(u.pm * 256 + row) * 4 + u.pn), __float_as_uint(tot), __ATOMIC_RELAXED, __HIP_MEMORY_SCOPE_AGENT);
        }
        asm volatile("s_waitcnt vmcnt(0)" ::: "memory");
        if (lane == 0) __hip_atomic_fetch_add(cnt + 64 * u.pm, 1u, __ATOMIC_RELAXED, __HIP_MEMORY_SCOPE_AGENT);
        if (wid == 0) {
            unsigned sp = 0;
            while ((unsigned)__builtin_amdgcn_readfirstlane(__hip_atomic_load(cnt + 64 * u.pm, __ATOMIC_RELAXED, __HIP_MEMORY_SCOPE_AGENT)) < 32u) { __builtin_amdgcn_s_sleep(2); if (++sp > (1u << 22)) break; }
            __builtin_amdgcn_fence(__ATOMIC_ACQUIRE, "agent");
        }
        asm volatile("s_waitcnt vmcnt(0) lgkmcnt(0)" ::: "memory"); __builtin_amdgcn_s_barrier(); asm volatile("" ::: "memory");
        if (lane < 32) {
            const unsigned* slot = xbuf + (size_t)(u.pm * 256 + row) * 4; float t = 0.f;
#pragma unroll
            for (int k = 0; k < 4; ++k) t += __uint_as_float(__hip_atomic_load(slot + k, __ATOMIC_RELAXED, __HIP_MEMORY_SCOPE_AGENT));
            S[row] = t;
        }
        asm volatile("s_waitcnt lgkmcnt(0)" ::: "memory"); __builtin_amdgcn_s_barrier(); asm volatile("" ::: "memory");
    }
};
template <int BANK, int GPOST, int GPRE> struct EpiRmsRes {
    static constexpr bool PERM = false, AFTER_DRAIN = true, HAS_PRE = GPRE >= 0; static constexpr int bank = BANK;
    const float* base; float* out; unsigned char* ws; const float* gains;
    __device__ __forceinline__ void fused(f32x4 (&acc)[2][2][4][2], const Unit& u, int wr, int wc, int fr, int fq, LAS unsigned char* lds, int wid, int lane) const {
        const LAS float* S = (const LAS float*)(lds + 8192);
        const int col0 = u.pn * 256 + wc * 32 + 4 * fq;
        const float* g_post = gains + GPOST; const float* g_pre = gains + (GPRE >= 0 ? GPRE : 0);
        { const RowSsq st1{(unsigned*)(ws + WS_XBUF) + (size_t)bank * 65536, (unsigned*)(ws + WS_CNT) + bank * 4096}; st1.run(acc, u, wr, wc, fr, fq, lds, wid, lane); }
#pragma unroll
        for (int ai = 0; ai < 2; ++ai)
#pragma unroll
            for (int m = 0; m < 4; ++m) {
                const int r = ai * 128 + wr * 64 + m * 16 + fr; const float rstd = rsqrtf(S[r] * (1.0f / 1024.0f) + EPS);
                const size_t off = (size_t)(u.pm * 256 + r) * 1024 + col0;
#pragma unroll
                for (int bj = 0; bj < 2; ++bj)
#pragma unroll
                    for (int n = 0; n < 2; ++n) {
                        const f32x4 g = *(const f32x4*)(g_post + col0 + bj * 128 + n * 16); const f32x4 bs = *(const f32x4*)(base + off + bj * 128 + n * 16);
                        const f32x4 x1 = bs + acc[ai][bj][m][n] * rstd * g;
                        acc[ai][bj][m][n] = x1; *(f32x4*)(out + off + bj * 128 + n * 16) = x1;
                    }
                asm volatile("" : "+v"(acc[ai][0][m][0]), "+v"(acc[ai][0][m][1]), "+v"(acc[ai][1][m][0]), "+v"(acc[ai][1][m][1]));
                if (m & 1) asm volatile("" ::: "memory");
            }
        if constexpr (HAS_PRE) {
            { const RowSsq st2{(unsigned*)(ws + WS_XBUF) + (size_t)(bank + 1) * 65536, (unsigned*)(ws + WS_CNT) + (bank + 1) * 4096}; st2.run(acc, u, wr, wc, fr, fq, lds, wid, lane); }
            bf16_t* xn = (bf16_t*)(ws + WS_XN);
#pragma unroll
            for (int ai = 0; ai < 2; ++ai)
#pragma unroll
                for (int m = 0; m < 4; ++m) {
                    const int r = ai * 128 + wr * 64 + m * 16 + fr; const float rstd = rsqrtf(S[r] * (1.0f / 1024.0f) + EPS);
                    const size_t off = (size_t)(u.pm * 256 + r) * 1024 + col0;
#pragma unroll
                    for (int bj = 0; bj < 2; ++bj)
#pragma unroll
                        for (int n = 0; n < 2; ++n) {
                            const f32x4 g = *(const f32x4*)(g_pre + col0 + bj * 128 + n * 16); const f32x4 o = acc[ai][bj][m][n] * rstd * g;
                            u32x2 w; w.x = cvt_pk_bf16(o[0], o[1]); w.y = cvt_pk_bf16(o[2], o[3]);
                            *(u32x2*)(xn + off + bj * 128 + n * 16) = w;
                        }
                    asm volatile("" ::: "memory");
                }
        }
    }
};
struct EpiSwiglu {
    static constexpr bool PERM = true, AFTER_DRAIN = false;
    bf16_t* H;
    __device__ __forceinline__ void operator()(const f32x4 (&acc)[2][2][4][2], const Unit& u, int wr, int wc, int fr, int fq) const {
        const int row0 = u.pm * 256 + wr * 64 + fr, col0 = u.pn * 128 + wc * 32 + 8 * fq;
#pragma unroll
        for (int ai = 0; ai < 2; ++ai)
#pragma unroll
            for (int m = 0; m < 4; ++m) {
                float h[8];
#pragma unroll
                for (int n = 0; n < 2; ++n)
#pragma unroll
                    for (int e = 0; e < 4; ++e) { const float a = acc[ai][0][m][n][e], b = acc[ai][1][m][n][e]; h[4 * n + e] = a / (1.0f + __expf(-a)) * b; }
                u32x4 w; w.x = cvt_pk_bf16(h[0], h[1]); w.y = cvt_pk_bf16(h[2], h[3]); w.z = cvt_pk_bf16(h[4], h[5]); w.w = cvt_pk_bf16(h[6], h[7]);
                *(u32x4*)(H + (size_t)(row0 + ai * 128 + m * 16) * FF + col0) = w;
            }
    }
};
struct EpiQKV {
    static constexpr bool PERM = true, AFTER_DRAIN = false;
    bf16_t* O;
    __device__ __forceinline__ void operator()(const f32x4 (&acc)[2][2][4][2], const Unit& u, int wr, int wc, int fr, int fq) const {
        const int row0 = u.pm * 256 + wr * 64 + fr, col0 = u.pn * 256 + wc * 32 + 8 * fq;
        const float sc = u.pn < 4 ? 0.125f * LOG2E : 1.0f;
#pragma unroll
        for (int ai = 0; ai < 2; ++ai)
#pragma unroll
            for (int m = 0; m < 4; ++m)
#pragma unroll
                for (int bj = 0; bj < 2; ++bj) {
                    const f32x4 v0 = acc[ai][bj][m][0] * sc, v1 = acc[ai][bj][m][1] * sc;
                    u32x4 w; w.x = cvt_pk_bf16(v0[0], v0[1]); w.y = cvt_pk_bf16(v0[2], v0[3]); w.z = cvt_pk_bf16(v1[0], v1[1]); w.w = cvt_pk_bf16(v1[2], v1[3]);
                    *(u32x4*)(O + (size_t)(row0 + ai * 128 + m * 16) * 1536 + col0 + bj * 128) = w;
                }
    }
};

__device__ __forceinline__ void transpose_item(const float* W, int ldw, int K, bf16_t* WT, int k0, int n0src, int dst_row0, LAS float* scr, int lane) {
#pragma unroll
    for (int i = 0; i < 8; ++i) {
        const int kk = i * 8 + (lane >> 3), q4 = lane & 7;
        const f32x4 v = *(const f32x4*)(W + (size_t)(k0 + kk) * ldw + n0src + 4 * q4);
        LAS float* d = scr + kk * 33 + 4 * q4; d[0] = v.x; d[1] = v.y; d[2] = v.z; d[3] = v.w;
    }
    LDS_WAIT();
    const int c = lane & 7;
#pragma unroll
    for (int j = 0; j < 4; ++j) {
        const int n = (lane >> 3) + 8 * j; const LAS float* s = scr + (8 * c) * 33 + n;
        u32x4 o; o.x = cvt_pk_bf16(s[0 * 33], s[1 * 33]); o.y = cvt_pk_bf16(s[2 * 33], s[3 * 33]); o.z = cvt_pk_bf16(s[4 * 33], s[5 * 33]); o.w = cvt_pk_bf16(s[6 * 33], s[7 * 33]);
        *(u32x4*)(WT + (size_t)(dst_row0 + n) * K + k0 + 8 * c) = o;
    }
    LDS_WAIT();
}
__device__ __forceinline__ void rms_row_to_bf16(const float* xrow, const float* gain, bf16_t* orow, int lane) {
    f32x4 v[4]; float ss = 0.f;
#pragma unroll
    for (int j = 0; j < 4; ++j) { v[j] = ((const f32x4*)xrow)[lane + 64 * j]; ss += (v[j].x * v[j].x + v[j].y * v[j].y) + (v[j].z * v[j].z + v[j].w * v[j].w); }
    const float r = rsqrtf(wave_sum(ss) * (1.0f / D) + EPS);
#pragma unroll
    for (int j = 0; j < 4; ++j) {
        const f32x4 g = ((const f32x4*)gain)[lane + 64 * j]; const f32x4 o = v[j] * r * g;
        u32x2 w; w.x = cvt_pk_bf16(o.x, o.y); w.y = cvt_pk_bf16(o.z, o.w);
        ((u32x2*)orow)[lane + 64 * j] = w;
    }
}
__device__ __forceinline__ void postnorm_rows(const float* xin, float* xout, const float* mbuf, const float* g_post, const float* g_pre, bf16_t* XN, int gw, int ngw, int lane) {
    for (int row = gw; row < M; row += ngw) {
        const f32x4* mr = (const f32x4*)(mbuf + (size_t)row * D); const f32x4* xr = (const f32x4*)(xin + (size_t)row * D);
        f32x4 mv[4], xv[4]; float ss = 0.f;
#pragma unroll
        for (int j = 0; j < 4; ++j) { mv[j] = mr[lane + 64 * j]; xv[j] = xr[lane + 64 * j]; ss += (mv[j].x * mv[j].x + mv[j].y * mv[j].y) + (mv[j].z * mv[j].z + mv[j].w * mv[j].w); }
        const float r = rsqrtf(wave_sum(ss) * (1.0f / D) + EPS);
        float ss2 = 0.f;
#pragma unroll
        for (int j = 0; j < 4; ++j) {
            const f32x4 g = ((const f32x4*)g_post)[lane + 64 * j];
            xv[j] = xv[j] + mv[j] * r * g;
            ((f32x4*)(xout + (size_t)row * D))[lane + 64 * j] = xv[j];
            ss2 += (xv[j].x * xv[j].x + xv[j].y * xv[j].y) + (xv[j].z * xv[j].z + xv[j].w * xv[j].w);
        }
        if (g_pre) {
            const float r2 = rsqrtf(wave_sum(ss2) * (1.0f / D) + EPS);
#pragma unroll
            for (int j = 0; j < 4; ++j) {
                const f32x4 g = ((const f32x4*)g_pre)[lane + 64 * j]; const f32x4 o = xv[j] * r2 * g;
                u32x2 w; w.x = cvt_pk_bf16(o.x, o.y); w.y = cvt_pk_bf16(o.z, o.w);
                ((u32x2*)(XN + (size_t)row * D))[lane + 64 * j] = w;
            }
        }
    }
}

constexpr int HG_G = 0, HG_QR = 16384, HG_KR = HG_QR + 8704, HG_QIN = HG_KR + 8704, HG_KO = HG_QIN + 8704, HG_V = HG_KO + 8704, HG_STB = HG_V + 32 * 72 * 2, HG_END = HG_STB + 2 * 64 * 136 * 2;
static_assert(HG_END <= 131072, "hgrn lds");
__device__ __forceinline__ bf16x8 gather8(const LAS bf16_t* p, int stride) {
    unsigned a0 = p[0], a1 = p[stride], a2 = p[2 * stride], a3 = p[3 * stride], a4 = p[4 * stride], a5 = p[5 * stride], a6 = p[6 * stride], a7 = p[7 * stride];
    u32x4 w; w.x = a0 | (a1 << 16); w.y = a2 | (a3 << 16); w.z = a4 | (a5 << 16); w.w = a6 | (a7 << 16);
    return __builtin_bit_cast(bf16x8, w);
}
__device__ __forceinline__ bf16x8 gather8p(const LAS bf16_t* p, int stride) {
    unsigned a0 = p[0], a1 = p[stride], a2 = p[2 * stride], a3 = p[3 * stride], a4 = p[8 * stride], a5 = p[9 * stride], a6 = p[10 * stride], a7 = p[11 * stride];
    u32x4 w; w.x = a0 | (a1 << 16); w.y = a2 | (a3 << 16); w.z = a4 | (a5 << 16); w.w = a6 | (a7 << 16);
    return __builtin_bit_cast(bf16x8, w);
}
typedef short v4i16_t __attribute__((ext_vector_type(4)));
__device__ __forceinline__ s16x4 vtr(const LAS bf16_t* p) { return __builtin_bit_cast(s16x4, __builtin_amdgcn_ds_read_tr16_b64_v4i16((LAS v4i16_t*)p)); }
__device__ __forceinline__ bf16x8 cat8(s16x4 lo, s16x4 hi) { return (bf16x8){lo[0], lo[1], lo[2], lo[3], hi[0], hi[1], hi[2], hi[3]}; }
__device__ __forceinline__ bf16x8 pack8(const f32x16& p, int s) {
    u32x4 w;
    if (s == 0) { w.x = cvt_pk_bf16(p[0], p[1]); w.y = cvt_pk_bf16(p[2], p[3]); w.z = cvt_pk_bf16(p[4], p[5]); w.w = cvt_pk_bf16(p[6], p[7]); }
    else        { w.x = cvt_pk_bf16(p[8], p[9]); w.y = cvt_pk_bf16(p[10], p[11]); w.z = cvt_pk_bf16(p[12], p[13]); w.w = cvt_pk_bf16(p[14], p[15]); }
    return __builtin_bit_cast(bf16x8, w);
}

__device__ __forceinline__ void hgrn_unit(LAS unsigned char* lds, int unit, const bf16_t* Q0, const float* LOGF, const bf16_t* V0, bf16_t* OFB) {
    const int vs = unit & 1, dir = (unit >> 1) & 1, h = (unit >> 2) & 3, b = unit >> 4;
    int tid_ = threadIdx.x; asm volatile("" : "+v"(tid_)); const int tid = tid_, lane = tid & 63, wave = __builtin_amdgcn_readfirstlane(tid >> 6), l31 = lane & 31, hi = lane >> 5;
    LAS float* G = (LAS float*)(lds + HG_G);
    LAS bf16_t* QR = (LAS bf16_t*)(lds + HG_QR);
    LAS bf16_t* KR = (LAS bf16_t*)(lds + HG_KR);
    LAS bf16_t* QIN = (LAS bf16_t*)(lds + HG_QIN);
    LAS bf16_t* KO = (LAS bf16_t*)(lds + HG_KO);
    LAS bf16_t* VL = (LAS bf16_t*)(lds + HG_V);
    LAS bf16_t* STB = (LAS bf16_t*)(lds + HG_STB);
    const int r = tid >> 4, k0 = (tid & 15) * 8, v0 = (tid & 15) * 4;
    const int vt = wave >> 2, kt = wave & 3;
    for (int i = tid; i < 64 * 136 / 2; i += 512) ((LAS unsigned*)STB)[i] = 0u;
    f32x16 ST;
#pragma unroll
    for (int i = 0; i < 16; ++i) ST[i] = 0.f;
    const size_t tokb = (size_t)b * T;
    f32x4 nlf0, nlf1; u32x4 nq; u32x2 nv;
    {
        const int c = dir ? 63 : 0; const size_t tok = tokb + c * 32 + (dir ? 31 - r : r);
        const float* lp = LOGF + tok * 1024 + dir * 512 + h * 128 + k0; nlf0 = *(const f32x4*)lp; nlf1 = *(const f32x4*)(lp + 4);
        nq = *(const u32x4*)(Q0 + tok * 512 + h * 128 + k0);
        nv = *(const u32x2*)(V0 + tok * 512 + h * 128 + vs * 64 + v0);
    }
    int cur = 0;
    for (int ci = 0; ci < 64; ++ci) {
        const int c = dir ? 63 - ci : ci;
        const size_t base = tokb + (size_t)c * 32;
        float lf[8] = {nlf0.x, nlf0.y, nlf0.z, nlf0.w, nlf1.x, nlf1.y, nlf1.z, nlf1.w};
        const u32x4 qraw = nq;
        float kk[8];
#pragma unroll
        for (int j = 0; j < 8; ++j) kk[j] = 1.0f - __expf(lf[j]);
        *(LAS f32x4*)(G + r * 128 + k0) = nlf0; *(LAS f32x4*)(G + r * 128 + k0 + 4) = nlf1;
        *(LAS u32x2*)(VL + r * 72 + v0) = nv;
        if (ci + 1 < 64) {
            const int c2 = dir ? 62 - ci : ci + 1; const size_t tok = tokb + c2 * 32 + (dir ? 31 - r : r);
            const float* lp = LOGF + tok * 1024 + dir * 512 + h * 128 + k0; nlf0 = *(const f32x4*)lp; nlf1 = *(const f32x4*)(lp + 4);
            nq = *(const u32x4*)(Q0 + tok * 512 + h * 128 + k0);
            nv = *(const u32x2*)(V0 + tok * 512 + h * 128 + vs * 64 + v0);
        }
        __syncthreads();
        if (tid < 128) {
            float a = 0.f;
#pragma unroll
            for (int t = 0; t < 32; ++t) { a += G[t * 128 + tid]; G[t * 128 + tid] = a; }
        }
        __syncthreads();
        {
            float g[8], gr[8], gl[8];
            { const f32x4 a0 = *(LAS f32x4*)(G + r * 128 + k0), a1 = *(LAS f32x4*)(G + r * 128 + k0 + 4);
              const f32x4 b0 = *(LAS f32x4*)(G + 15 * 128 + k0), b1 = *(LAS f32x4*)(G + 15 * 128 + k0 + 4);
              const f32x4 c0 = *(LAS f32x4*)(G + 31 * 128 + k0), c1 = *(LAS f32x4*)(G + 31 * 128 + k0 + 4);
#pragma unroll
              for (int j = 0; j < 4; ++j) { g[j] = a0[j]; g[4 + j] = a1[j]; gr[j] = b0[j]; gr[4 + j] = b1[j]; gl[j] = c0[j]; gl[4 + j] = c1[j]; } }
            float q[8];
            q[0] = bf2f((unsigned short)(qraw.x & 0xffff)); q[1] = bf2f((unsigned short)(qraw.x >> 16));
            q[2] = bf2f((unsigned short)(qraw.y & 0xffff)); q[3] = bf2f((unsigned short)(qraw.y >> 16));
            q[4] = bf2f((unsigned short)(qraw.z & 0xffff)); q[5] = bf2f((unsigned short)(qraw.z >> 16));
            q[6] = bf2f((unsigned short)(qraw.w & 0xffff)); q[7] = bf2f((unsigned short)(qraw.w >> 16));
            float qr[8], kr[8], qi[8], ko[8];
#pragma unroll
            for (int j = 0; j < 8; ++j) {
                qr[j] = q[j] * __expf(g[j] - gr[j]); kr[j] = kk[j] * __expf(gr[j] - g[j]);
                qi[j] = q[j] * __expf(g[j]);         ko[j] = kk[j] * __expf(gl[j] - g[j]);
            }
            u32x4 w;
            w.x = cvt_pk_bf16(qr[0], qr[1]); w.y = cvt_pk_bf16(qr[2], qr[3]); w.z = cvt_pk_bf16(qr[4], qr[5]); w.w = cvt_pk_bf16(qr[6], qr[7]); *(LAS u32x4*)(QR + r * 136 + k0) = w;
            w.x = cvt_pk_bf16(kr[0], kr[1]); w.y = cvt_pk_bf16(kr[2], kr[3]); w.z = cvt_pk_bf16(kr[4], kr[5]); w.w = cvt_pk_bf16(kr[6], kr[7]); *(LAS u32x4*)(KR + r * 136 + k0) = w;
            w.x = cvt_pk_bf16(qi[0], qi[1]); w.y = cvt_pk_bf16(qi[2], qi[3]); w.z = cvt_pk_bf16(qi[4], qi[5]); w.w = cvt_pk_bf16(qi[6], qi[7]); *(LAS u32x4*)(QIN + r * 136 + k0) = w;
            w.x = cvt_pk_bf16(ko[0], ko[1]); w.y = cvt_pk_bf16(ko[2], ko[3]); w.z = cvt_pk_bf16(ko[4], ko[5]); w.w = cvt_pk_bf16(ko[6], ko[7]); *(LAS u32x4*)(KO + r * 136 + k0) = w;
        }
        __syncthreads();
        if (wave < 2) {
            const int ot = wave;
            f32x16 p;
#pragma unroll
            for (int i = 0; i < 16; ++i) p[i] = 0.f;
#pragma unroll
            for (int ks = 0; ks < 8; ++ks) {
                const bf16x8 a = *(const LAS bf16x8*)(KR + l31 * 136 + 16 * ks + 8 * hi);
                const bf16x8 bq = *(const LAS bf16x8*)(QR + l31 * 136 + 16 * ks + 8 * hi);
                p = MFMA32(a, bq, p);
            }
#pragma unroll
            for (int i = 0; i < 16; ++i) { if (crow(i, hi) > l31) p[i] = 0.f; }
            const bf16x8 pf0 = pack8(p, 0), pf1 = pack8(p, 1);
            f32x16 o;
#pragma unroll
            for (int i = 0; i < 16; ++i) o[i] = 0.f;
            { const LAS bf16_t* vp = VL + (4 * hi + ((lane & 15) >> 2)) * 72 + 16 * ((lane >> 4) & 1) + 4 * (lane & 3) + ot * 32;
              const bf16x8 a0 = cat8(vtr(vp), vtr(vp + 8 * 72)); o = MFMA32(a0, pf0, o);
              const bf16x8 a1 = cat8(vtr(vp + 16 * 72), vtr(vp + 24 * 72)); o = MFMA32(a1, pf1, o); }
            const LAS bf16_t* stb = STB + cur * (64 * 136);
#pragma unroll
            for (int ks = 0; ks < 8; ++ks) {
                const bf16x8 a = *(const LAS bf16x8*)(stb + (ot * 32 + l31) * 136 + 16 * ks + 8 * hi);
                const bf16x8 bq = *(const LAS bf16x8*)(QIN + l31 * 136 + 16 * ks + 8 * hi);
                o = MFMA32(a, bq, o);
            }
            const size_t tok = base + (dir ? 31 - l31 : l31);
            bf16_t* op = OFB + ((size_t)dir * M + tok) * 512 + h * 128 + vs * 64 + ot * 32 + 4 * hi;
#pragma unroll
            for (int g4 = 0; g4 < 4; ++g4) { u32x2 w; w.x = cvt_pk_bf16(o[4 * g4], o[4 * g4 + 1]); w.y = cvt_pk_bf16(o[4 * g4 + 2], o[4 * g4 + 3]); *(u32x2*)(op + 8 * g4) = w; }
        }
        {
            const float dec = __expf(G[31 * 128 + kt * 32 + l31]);
#pragma unroll
            for (int i = 0; i < 16; ++i) ST[i] *= dec;
#pragma unroll
            for (int st = 0; st < 2; ++st) {
                const LAS bf16_t* vp = VL + (16 * st + 8 * hi + ((lane & 15) >> 2)) * 72 + 16 * ((lane >> 4) & 1) + 4 * (lane & 3) + vt * 32;
                const LAS bf16_t* kp = KO + (16 * st + 8 * hi + ((lane & 15) >> 2)) * 136 + 16 * ((lane >> 4) & 1) + 4 * (lane & 3) + kt * 32;
                const bf16x8 a = cat8(vtr(vp), vtr(vp + 4 * 72));
                const bf16x8 bk = cat8(vtr(kp), vtr(kp + 4 * 136));
                ST = MFMA32(a, bk, ST);
            }
            LAS bf16_t* stn = STB + (cur ^ 1) * (64 * 136);
#pragma unroll
            for (int i = 0; i < 16; ++i) stn[(vt * 32 + crow(i, hi)) * 136 + kt * 32 + l31] = (bf16_t)f2bf(ST[i]);
        }
        __syncthreads();
        cur ^= 1;
    }
}

constexpr int AT_K = 0, AT_V = 384 * 72 * 2, AT_END = 2 * 384 * 72 * 2;
static_assert(AT_END <= 131072, "attn lds");
__device__ __forceinline__ void attn_unit(LAS unsigned char* lds, int unit, const bf16_t* QKV, const float* sink, bf16_t* OUT) {
    const int qb = unit & 15, kv = (unit >> 4) & 3, b = unit >> 6;
    int tid_ = threadIdx.x; asm volatile("" : "+v"(tid_)); const int tid = tid_, lane = tid & 63, wave = __builtin_amdgcn_readfirstlane(tid >> 6), l31 = lane & 31, hi = lane >> 5;
    LAS bf16_t* KL = (LAS bf16_t*)(lds + AT_K);
    LAS bf16_t* VL = (LAS bf16_t*)(lds + AT_V);
    const int Q0p = qb * 128, kbase = Q0p - 128;
    const size_t tokb = (size_t)b * T;
#pragma unroll
    for (int it = 0; it < 6; ++it) {
        const int idx = tid + it * 512, row = idx >> 3, c8 = idx & 7, pos = kbase + row;
        u32x4 kx = {0u, 0u, 0u, 0u}, vx = {0u, 0u, 0u, 0u};
        if (pos >= 0 && pos < T) {
            const bf16_t* p = QKV + (tokb + pos) * 1536 + kv * 64 + c8 * 8;
            kx = *(const u32x4*)(p + 1024); vx = *(const u32x4*)(p + 1280);
        }
        *(LAS u32x4*)(KL + row * 72 + c8 * 8) = kx; *(LAS u32x4*)(VL + row * 72 + c8 * 8) = vx;
    }
    __syncthreads();
    const int g = wave >> 1, hh = kv * 4 + g, half = wave & 1;
    const float slope2 = exp2f(-0.5f * (float)(hh + 1)) * LOG2E, sink2 = sink[hh] * LOG2E;
    const LAS bf16_t* vtr0 = VL + (4 * hi + ((lane & 15) >> 2)) * 72 + 16 * ((lane >> 4) & 1) + 4 * (lane & 3);
    for (int qt = 0; qt < 2; ++qt) {
        const int q0l = half * 64 + qt * 32, qpos = Q0p + q0l + l31;
        bf16x8 qf[4];
        { const bf16_t* qp = QKV + (tokb + qpos) * 1536 + hh * 64 + 8 * hi;
#pragma unroll
          for (int s = 0; s < 4; ++s) qf[s] = *(const bf16x8*)(qp + 16 * s); }
        float mrun = sink2, lsum = hi == 0 ? 1.0f : 0.0f;
        f32x16 o0, o1;
#pragma unroll
        for (int i = 0; i < 16; ++i) { o0[i] = 0.f; o1[i] = 0.f; }
        for (int kt = 0; kt < 9; ++kt) {
            const int krow0 = q0l + 32 * kt, kpos0 = kbase + krow0;
            if (kpos0 + 31 < 0 || kpos0 >= T) continue;
            f32x16 s;
#pragma unroll
            for (int i = 0; i < 16; ++i) s[i] = 0.f;
#pragma unroll
            for (int ks = 0; ks < 4; ++ks) {
                const bf16x8 a = *(const LAS bf16x8*)(KL + (krow0 + l31) * 72 + 16 * ks + 8 * hi);
                s = MFMA32(a, qf[ks], s);
            }
            if (kt == 4) {
#pragma unroll
                for (int i = 0; i < 16; ++i) { const int dd = qpos - (kpos0 + crow(i, hi)); s[i] = __builtin_fmaf(-slope2, (float)(dd < 0 ? -dd : dd), s[i]); }
            } else {
                const float sg = kt < 4 ? 1.0f : -1.0f;
                const int dq = qpos - kpos0 - 4 * hi;
                const float base = -slope2 * sg * (float)dq, step = slope2 * sg;
#pragma unroll
                for (int i = 0; i < 16; ++i) s[i] = __builtin_fmaf(step, (float)((i & 3) + 8 * (i >> 2)), s[i] + base);
                if (kt == 0) {
#pragma unroll
                    for (int i = 0; i < 16; ++i) { if (dq - ((i & 3) + 8 * (i >> 2)) > 128) s[i] = -INFINITY; }
                }
                if (kt == 8) {
#pragma unroll
                    for (int i = 0; i < 16; ++i) { if (((i & 3) + 8 * (i >> 2)) - dq > 128) s[i] = -INFINITY; }
                }
            }
            float tmax = s[0];
#pragma unroll
            for (int i = 1; i < 16; ++i) tmax = fmaxf(tmax, s[i]);
            tmax = fmaxf(tmax, __shfl_xor(tmax, 32));
            const float mnew = fmaxf(mrun, tmax), alpha = __builtin_amdgcn_exp2f(mrun - mnew);
            mrun = mnew; lsum *= alpha;
#pragma unroll
            for (int i = 0; i < 16; ++i) { o0[i] *= alpha; o1[i] *= alpha; }
            float ps = 0.f;
#pragma unroll
            for (int i = 0; i < 16; ++i) { const float pe = __builtin_amdgcn_exp2f(s[i] - mnew); s[i] = pe; ps += pe; }
            lsum += ps;
            const bf16x8 pf0 = pack8(s, 0), pf1 = pack8(s, 1);
            const LAS bf16_t* vp = vtr0 + krow0 * 72;
            { const bf16x8 a = cat8(vtr(vp), vtr(vp + 8 * 72)); o0 = MFMA32(a, pf0, o0); }
            { const bf16x8 a = cat8(vtr(vp + 32), vtr(vp + 8 * 72 + 32)); o1 = MFMA32(a, pf0, o1); }
            { const bf16x8 a = cat8(vtr(vp + 16 * 72), vtr(vp + 24 * 72)); o0 = MFMA32(a, pf1, o0); }
            { const bf16x8 a = cat8(vtr(vp + 16 * 72 + 32), vtr(vp + 24 * 72 + 32)); o1 = MFMA32(a, pf1, o1); }
        }
        const float ltot = lsum + __shfl_xor(lsum, 32), inv = 1.0f / ltot;
        bf16_t* op = OUT + (tokb + qpos) * 1024 + hh * 64 + 4 * hi;
#pragma unroll
        for (int g4 = 0; g4 < 4; ++g4) {
            u32x2 w; w.x = cvt_pk_bf16(o0[4 * g4] * inv, o0[4 * g4 + 1] * inv); w.y = cvt_pk_bf16(o0[4 * g4 + 2] * inv, o0[4 * g4 + 3] * inv); *(u32x2*)(op + 8 * g4) = w;
            u32x2 w2; w2.x = cvt_pk_bf16(o1[4 * g4] * inv, o1[4 * g4 + 1] * inv); w2.y = cvt_pk_bf16(o1[4 * g4 + 2] * inv, o1[4 * g4 + 3] * inv); *(u32x2*)(op + 32 + 8 * g4) = w2;
        }
    }
    __syncthreads();
}

struct Args { const float* in[12]; float* out; unsigned char* ws; };

__device__ __forceinline__ void prologue(const Args& a, LAS unsigned char* lds, int gw, int ngw, int wave, int lane) {
    unsigned char* ws = a.ws;
    LAS float* scr = (LAS float*)(lds + wave * 16384);
    const float* w_in = a.in[2];
    constexpr int I_DFT = 2048, I_T1 = 16 * 80, I_T2 = 16 * 32, I_T3 = 16 * 48, I_T4 = 16 * 32, I_T5 = 2 * 16 * 88, I_T6 = I_T5, I_T7 = 2 * 44 * 32;
    constexpr int NITEMS = I_DFT + I_T1 + I_T2 + I_T3 + I_T4 + I_T5 + I_T6 + I_T7;
    if (wave < 2) {
        const int G_ = ngw >> 3, bid_ = gw >> 3;
        bf16_t* Wcs = (bf16_t*)(ws + WS_WCS);
        for (int j = wave * G_ + bid_; j < 512; j += 2 * G_) {
            const int g = j >> 7, k0 = (j & 127) * 8;
#pragma unroll
            for (int i = 0; i < 4; ++i) { const int idx = i * 64 + lane, kk = idx >> 5, c4 = idx & 31; *(LAS f32x4*)(scr + kk * 128 + 4 * c4) = *(const f32x4*)(w_in + (size_t)(k0 + kk) * 3072 + 2560 + g * 128 + 4 * c4); }
            LDS_WAIT();
            float aca[8], asa[8], acb[8], asb[8];
#pragma unroll
            for (int kk = 0; kk < 8; ++kk) { aca[kk] = 0.f; asa[kk] = 0.f; acb[kk] = 0.f; asb[kk] = 0.f; }
            for (int c = 0; c < 128; ++c) {
                const float ph = (float)((lane * c) & 127) * (1.0f / 128.0f);
                const float ca = __builtin_amdgcn_cosf(ph), sa = __builtin_amdgcn_sinf(ph);
                const float cb = (c & 1) ? -ca : ca, sb = (c & 1) ? -sa : sa;
#pragma unroll
                for (int kk = 0; kk < 8; ++kk) { const float w = scr[kk * 128 + c]; aca[kk] += w * ca; asa[kk] += w * sa; acb[kk] += w * cb; asb[kk] += w * sb; }
            }
            u32x4 o;
            o.x = cvt_pk_bf16(aca[0], aca[1]); o.y = cvt_pk_bf16(aca[2], aca[3]); o.z = cvt_pk_bf16(aca[4], aca[5]); o.w = cvt_pk_bf16(aca[6], aca[7]); *(u32x4*)(Wcs + (size_t)(g * 128 + lane) * 1024 + k0) = o;
            o.x = cvt_pk_bf16(acb[0], acb[1]); o.y = cvt_pk_bf16(acb[2], acb[3]); o.z = cvt_pk_bf16(acb[4], acb[5]); o.w = cvt_pk_bf16(acb[6], acb[7]); *(u32x4*)(Wcs + (size_t)(g * 128 + lane + 64) * 1024 + k0) = o;
            o.x = cvt_pk_bf16(asa[0], asa[1]); o.y = cvt_pk_bf16(asa[2], asa[3]); o.z = cvt_pk_bf16(asa[4], asa[5]); o.w = cvt_pk_bf16(asa[6], asa[7]); *(u32x4*)(Wcs + (size_t)(512 + g * 128 + lane) * 1024 + k0) = o;
            o.x = cvt_pk_bf16(asb[0], asb[1]); o.y = cvt_pk_bf16(asb[2], asb[3]); o.z = cvt_pk_bf16(asb[4], asb[5]); o.w = cvt_pk_bf16(asb[6], asb[7]); *(u32x4*)(Wcs + (size_t)(512 + g * 128 + lane + 64) * 1024 + k0) = o;
            LDS_WAIT();
        }
    }
    for (int it0 = gw; it0 < NITEMS; it0 += ngw) {
        int it = it0;
        if (it < I_DFT) {
            const int k1 = it; bf16_t* dr = (bf16_t*)(ws + WS_DFT) + (size_t)k1 * 4096;
#pragma unroll 2
            for (int i = 0; i < 8; ++i) {
                const int col0 = (i * 64 + lane) * 8, cs = col0 >> 11;
                float v[8];
#pragma unroll
                for (int j = 0; j < 8; ++j) {
                    const int t = (col0 + j) & 2047; const float ph = (float)((k1 * t) & 2047) * (1.0f / 2048.0f);
                    v[j] = (cs ? -__builtin_amdgcn_sinf(ph) : __builtin_amdgcn_cosf(ph)) * (1.0f / 512.0f);
                }
                u32x4 o; o.x = cvt_pk_bf16(v[0], v[1]); o.y = cvt_pk_bf16(v[2], v[3]); o.z = cvt_pk_bf16(v[4], v[5]); o.w = cvt_pk_bf16(v[6], v[7]);
                *(u32x4*)(dr + col0) = o;
            }
            continue;
        }
        it -= I_DFT;
        if (it < I_T1) { const int kb = it / 80, nb = it % 80; transpose_item(w_in, 3072, 1024, (bf16_t*)(ws + WS_WP), kb * 64, nb * 32, nb * 32, scr, lane); continue; }
        it -= I_T1;
        if (it < I_T2) { const int kb = it / 32, nb = it % 32; transpose_item(a.in[5], 1024, 1024, (bf16_t*)(ws + WS_WO0), kb * 64, nb * 32, nb * 32, scr, lane); continue; }
        it -= I_T2;
        if (it < I_T3) { const int kb = it / 48, nb = it % 48; transpose_item(a.in[6], 1536, 1024, (bf16_t*)(ws + WS_WQKV), kb * 64, nb * 32, nb * 32, scr, lane); continue; }
        it -= I_T3;
        if (it < I_T4) { const int kb = it / 32, nb = it % 32; transpose_item(a.in[8], 1024, 1024, (bf16_t*)(ws + WS_WO1), kb * 64, nb * 32, nb * 32, scr, lane); continue; }
        it -= I_T4;
        if (it < I_T5 + I_T6) {
            const int which = it >= I_T5; if (which) it -= I_T5;
            const int layer = it / (16 * 88); it -= layer * (16 * 88);
            const int kb = it / 88, nb = it % 88, n0 = nb * 32;
            const float* src = (which ? a.in[10] : a.in[9]) + (size_t)layer * 1024 * FF;
            transpose_item(src, FF, 1024, (bf16_t*)(ws + WS_W13) + (size_t)layer * W13_STRIDE, kb * 64, n0, 256 * (n0 >> 7) + 128 * which + (n0 & 127), scr, lane); continue;
        }
        it -= I_T5 + I_T6;
        { const int layer = it / (44 * 32); it -= layer * (44 * 32);
          const int kb = it / 32, nb = it % 32;
          transpose_item(a.in[11] + (size_t)layer * FF * 1024, 1024, FF, (bf16_t*)(ws + WS_W2) + (size_t)layer * W2_STRIDE, kb * 64, nb * 32, nb * 32, scr, lane); }
    }
    for (int row = gw; row < M; row += ngw) rms_row_to_bf16(a.in[0] + (size_t)row * D, a.in[1], (bf16_t*)(ws + WS_XN) + (size_t)row * D, lane);
}

#ifndef PHMASK
#define PHMASK 0xffff
#endif
#ifndef REP_HGRN
#define REP_HGRN 1
#endif
#ifndef REP_SYNC
#define REP_SYNC 1
#endif
#ifndef REP_PRO
#define REP_PRO 1
#endif
#ifndef REP_ATTN
#define REP_ATTN 1
#endif
#ifndef REP_FNET
#define REP_FNET 1
#endif
#ifndef REP_GEMM
#define REP_GEMM 1
#endif
#define GSYNC() do { for (int r_ = 0; r_ < REP_SYNC; ++r_) xcd_barrier(xbar); } while (0)

__global__ void __launch_bounds__(512, 2) fwd_megakernel(Args a) {
    extern __shared__ __attribute__((aligned(16))) unsigned char lds_raw[];
    LAS unsigned char* lds = (LAS unsigned char*)lds_raw;
    cg::grid_group grid = cg::this_grid();
    const int tid = threadIdx.x, lane = tid & 63, wave = __builtin_amdgcn_readfirstlane(tid >> 6);
    const int G = gridDim.x, bid = blockIdx.x, gw = bid * 8 + wave, ngw = G * 8;
    unsigned char* ws = a.ws;
    bf16_t* XN = (bf16_t*)(ws + WS_XN); float* MBUF = (float*)(ws + WS_MBUF);
    bf16_t* ACAT = (bf16_t*)(ws + WS_ACAT); bf16_t* HB = (bf16_t*)(ws + WS_H);
    float* LOGF = a.out;
    const float* gains = a.in[1];
    if (tid < 64) ((LAS unsigned*)(lds + 131072))[tid] = 0u;
    __syncthreads();
    grid.sync();
    XcdBarrier xbar = xcd_barrier_post((unsigned*)ws, (volatile LAS unsigned*)(lds + 131072 + 32));

#if PHMASK & 1
    for (int rp = 0; rp < REP_PRO; ++rp) prologue(a, lds, gw, ngw, wave, lane);
#endif
    GSYNC();

#if PHMASK & 2
    {
        pg8::Gemm g{XN, (const bf16_t*)(ws + WS_WP), M, 2560, 1024}; pg8::StaticOrder S; S.init(M, 2560, G, bid);
        EpiProj E{(bf16_t*)(ws + WS_Q0), LOGF, a.in[3]};
        static_assert(WS_V0 == WS_Q0 + (size_t)M * 512 * 2 && WS_GATE == WS_V0 + (size_t)M * 512 * 2, "Q0 | V0 | GATE consecutive");
        { pg8::gemm_phase<EpiProj, pg8::StaticOrder, true, true>(lds, g, S, E);
#if REP_GEMM > 1
        pg8::gemm_phase<EpiProj, pg8::StaticOrder, true, true>(lds, g, S, E);
#endif
        }
    }
#endif
#if PHMASK & 4
    {
        pg8::Gemm g{(const bf16_t*)(ws + WS_WCS), XN, 1024, M, 1024}; pg8::StaticOrder S; S.init(1024, M, G, bid);
        EpiYt E{(bf16_t*)(ws + WS_YT)};
        { pg8::gemm_phase<EpiYt, pg8::StaticOrder, true, true>(lds, g, S, E);
#if REP_GEMM > 1
        pg8::gemm_phase<EpiYt, pg8::StaticOrder, true, true>(lds, g, S, E);
#endif
        }
    }
#endif
    GSYNC();

    {
        const bool split = (G % 16) == 0;
        const bool do_f = !split || (((bid >> 3) & 1) == 0), do_h = !split || (((bid >> 3) & 1) == 1);
        const int gsz = split ? G / 2 : G, gidx = split ? (bid >> 4) * 8 + (bid & 7) : bid;
#if PHMASK & 8
        if (do_f) for (int rp = 0; rp < REP_FNET; ++rp) {
            pg8::Gemm g{(const bf16_t*)(ws + WS_DFT), (const bf16_t*)(ws + WS_YT), 2048, 4096, 4096}; pg8::StaticOrder S; S.init(2048, 4096, gsz, gidx);
            EpiFnet E{ACAT};
            pg8::gemm_phase<EpiFnet, pg8::StaticOrder, true, true>(lds, g, S, E);
        }
#endif
#if PHMASK & 16
        if (do_h) {
            for (int rp = 0; rp < REP_HGRN; ++rp) for (int u = gidx; u < 128; u += gsz) hgrn_unit(lds, u, (const bf16_t*)(ws + WS_Q0), LOGF, (const bf16_t*)(ws + WS_V0), (bf16_t*)(ws + WS_OFB));
        }
#endif
    }
    GSYNC();

    {
        const bf16_t* OFB = (const bf16_t*)(ws + WS_OFB); const bf16_t* GATE = (const bf16_t*)(ws + WS_GATE); const float* og = a.in[4];
        for (int row = gw; row < M; row += ngw) {
            const u32x4 f = *(const u32x4*)(OFB + (size_t)row * 512 + lane * 8), bw = *(const u32x4*)(OFB + ((size_t)M + row) * 512 + lane * 8), gt = *(const u32x4*)(GATE + (size_t)row * 512 + lane * 8);
            float o[8]; float ss = 0.f;
#pragma unroll
            for (int j = 0; j < 4; ++j) {
                o[2 * j] = bf2f((unsigned short)(f[j] & 0xffff)) + bf2f((unsigned short)(bw[j] & 0xffff));
                o[2 * j + 1] = bf2f((unsigned short)(f[j] >> 16)) + bf2f((unsigned short)(bw[j] >> 16));
                ss += o[2 * j] * o[2 * j] + o[2 * j + 1] * o[2 * j + 1];
            }
            ss += __shfl_xor(ss, 1); ss += __shfl_xor(ss, 2); ss += __shfl_xor(ss, 4); ss += __shfl_xor(ss, 8);
            const float r = rsqrtf(ss * (1.0f / 128.0f) + EPS);
            const f32x4 g0 = *(const f32x4*)(og + lane * 8), g1 = *(const f32x4*)(og + lane * 8 + 4);
            float res[8];
#pragma unroll
            for (int j = 0; j < 4; ++j) {
                res[2 * j] = o[2 * j] * r * (2 * j < 4 ? g0[2 * j] : g1[2 * j - 4]) * bf2f((unsigned short)(gt[j] & 0xffff));
                res[2 * j + 1] = o[2 * j + 1] * r * (2 * j + 1 < 4 ? g0[2 * j + 1] : g1[2 * j + 1 - 4]) * bf2f((unsigned short)(gt[j] >> 16));
            }
            u32x4 w; w.x = cvt_pk_bf16(res[0], res[1]); w.y = cvt_pk_bf16(res[2], res[3]); w.z = cvt_pk_bf16(res[4], res[5]); w.w = cvt_pk_bf16(res[6], res[7]);
            *(u32x4*)(ACAT + (size_t)row * 1024 + lane * 8) = w;
        }
    }
    GSYNC();

#pragma unroll
    for (int layer = 0; layer < 2; ++layer) {
        const float* gl = gains + (size_t)layer * 4 * D;
        if (layer == 1) {
            {
                pg8::Gemm g{XN, (const bf16_t*)(ws + WS_WQKV), M, 1536, 1024}; pg8::StaticOrder S; S.init(M, 1536, G, bid);
                EpiQKV E{(bf16_t*)(ws + WS_QKV1)};
                { pg8::gemm_phase<EpiQKV, pg8::StaticOrder, true, true>(lds, g, S, E);
#if REP_GEMM > 1
        pg8::gemm_phase<EpiQKV, pg8::StaticOrder, true, true>(lds, g, S, E);
#endif
        }
            }
            GSYNC();
#if PHMASK & 32
            for (int rp = 0; rp < REP_ATTN; ++rp) for (int u = bid; u < 512; u += G) attn_unit(lds, u, (const bf16_t*)(ws + WS_QKV1), a.in[7], ACAT);
#endif
            GSYNC();
        }
        {
            pg8::Gemm g{ACAT, (const bf16_t*)(ws + (layer == 0 ? WS_WO0 : WS_WO1)), M, 1024, 1024}; pg8::StaticOrder S; S.init(M, 1024, G, bid);
            if (layer == 0) { typedef EpiRmsRes<0, 1 * D, 2 * D> EP; EP E{a.in[0], a.out, ws, gains}; pg8::gemm_phase<EP, pg8::StaticOrder, false, true>(lds, g, S, E); }
            else            { typedef EpiRmsRes<4, 5 * D, 6 * D> EP; EP E{a.out, a.out, ws, gains}; pg8::gemm_phase<EP, pg8::StaticOrder, false, true>(lds, g, S, E); }
        }
        GSYNC();
        {
            pg8::Gemm g{XN, (const bf16_t*)(ws + WS_W13) + (size_t)layer * W13_STRIDE, M, 5632, 1024}; pg8::StaticOrder S; S.init(M, 5632, G, bid);
            EpiSwiglu E{HB};
            { pg8::gemm_phase<EpiSwiglu, pg8::StaticOrder, true, true>(lds, g, S, E);
#if REP_GEMM > 1
        pg8::gemm_phase<EpiSwiglu, pg8::StaticOrder, true, true>(lds, g, S, E);
#endif
        }
        }
        GSYNC();
        {
            pg8::Gemm g{HB, (const bf16_t*)(ws + WS_W2) + (size_t)layer * W2_STRIDE, M, 1024, FF}; pg8::StaticOrder S; S.init(M, 1024, G, bid);
            if (layer == 0) { typedef EpiRmsRes<2, 3 * D, 4 * D> EP; EP E{a.out, a.out, ws, gains}; pg8::gemm_phase<EP, pg8::StaticOrder, false, true>(lds, g, S, E); }
            else            { typedef EpiRmsRes<6, 7 * D, -1> EP;    EP E{a.out, a.out, ws, gains}; pg8::gemm_phase<EP, pg8::StaticOrder, false, true>(lds, g, S, E); }
        }
        if (layer == 0) GSYNC();
    }
}

extern "C" void kernel_launch(void* const* d_in, const int* in_sizes, int n_in, void* d_out, int out_size, void* d_ws, size_t ws_size, hipStream_t stream) {
    static int grid = 0;
    if (grid == 0) {
        if (n_in != 12 || out_size != M * D || ws_size < WS_END) { fprintf(stderr, "kernel_launch: unexpected shapes (n_in %d out %d ws %zu)\n", n_in, out_size, ws_size); grid = -1; return; }
        int dev = 0, cus = 0, per_cu = 0;
        hipGetDevice(&dev); hipDeviceGetAttribute(&cus, hipDeviceAttributeMultiprocessorCount, dev);
        if (hipFuncSetAttribute((const void*)fwd_megakernel, hipFuncAttributeMaxDynamicSharedMemorySize, LDS_BYTES) != hipSuccess) { fprintf(stderr, "kernel_launch: hipFuncSetAttribute failed\n"); grid = -1; return; }
        if (hipOccupancyMaxActiveBlocksPerMultiprocessor(&per_cu, (const void*)fwd_megakernel, 512, LDS_BYTES) != hipSuccess || per_cu < 1) { fprintf(stderr, "kernel_launch: occupancy query gave %d\n", per_cu); per_cu = 1; }
        (void)hipGetLastError();
        grid = cus;
    }
    if (grid < 0) return;
    Args a{};
    for (int i = 0; i < 12; ++i) a.in[i] = (const float*)d_in[i];
    a.out = (float*)d_out; a.ws = (unsigned char*)d_ws;
    if (hipMemsetAsync(d_ws, 0, 65536 + 8 * 16384, stream) != hipSuccess) { fprintf(stderr, "kernel_launch: memset failed\n"); return; }
    void* args[] = {&a};
    hipError_t e = hipLaunchCooperativeKernel((const void*)fwd_megakernel, dim3(grid), dim3(512), args, LDS_BYTES, stream);
    if (e != hipSuccess) fprintf(stderr, "cooperative launch failed: %s (grid %d)\n", hipGetErrorString(e), grid);
}
```

```cpp
#include <hip/hip_runtime.h>
#include <hip/hip_cooperative_groups.h>
#include <cstdio>
#include <cstdint>
namespace cg = cooperative_groups;
namespace pg8 {
#define PG8_LAS __attribute__((address_space(3)))
typedef unsigned short bf16_t;
typedef short bf16x8 __attribute__((ext_vector_type(8)));
typedef float f32x4 __attribute__((ext_vector_type(4)));
typedef unsigned u32x4 __attribute__((ext_vector_type(4)));
constexpr int BM = 256, BK = 64, HALF = 128, HTB = HALF * BK * 2  , STAGE_BYTES = 8 * HTB, NXCD = 8, WGM = 8;

__host__ __device__ __forceinline__ int lds_byte(int r, int c) { const int st = (r >> 4) * 2 + (c >> 5), rr = r & 15, cc = c & 31, ob = rr * 64 + cc * 2; return st * 1024 + (ob ^ (((ob >> 9) & 1) << 5)); }
__host__ __device__ __forceinline__ void stage_rc(int b, int& R, int& C) { const int st = b / 1024, sb = b % 1024, swz = sb ^ (((sb >> 9) & 1) << 5); R = (st >> 1) * 16 + swz / 64; C = (st & 1) * 32 + (swz % 64) / 2; }
__host__ __device__ __forceinline__ int perm32(int rho) { const int n = rho >> 4, i = rho & 15; return 8 * (i >> 2) + 4 * n + (i & 3); }

struct Unit { int pm, pn; };
struct Gemm { const bf16_t* A; const bf16_t* Bt; int M, N, K; };

struct StaticOrder {
    int nM, nN, nwg, G, c;
    __host__ __device__ void init(int M, int N, int G_, int c_) { nM = M / BM; nN = N / BM; nwg = nM * nN; G = G_; c = c_; }
    __host__ __device__ bool next(int i, Unit& u) const {
        const long L = (long)i * G + c; if (L >= nwg) return false;
        int wgid = (int)L; { const int q = nwg / NXCD, r = nwg % NXCD, xcd = wgid % NXCD, off = wgid / NXCD; wgid = (xcd < r ? xcd * (q + 1) : r * (q + 1) + (xcd - r) * q) + off; }
        const int nig = WGM * nN, gid = wgid / nig, fm = gid * WGM, gsz = (nM - fm) < WGM ? (nM - fm) : WGM;
        u.pm = fm + ((wgid % nig) % gsz); u.pn = (wgid % nig) / gsz; return true;
    }
    __device__ __forceinline__ void a_ready(const Unit&) const {}
    __device__ __forceinline__ void done(const Unit&) const {}
};

typedef float f32x2_t __attribute__((ext_vector_type(2))); typedef __bf16 bf16x2_t __attribute__((ext_vector_type(2)));
__device__ __forceinline__ unsigned cvt_pk_bf16(float lo, float hi) { f32x2_t v = {lo, hi}; bf16x2_t b = __builtin_convertvector(v, bf16x2_t); return __builtin_bit_cast(unsigned, b); }
template <class Epi, class Sched, bool ALIGN_EPI = false, bool SP2 = false>
__device__ __forceinline__ void gemm_phase(PG8_LAS unsigned char* lds, const Gemm g, const Sched& S, const Epi& E) {
    int tid_ = threadIdx.x; asm volatile("" : "+v"(tid_));
    const int tid = tid_, wid = __builtin_amdgcn_readfirstlane(tid >> 6), lane = tid & 63, wr = wid >> 2, wc = wid & 3, fr = lane & 15, fq = lane >> 4;
    const int K = g.K, nt = K / BK;
    unsigned voffA[2], voffB[2];
#pragma unroll
    for (int i = 0; i < 2; ++i) { int R, C; stage_rc(tid * 16 + i * 8192, R, C); const int Rb = Epi::PERM ? ((R & ~31) + perm32(R & 31)) : R;
        voffA[i] = (unsigned)(R * K + C) * 2u; voffB[i] = (unsigned)(Rb * K + C) * 2u; }
    const size_t kstep = (size_t)(BK * 2);
    const size_t hstep = (size_t)HALF * K * 2;
    const size_t tstep = 2 * hstep;
    const unsigned ldsw = (unsigned)wid * 1024u;
    const int aoff = lds_byte(wr * 64 + fr, fq * 8), boff = lds_byte(wc * 32 + fr, fq * 8);
#define PG8_SA(b, h) (((b) * 2 + (h)) * HTB)
#define PG8_SB(b, h) ((4 + (b) * 2 + (h)) * HTB)
#define PG8_STAGE(bufoff, gbase, voff) do { _Pragma("unroll") for (int _i = 0; _i < 2; ++_i) \
        __builtin_amdgcn_global_load_lds((const unsigned*)((const char*)(gbase) + (voff)[_i]), (PG8_LAS unsigned*)(lds + (bufoff) + ldsw + _i * 8192), 16, 0, 0); } while (0)
#define PG8_LDA(dst, b, h) do { _Pragma("unroll") for (int m = 0; m < 4; ++m) _Pragma("unroll") for (int k = 0; k < 2; ++k) dst[m][k] = *(const PG8_LAS bf16x8*)(lds + PG8_SA(b, h) + aoff + m * 2048 + k * 1024); } while (0)
#define PG8_LDB(dst, b, h) do { _Pragma("unroll") for (int n = 0; n < 2; ++n) _Pragma("unroll") for (int k = 0; k < 2; ++k) dst[n][k] = *(const PG8_LAS bf16x8*)(lds + PG8_SB(b, h) + boff + n * 2048 + k * 1024); } while (0)
#define PG8_MMA(ai, bj, At, Bt) do { __builtin_amdgcn_s_setprio(1); _Pragma("unroll") for (int m = 0; m < 4; ++m) _Pragma("unroll") for (int n = 0; n < 2; ++n) _Pragma("unroll") for (int k = 0; k < 2; ++k) \
        acc[ai][bj][m][n] = __builtin_amdgcn_mfma_f32_16x16x32_bf16(Bt[n][k], At[m][k], acc[ai][bj][m][n], 0, 0, 0); __builtin_amdgcn_s_setprio(0); } while (0)
#define PG8_WAIT_V(n) asm volatile("s_waitcnt vmcnt(" #n ")" ::: "memory")
#define PG8_WAIT_L(n) asm volatile("s_waitcnt lgkmcnt(" #n ")" ::: "memory")
#define PG8_BAR __builtin_amdgcn_s_barrier()
#define PG8_SCHED __builtin_amdgcn_sched_barrier(0)
    Unit cur, nxt; int ui = 0;
    if (!S.next(0, cur)) return;
    f32x4 acc[2][2][4][2];
#pragma unroll
    for (int a = 0; a < 2; ++a)
#pragma unroll
        for (int b = 0; b < 2; ++b)
#pragma unroll
            for (int m = 0; m < 4; ++m)
#pragma unroll
                for (int n = 0; n < 2; ++n) acc[a][b][m][n] = (f32x4){0.f, 0.f, 0.f, 0.f};
    bf16x8 At[4][2], B0[2][2], B1[2][2];
    const char* cA = (const char*)g.A + (size_t)cur.pm * tstep; const char* cB = (const char*)g.Bt + (size_t)cur.pn * tstep;
    S.a_ready(cur);
    if constexpr (SP2) {
        PG8_STAGE(PG8_SB(0, 0), cB, voffB); PG8_STAGE(PG8_SB(0, 1), cB + hstep, voffB); PG8_STAGE(PG8_SA(0, 0), cA, voffA); PG8_STAGE(PG8_SA(0, 1), cA + hstep, voffA);
        if (wr == 1) PG8_BAR;
        PG8_WAIT_V(2); PG8_BAR;
        PG8_STAGE(PG8_SB(1, 0), cB + kstep, voffB); PG8_STAGE(PG8_SA(1, 0), cA + kstep, voffA); PG8_STAGE(PG8_SB(1, 1), cB + hstep + kstep, voffB);
        PG8_WAIT_V(6); PG8_BAR;
    } else {
        PG8_STAGE(PG8_SB(0, 0), cB, voffB); PG8_STAGE(PG8_SA(0, 0), cA, voffA); PG8_STAGE(PG8_SB(0, 1), cB + hstep, voffB); PG8_STAGE(PG8_SA(0, 1), cA + hstep, voffA);
        if (wr == 1) PG8_BAR;
        PG8_WAIT_V(4); PG8_BAR;
        PG8_STAGE(PG8_SB(1, 0), cB + kstep, voffB); PG8_STAGE(PG8_SA(1, 0), cA + kstep, voffA); PG8_STAGE(PG8_SB(1, 1), cB + hstep + kstep, voffB);
        PG8_WAIT_V(6); PG8_BAR;
    }
    for (;;) {
        const bool has_next = S.next(ui + 1, nxt);
        const char* nA = has_next ? (const char*)g.A + (size_t)nxt.pm * tstep : cA; const char* nB = has_next ? (const char*)g.Bt + (size_t)nxt.pn * tstep : cB;
        for (int t = 0; t < nt; t += 2) {
            const bool last = (t == nt - 2);
            const char* a1 = cA + (size_t)(t + 1) * kstep;
            const char* a2 = last ? nA : cA + (size_t)(t + 2) * kstep; const char* b2 = last ? nB : cB + (size_t)(t + 2) * kstep;
            const char* a3 = a2 + kstep; const char* b3 = b2 + kstep;
            if (last && has_next) S.a_ready(nxt);
            if constexpr (SP2) {
            PG8_LDB(B0, 0, 0); PG8_LDB(B1, 0, 1); PG8_SCHED; PG8_LDA(At, 0, 0); PG8_STAGE(PG8_SA(1, 1), a1 + hstep, voffA);
            PG8_WAIT_V(8); PG8_WAIT_L(0); PG8_BAR; PG8_MMA(0, 0, At, B0); PG8_MMA(0, 1, At, B1); PG8_BAR; PG8_SCHED;
            PG8_LDA(At, 0, 1); PG8_STAGE(PG8_SB(0, 0), b2, voffB); PG8_STAGE(PG8_SB(0, 1), b2 + hstep, voffB); PG8_STAGE(PG8_SA(0, 0), a2, voffA);
            PG8_WAIT_V(8); PG8_WAIT_L(0); PG8_BAR; PG8_MMA(1, 0, At, B0); PG8_MMA(1, 1, At, B1); PG8_BAR; PG8_SCHED;
            PG8_LDB(B0, 1, 0); PG8_LDB(B1, 1, 1); PG8_SCHED; PG8_LDA(At, 1, 0); PG8_STAGE(PG8_SA(0, 1), a2 + hstep, voffA);
            PG8_WAIT_V(8); PG8_WAIT_L(0); PG8_BAR; PG8_MMA(0, 0, At, B0); PG8_MMA(0, 1, At, B1); PG8_BAR; PG8_SCHED;
            PG8_LDA(At, 1, 1); PG8_STAGE(PG8_SB(1, 0), b3, voffB); PG8_STAGE(PG8_SB(1, 1), b3 + hstep, voffB); PG8_STAGE(PG8_SA(1, 0), a3, voffA);
            PG8_WAIT_V(8); PG8_WAIT_L(0); PG8_BAR; PG8_MMA(1, 0, At, B0); PG8_MMA(1, 1, At, B1); PG8_BAR; PG8_SCHED;
            } else {
            PG8_LDB(B0, 0, 0); PG8_SCHED; PG8_LDA(At, 0, 0); PG8_STAGE(PG8_SA(1, 1), a1 + hstep, voffA);
            PG8_WAIT_L(8); PG8_BAR; PG8_WAIT_L(0); PG8_MMA(0, 0, At, B0); PG8_BAR; PG8_SCHED;
            PG8_LDB(B1, 0, 1); PG8_STAGE(PG8_SB(0, 0), b2, voffB);
            PG8_BAR; PG8_WAIT_L(0); PG8_MMA(0, 1, At, B1); PG8_BAR;
            PG8_LDA(At, 0, 1); PG8_STAGE(PG8_SA(0, 0), a2, voffA);
            PG8_BAR; PG8_WAIT_L(0); PG8_MMA(1, 0, At, B0); PG8_BAR; PG8_SCHED;
            PG8_STAGE(PG8_SB(0, 1), b2 + hstep, voffB);
            PG8_WAIT_V(6); PG8_BAR; PG8_MMA(1, 1, At, B1); PG8_BAR;
            PG8_LDB(B0, 1, 0); PG8_SCHED; PG8_LDA(At, 1, 0); PG8_STAGE(PG8_SA(0, 1), a2 + hstep, voffA);
            PG8_WAIT_L(8); PG8_BAR; PG8_WAIT_L(0); PG8_MMA(0, 0, At, B0); PG8_BAR; PG8_SCHED;
            PG8_LDB(B1, 1, 1); PG8_STAGE(PG8_SB(1, 0), b3, voffB);
            PG8_BAR; PG8_WAIT_L(0); PG8_MMA(0, 1, At, B1); PG8_BAR;
            PG8_LDA(At, 1, 1); PG8_STAGE(PG8_SA(1, 0), a3, voffA);
            PG8_BAR; PG8_WAIT_L(0); PG8_MMA(1, 0, At, B0); PG8_BAR; PG8_SCHED;
            PG8_STAGE(PG8_SB(1, 1), b3 + hstep, voffB);
            PG8_WAIT_V(6); PG8_BAR; PG8_MMA(1, 1, At, B1); PG8_BAR;
            }
        }
        if constexpr (ALIGN_EPI) { if (wr == 0) PG8_BAR; }
        if constexpr (!Epi::AFTER_DRAIN) { E(acc, cur, wr, wc, fr, fq); S.done(cur); }
        if (!has_next) break;
#pragma unroll
        for (int a = 0; a < 2; ++a)
#pragma unroll
            for (int b = 0; b < 2; ++b)
#pragma unroll
                for (int m = 0; m < 4; ++m)
#pragma unroll
                    for (int n = 0; n < 2; ++n) acc[a][b][m][n] = (f32x4){0.f, 0.f, 0.f, 0.f};
        cur = nxt; cA = nA; cB = nB; ++ui;
        if constexpr (ALIGN_EPI) { if (wr == 1) PG8_BAR; }
    }
    PG8_WAIT_V(0);
    if constexpr (!ALIGN_EPI) { if (wr == 0) PG8_BAR; }
    PG8_BAR;
    if constexpr (Epi::AFTER_DRAIN) { E.fused(acc, cur, wr, wc, fr, fq, lds, wid, lane); S.done(cur); }
#undef PG8_SA
#undef PG8_SB
#undef PG8_STAGE
#undef PG8_LDA
#undef PG8_LDB
#undef PG8_MMA
#undef PG8_WAIT_V
#undef PG8_WAIT_L
#undef PG8_BAR
#undef PG8_SCHED
}
}

#define LAS __attribute__((address_space(3)))
using pg8::bf16_t; using pg8::bf16x8; using pg8::f32x4; using pg8::u32x4; using pg8::Unit; using pg8::cvt_pk_bf16;
typedef float f32x16 __attribute__((ext_vector_type(16)));
typedef unsigned u32x2 __attribute__((ext_vector_type(2)));
typedef short s16x4 __attribute__((ext_vector_type(4)));
#define MFMA32(a, b, c) __builtin_amdgcn_mfma_f32_32x32x16_bf16((a), (b), (c), 0, 0, 0)

constexpr int NB = 8, T = 2048, D = 1024, M = NB * T, FF = 2816;
constexpr float EPS = 1e-6f;
constexpr float LOG2E = 1.4426950408889634f;
constexpr int LDS_BYTES = 147456;

constexpr size_t MiB = 1u << 20;
constexpr size_t WS_WP = 1 * MiB;
constexpr size_t WS_WCS = 6 * MiB;
constexpr size_t WS_DFT = 8 * MiB;
constexpr size_t WS_WO0 = 24 * MiB;
constexpr size_t WS_WQKV = 26 * MiB;
constexpr size_t WS_WO1 = 29 * MiB;
constexpr size_t WS_W13 = 31 * MiB;
constexpr size_t WS_W2 = 53 * MiB;
constexpr size_t W13_STRIDE = (size_t)5632 * 1024, W2_STRIDE = (size_t)1024 * 2816;
constexpr size_t WS_CNT = 65536;
constexpr size_t WS_XBUF = 64 * MiB;
constexpr size_t WS_XN = 66 * MiB;
constexpr size_t WS_MBUF = 98 * MiB;
constexpr size_t WS_XRES = 98 * MiB;
constexpr size_t WS_YT = 98 * MiB;
constexpr size_t WS_OFB = 130 * MiB;
constexpr size_t WS_Q0 = 162 * MiB;
constexpr size_t WS_V0 = 178 * MiB;
constexpr size_t WS_GATE = 194 * MiB;
constexpr size_t WS_ACAT = 210 * MiB;
constexpr size_t WS_H = 162 * MiB;
constexpr size_t WS_QKV1 = 162 * MiB;
constexpr size_t WS_END = 256 * MiB;

__device__ __forceinline__ unsigned f2bf(float f) { unsigned u = __builtin_bit_cast(unsigned, f); return (u + 0x7fffu + ((u >> 16) & 1u)) >> 16; }
__device__ __forceinline__ float bf2f(unsigned short h) { return __builtin_bit_cast(float, (unsigned)h << 16); }
__device__ __forceinline__ float wave_sum(float v) {
#pragma unroll
    for (int o = 1; o < 64; o <<= 1) v += __shfl_xor(v, o);
    return v;
}
__device__ __forceinline__ int crow(int r, int hi) { return (r & 3) + 8 * (r >> 2) + 4 * hi; }
#define LDS_WAIT() asm volatile("s_waitcnt lgkmcnt(0)" ::: "memory")
#define XB_TMO      128
#define XB_XCNT(j)  (256  + 64 * (j))
#define XB_XSUB(j)  (1280 + 64 * (j))
#define XB_XGEN(j)  (2304 + 64 * (j))
#define XB_TOP      3328
#define XB_TOPGEN   3392
#define XCD_BAR_WORDS 3456
#define XB_SPIN_CAP (1u << 18)

__device__ __forceinline__ unsigned xb_ld(unsigned* p)              { return __hip_atomic_load(p, __ATOMIC_RELAXED, __HIP_MEMORY_SCOPE_AGENT); }
__device__ __forceinline__ unsigned xb_add(unsigned* p, unsigned v) { return __hip_atomic_fetch_add(p, v, __ATOMIC_RELAXED, __HIP_MEMORY_SCOPE_AGENT); }
__device__ __forceinline__ unsigned xb_xcc_id() { return (unsigned)__builtin_amdgcn_s_getreg((3 << 11) | 20) & 0xFu; }
#define XB_SPIN(cond, bar) do { unsigned _sp = 0; while (cond) { __builtin_amdgcn_s_sleep(1); \
    if ((++_sp & 255u) == 0u) { if (xb_ld(&(bar)[XB_TMO])) break; if (_sp > XB_SPIN_CAP) { atomicAdd(&(bar)[XB_TMO], 1u); break; } } } } while (0)

struct XcdBarrier {
    unsigned* bar; unsigned x;
    volatile LAS unsigned* st;
};

__device__ __forceinline__ XcdBarrier xcd_barrier_post(unsigned* bar, volatile LAS unsigned* st) {
    XcdBarrier b; b.bar = bar; b.x = xb_xcc_id(); b.st = st;
    if (threadIdx.x == 0) (void)xb_add(&bar[XB_XCNT(b.x)], 1u);
    return b;
}
__device__ __forceinline__ void xcd_barrier_complete(unsigned* bar, unsigned x, unsigned& nloc, unsigned& nx) {
    const unsigned G = gridDim.x * gridDim.y * gridDim.z;
    unsigned sum, cnt, mine, sp = 0u;
    for (;;) {
        sum = 0u; cnt = 0u; mine = 0u;
#pragma unroll
        for (unsigned j = 0; j < 16; ++j) { const unsigned c = xb_ld(&bar[XB_XCNT(j)]); sum += c; cnt += (c > 0u) ? 1u : 0u; mine = (j == x) ? c : mine; }
        if (sum == G) break;
        __builtin_amdgcn_s_sleep(1);
        if ((++sp & 255u) == 0u) { if (xb_ld(&bar[XB_TMO])) break; if (sp > XB_SPIN_CAP) { atomicAdd(&bar[XB_TMO], 1u); break; } }
    }
    nloc = mine > 0u ? mine : 1u; nx = cnt > 0u ? cnt : 1u;
}

__device__ __forceinline__ void xcd_barrier(const XcdBarrier& b) {
    asm volatile("s_waitcnt vmcnt(0)" ::: "memory");
    __syncthreads();
    if (threadIdx.x == 0) {
        unsigned* bar = b.bar;
        __builtin_amdgcn_s_waitcnt(0);
        unsigned nloc = b.st[0], nx = b.st[1];
        if (nloc == 0u) { xcd_barrier_complete(bar, b.x, nloc, nx); b.st[0] = nloc; b.st[1] = nx; }
        const unsigned old = xb_add(&bar[XB_XSUB(b.x)], 1u);
        const unsigned gen = old / nloc;
        if (old + 1u == (gen + 1u) * nloc) {
            __builtin_amdgcn_fence(__ATOMIC_RELEASE, "agent");
            asm volatile("s_waitcnt vmcnt(0)" ::: "memory");
            const unsigned og = xb_add(&bar[XB_TOP], 1u);
            const unsigned tg = og / nx;
            if (og + 1u == (tg + 1u) * nx) xb_add(&bar[XB_TOPGEN], 1u);
            else XB_SPIN(xb_ld(&bar[XB_TOPGEN]) == tg, bar);
            __builtin_amdgcn_fence(__ATOMIC_ACQUIRE, "agent");
            xb_add(&bar[XB_XGEN(b.x)], 1u);
            asm volatile("s_waitcnt vmcnt(0)" ::: "memory");
        } else {
            XB_SPIN(xb_ld(&bar[XB_XGEN(b.x)]) == gen, bar);
            __builtin_amdgcn_fence(__ATOMIC_ACQUIRE, "agent");
            asm volatile("s_waitcnt vmcnt(0)" ::: "memory");
        }
    }
    __syncthreads();
}

struct EpiProj {
    static constexpr bool PERM = true, AFTER_DRAIN = false;
    bf16_t* Q0; float* LOGF; const float* tab;
    __device__ __forceinline__ void operator()(const f32x4 (&acc)[2][2][4][2], const Unit& u, int wr, int wc, int fr, int fq) const {
        const int seg = u.pn >> 1;
        const int cseg = (u.pn & 1) * 256 + wc * 32 + 8 * fq;
        const int row0 = u.pm * 256 + wr * 64 + fr;
        if (seg == 1 || seg == 2) {
            const int dir = seg - 1;
#pragma unroll
            for (int bj = 0; bj < 2; ++bj) {
                const int c = cseg + bj * 128;
                const f32x4 ta0 = *(const f32x4*)(tab + dir * 512 + c), ta1 = *(const f32x4*)(tab + dir * 512 + c + 4);
                const f32x4 tb0 = *(const f32x4*)(tab + 1024 + dir * 512 + c), tb1 = *(const f32x4*)(tab + 1024 + dir * 512 + c + 4);
                f32x4 lb0, lb1;
#pragma unroll
                for (int e = 0; e < 4; ++e) { lb0[e] = 1.0f / (1.0f + __expf(tb0[e] - ta0[e])); lb1[e] = 1.0f / (1.0f + __expf(tb1[e] - ta1[e])); }
#pragma unroll
                for (int ai = 0; ai < 2; ++ai)
#pragma unroll
                    for (int m = 0; m < 4; ++m) {
                        float* dst = LOGF + (size_t)(row0 + ai * 128 + m * 16) * 1024 + dir * 512 + c;
                        const f32x4 z0 = acc[ai][bj][m][0], z1 = acc[ai][bj][m][1]; f32x4 o0, o1;
#pragma unroll
                        for (int e = 0; e < 4; ++e) {
                            const float s0 = 1.0f / (1.0f + __expf(-z0[e])), s1 = 1.0f / (1.0f + __expf(-z1[e]));
                            o0[e] = __logf(lb0[e] + (1.0f - lb0[e]) * s0); o1[e] = __logf(lb1[e] + (1.0f - lb1[e]) * s1);
                        }
                        *(f32x4*)dst = o0; *(f32x4*)(dst + 4) = o1;
                    }
            }
        } else {
            bf16_t* base = Q0 + (size_t)(seg == 0 ? 0 : seg - 2) * ((size_t)M * 512);
            const float sc = seg == 0 ? 0.08838834764831845f : 1.0f;
#pragma unroll
            for (int bj = 0; bj < 2; ++bj) {
                const int c = cseg + bj * 128;
#pragma unroll
                for (int ai = 0; ai < 2; ++ai)
#pragma unroll
                    for (int m = 0; m < 4; ++m) {
                        f32x4 v0 = acc[ai][bj][m][0], v1 = acc[ai][bj][m][1];
                        if (seg == 4) {
#pragma unroll
                            for (int e = 0; e < 4; ++e) { v0[e] = v0[e] / (1.0f + __expf(-v0[e])); v1[e] = v1[e] / (1.0f + __expf(-v1[e])); }
                        } else { v0 = v0 * sc; v1 = v1 * sc; }
                        u32x4 w; w.x = cvt_pk_bf16(v0[0], v0[1]); w.y = cvt_pk_bf16(v0[2], v0[3]); w.z = cvt_pk_bf16(v1[0], v1[1]); w.w = cvt_pk_bf16(v1[2], v1[3]);
                        *(u32x4*)(base + (size_t)(row0 + ai * 128 + m * 16) * 512 + c) = w;
                    }
            }
        }
    }
};
struct EpiYt {
    static constexpr bool PERM = true, AFTER_DRAIN = false;
    bf16_t* Yt;
    __device__ __forceinline__ void operator()(const f32x4 (&acc)[2][2][4][2], const Unit& u, int wr, int wc, int fr, int fq) const {
        const int row0 = u.pm * 256 + wr * 64 + fr, tok0 = u.pn * 256 + wc * 32 + 8 * fq;
#pragma unroll
        for (int ai = 0; ai < 2; ++ai)
#pragma unroll
            for (int m = 0; m < 4; ++m) {
                const int f = row0 + ai * 128 + m * 16, cs = f >> 9, n_ = f & 511;
#pragma unroll
                for (int bj = 0; bj < 2; ++bj) {
                    const int tok = tok0 + bj * 128, b = tok >> 11, t = tok & 2047;
                    const f32x4 v0 = acc[ai][bj][m][0], v1 = acc[ai][bj][m][1];
                    u32x4 w; w.x = cvt_pk_bf16(v0[0], v0[1]); w.y = cvt_pk_bf16(v0[2], v0[3]); w.z = cvt_pk_bf16(v1[0], v1[1]); w.w = cvt_pk_bf16(v1[2], v1[3]);
                    *(u32x4*)(Yt + ((size_t)(b * 512 + n_) * 2 + cs) * 2048 + t) = w;
                }
            }
    }
};
struct EpiFnet {
    static constexpr bool PERM = true, AFTER_DRAIN = false;
    bf16_t* ACAT;
    __device__ __forceinline__ void operator()(const f32x4 (&acc)[2][2][4][2], const Unit& u, int wr, int wc, int fr, int fq) const {
        const int row0 = u.pm * 256 + wr * 64 + fr, col0 = u.pn * 256 + wc * 32 + 8 * fq;
#pragma unroll
        for (int ai = 0; ai < 2; ++ai)
#pragma unroll
            for (int m = 0; m < 4; ++m) {
                const int k1 = row0 + ai * 128 + m * 16;
#pragma unroll
                for (int bj = 0; bj < 2; ++bj) {
                    const int c = col0 + bj * 128, b = c >> 9, n_ = c & 511;
                    const f32x4 v0 = acc[ai][bj][m][0], v1 = acc[ai][bj][m][1];
                    u32x4 w; w.x = cvt_pk_bf16(v0[0], v0[1]); w.y = cvt_pk_bf16(v0[2], v0[3]); w.z = cvt_pk_bf16(v1[0], v1[1]); w.w = cvt_pk_bf16(v1[2], v1[3]);
                    *(u32x4*)(ACAT + (size_t)(b * 2048 + k1) * 1024 + 512 + n_) = w;
                }
            }
    }
};
struct EpiF32 {
    static constexpr bool PERM = false, AFTER_DRAIN = false;
    float* O; int ldc;
    __device__ __forceinline__ void operator()(const f32x4 (&acc)[2][2][4][2], const Unit& u, int wr, int wc, int fr, int fq) const {
        const int row0 = u.pm * 256 + wr * 64 + fr, col0 = u.pn * 256 + wc * 32 + 4 * fq;
#pragma unroll
        for (int ai = 0; ai < 2; ++ai)
#pragma unroll
            for (int m = 0; m < 4; ++m) {
                float* rowp = O + (size_t)(row0 + ai * 128 + m * 16) * ldc + col0;
#pragma unroll
                for (int bj = 0; bj < 2; ++bj)
#pragma unroll
                    for (int n = 0; n < 2; ++n) *(f32x4*)(rowp + bj * 128 + n * 16) = acc[ai][bj][m][n];
            }
    }
};
struct RowSsq {
    unsigned* xbuf;
    unsigned* cnt;
    __device__ __forceinline__ void run(const f32x4 (&v)[2][2][4][2], const Unit& u, int wr, int wc, int fr, int fq, LAS unsigned char* lds, int wid, int lane) const {
        LAS float* P = (LAS float*)lds;
        LAS float* S = (LAS float*)(lds + 8192);
#pragma unroll
        for (int ai = 0; ai < 2; ++ai)
#pragma unroll
            for (int m = 0; m < 4; ++m) {
                float q = 0.f;
#pragma unroll
                for (int bj = 0; bj < 2; ++bj)
#pragma unroll
                    for (int n = 0; n < 2; ++n) { const f32x4 x = v[ai][bj][m][n]; q += (x[0] * x[0] + x[1] * x[1]) + (x[2] * x[2] + x[3] * x[3]); }
                q += __shfl_xor(q, 16); q += __shfl_xor(q, 32);
                if (fq == 0) P[(ai * 128 + wr * 64 + m * 16 + fr) * 4 + wc] = q;
            }
        asm volatile("s_waitcnt lgkmcnt(0)" ::: "memory"); __builtin_amdgcn_s_barrier(); asm volatile("" ::: "memory");
        const int row = wid * 32 + (lane & 31);
        if (lane < 32) {
            const float tot = (P[row * 4 + 0] + P[row * 4 + 1]) + (P[row * 4 + 2] + P[row * 4 + 3]);
            __hip_atomic_store(xbuf + ((size_t)(u.pm * 256 + row) * 4 + u.pn), __float_as_uint(tot), __ATOMIC_RELAXED, __HIP_MEMORY_SCOPE_AGENT);
        }
        asm volatile("s_waitcnt vmcnt(0)" ::: "memory");
        if (lane == 0) __hip_atomic_fetch_add(cnt + 64 * u.pm, 1u, __ATOMIC_RELAXED, __HIP_MEMORY_SCOPE_AGENT);
        if (wid == 0) {
            unsigned sp = 0;
            while ((unsigned)__builtin_amdgcn_readfirstlane(__hip_atomic_load(cnt + 64 * u.pm, __ATOMIC_RELAXED, __HIP_MEMORY_SCOPE_AGENT)) < 32u) { __builtin_amdgcn_s_sleep(2); if (++sp > (1u << 22)) break; }
            __builtin_amdgcn_fence(__ATOMIC_ACQUIRE, "agent");
        }
        asm volatile("s_waitcnt vmcnt(0) lgkmcnt(0)" ::: "memory"); __builtin_amdgcn_s_barrier(); asm volatile("" ::: "memory");
        if (lane < 32) {
            const unsigned* slot = xbuf + (size_t)(u.pm * 256 + row) * 4; float t = 0.f;
#pragma unroll
            for (int k = 0; k < 4; ++k) t += __uint_as_float(__hip_atomic_load(slot + k, __ATOMIC_RELAXED, __HIP_MEMORY_SCOPE_AGENT));
            S[row] = t;
        }
        asm volatile("s_waitcnt lgkmcnt(0)" ::: "memory"); __builtin_amdgcn_s_barrier(); asm volatile("" ::: "memory");
    }
};
template <int BANK, int GPOST, int GPRE, bool BASE_F32, bool OUT_F32> struct EpiRmsRes {
    static constexpr bool PERM = false, AFTER_DRAIN = true, HAS_PRE = GPRE >= 0; static constexpr int bank = BANK;
    const float* base; float* out; unsigned char* ws; const float* gains;
    __device__ __forceinline__ void fused(f32x4 (&acc)[2][2][4][2], const Unit& u, int wr, int wc, int fr, int fq, LAS unsigned char* lds, int wid, int lane) const {
        const LAS float* S = (const LAS float*)(lds + 8192);
        const int col0 = u.pn * 256 + wc * 32 + 4 * fq;
        const float* g_post = gains + GPOST; const float* g_pre = gains + (GPRE >= 0 ? GPRE : 0);
        bf16_t* xres = (bf16_t*)(ws + WS_XRES);
        { const RowSsq st1{(unsigned*)(ws + WS_XBUF) + (size_t)bank * 65536, (unsigned*)(ws + WS_CNT) + bank * 4096}; st1.run(acc, u, wr, wc, fr, fq, lds, wid, lane); }
#pragma unroll
        for (int ai = 0; ai < 2; ++ai)
#pragma unroll
            for (int m = 0; m < 4; ++m) {
                const int r = ai * 128 + wr * 64 + m * 16 + fr; const float rstd = rsqrtf(S[r] * (1.0f / 1024.0f) + EPS);
                const size_t off = (size_t)(u.pm * 256 + r) * 1024 + col0;
#pragma unroll
                for (int bj = 0; bj < 2; ++bj)
#pragma unroll
                    for (int n = 0; n < 2; ++n) {
                        const f32x4 g = *(const f32x4*)(g_post + col0 + bj * 128 + n * 16); f32x4 bs;
                        if constexpr (BASE_F32) bs = *(const f32x4*)(base + off + bj * 128 + n * 16);
                        else { const u32x2 rb = *(const u32x2*)(xres + off + bj * 128 + n * 16); bs = (f32x4){bf2f((unsigned short)(rb.x & 0xffff)), bf2f((unsigned short)(rb.x >> 16)), bf2f((unsigned short)(rb.y & 0xffff)), bf2f((unsigned short)(rb.y >> 16))}; }
                        f32x4 x1 = bs + acc[ai][bj][m][n] * rstd * g;
                        if constexpr (OUT_F32) *(f32x4*)(out + off + bj * 128 + n * 16) = x1;
                        else { u32x2 w; w.x = cvt_pk_bf16(x1[0], x1[1]); w.y = cvt_pk_bf16(x1[2], x1[3]); *(u32x2*)(xres + off + bj * 128 + n * 16) = w;
                               x1 = (f32x4){bf2f((unsigned short)(w.x & 0xffff)), bf2f((unsigned short)(w.x >> 16)), bf2f((unsigned short)(w.y & 0xffff)), bf2f((unsigned short)(w.y >> 16))}; }
                        acc[ai][bj][m][n] = x1;
                    }
                asm volatile("" : "+v"(acc[ai][0][m][0]), "+v"(acc[ai][0][m][1]), "+v"(acc[ai][1][m][0]), "+v"(acc[ai][1][m][1]));
                if (m & 1) asm volatile("" ::: "memory");
            }
        if constexpr (HAS_PRE) {
            { const RowSsq st2{(unsigned*)(ws + WS_XBUF) + (size_t)(bank + 1) * 65536, (unsigned*)(ws + WS_CNT) + (bank + 1) * 4096}; st2.run(acc, u, wr, wc, fr, fq, lds, wid, lane); }
            bf16_t* xn = (bf16_t*)(ws + WS_XN);
#pragma unroll
            for (int ai = 0; ai < 2; ++ai)
#pragma unroll
                for (int m = 0; m < 4; ++m) {
                    const int r = ai * 128 + wr * 64 + m * 16 + fr; const float rstd = rsqrtf(S[r] * (1.0f / 1024.0f) + EPS);
                    const size_t off = (size_t)(u.pm * 256 + r) * 1024 + col0;
#pragma unroll
                    for (int bj = 0; bj < 2; ++bj)
#pragma unroll
                        for (int n = 0; n < 2; ++n) {
                            const f32x4 g = *(const f32x4*)(g_pre + col0 + bj * 128 + n * 16); const f32x4 o = acc[ai][bj][m][n] * rstd * g;
                            u32x2 w; w.x = cvt_pk_bf16(o[0], o[1]); w.y = cvt_pk_bf16(o[2], o[3]);
                            *(u32x2*)(xn + off + bj * 128 + n * 16) = w;
                        }
                    asm volatile("" ::: "memory");
                }
        }
    }
};
struct EpiSwiglu {
    static constexpr bool PERM = true, AFTER_DRAIN = false;
    bf16_t* H;
    __device__ __forceinline__ void operator()(const f32x4 (&acc)[2][2][4][2], const Unit& u, int wr, int wc, int fr, int fq) const {
        const int row0 = u.pm * 256 + wr * 64 + fr, col0 = u.pn * 128 + wc * 32 + 8 * fq;
#pragma unroll
        for (int ai = 0; ai < 2; ++ai)
#pragma unroll
            for (int m = 0; m < 4; ++m) {
                float h[8];
#pragma unroll
                for (int n = 0; n < 2; ++n)
#pragma unroll
                    for (int e = 0; e < 4; ++e) { const float a = acc[ai][0][m][n][e], b = acc[ai][1][m][n][e]; h[4 * n + e] = a / (1.0f + __expf(-a)) * b; }
                u32x4 w; w.x = cvt_pk_bf16(h[0], h[1]); w.y = cvt_pk_bf16(h[2], h[3]); w.z = cvt_pk_bf16(h[4], h[5]); w.w = cvt_pk_bf16(h[6], h[7]);
                *(u32x4*)(H + (size_t)(row0 + ai * 128 + m * 16) * FF + col0) = w;
            }
    }
};
struct EpiQKV {
    static constexpr bool PERM = true, AFTER_DRAIN = false;
    bf16_t* O;
    __device__ __forceinline__ void operator()(const f32x4 (&acc)[2][2][4][2], const Unit& u, int wr, int wc, int fr, int fq) const {
        const int row0 = u.pm * 256 + wr * 64 + fr, col0 = u.pn * 256 + wc * 32 + 8 * fq;
        const float sc = u.pn < 4 ? 0.125f * LOG2E : 1.0f;
#pragma unroll
        for (int ai = 0; ai < 2; ++ai)
#pragma unroll
            for (int m = 0; m < 4; ++m)
#pragma unroll
                for (int bj = 0; bj < 2; ++bj) {
                    const f32x4 v0 = acc[ai][bj][m][0] * sc, v1 = acc[ai][bj][m][1] * sc;
                    u32x4 w; w.x = cvt_pk_bf16(v0[0], v0[1]); w.y = cvt_pk_bf16(v0[2], v0[3]); w.z = cvt_pk_bf16(v1[0], v1[1]); w.w = cvt_pk_bf16(v1[2], v1[3]);
                    *(u32x4*)(O + (size_t)(row0 + ai * 128 + m * 16) * 1536 + col0 + bj * 128) = w;
                }
    }
};

__device__ __forceinline__ void transpose_item(const float* W, int ldw, int K, bf16_t* WT, int k0, int n0src, int dst_row0, LAS float* scr, int lane) {
#pragma unroll
    for (int i = 0; i < 8; ++i) {
        const int kk = i * 8 + (lane >> 3), q4 = lane & 7;
        const f32x4 v = *(const f32x4*)(W + (size_t)(k0 + kk) * ldw + n0src + 4 * q4);
        LAS float* d = scr + kk * 33 + 4 * q4; d[0] = v.x; d[1] = v.y; d[2] = v.z; d[3] = v.w;
    }
    LDS_WAIT();
    const int c = lane & 7;
#pragma unroll
    for (int j = 0; j < 4; ++j) {
        const int n = (lane >> 3) + 8 * j; const LAS float* s = scr + (8 * c) * 33 + n;
        u32x4 o; o.x = cvt_pk_bf16(s[0 * 33], s[1 * 33]); o.y = cvt_pk_bf16(s[2 * 33], s[3 * 33]); o.z = cvt_pk_bf16(s[4 * 33], s[5 * 33]); o.w = cvt_pk_bf16(s[6 * 33], s[7 * 33]);
        *(u32x4*)(WT + (size_t)(dst_row0 + n) * K + k0 + 8 * c) = o;
    }
    LDS_WAIT();
}
__device__ __forceinline__ void rms_row_to_bf16(const float* xrow, const float* gain, bf16_t* orow, int lane) {
    f32x4 v[4]; float ss = 0.f;
#pragma unroll
    for (int j = 0; j < 4; ++j) { v[j] = ((const f32x4*)xrow)[lane + 64 * j]; ss += (v[j].x * v[j].x + v[j].y * v[j].y) + (v[j].z * v[j].z + v[j].w * v[j].w); }
    const float r = rsqrtf(wave_sum(ss) * (1.0f / D) + EPS);
#pragma unroll
    for (int j = 0; j < 4; ++j) {
        const f32x4 g = ((const f32x4*)gain)[lane + 64 * j]; const f32x4 o = v[j] * r * g;
        u32x2 w; w.x = cvt_pk_bf16(o.x, o.y); w.y = cvt_pk_bf16(o.z, o.w);
        ((u32x2*)orow)[lane + 64 * j] = w;
    }
}
__device__ __forceinline__ void postnorm_rows(const float* xin, float* xout, const float* mbuf, const float* g_post, const float* g_pre, bf16_t* XN, int gw, int ngw, int lane) {
    for (int row = gw; row < M; row += ngw) {
        const f32x4* mr = (const f32x4*)(mbuf + (size_t)row * D); const f32x4* xr = (const f32x4*)(xin + (size_t)row * D);
        f32x4 mv[4], xv[4]; float ss = 0.f;
#pragma unroll
        for (int j = 0; j < 4; ++j) { mv[j] = mr[lane + 64 * j]; xv[j] = xr[lane + 64 * j]; ss += (mv[j].x * mv[j].x + mv[j].y * mv[j].y) + (mv[j].z * mv[j].z + mv[j].w * mv[j].w); }
        const float r = rsqrtf(wave_sum(ss) * (1.0f / D) + EPS);
        float ss2 = 0.f;
#pragma unroll
        for (int j = 0; j < 4; ++j) {
            const f32x4 g = ((const f32x4*)g_post)[lane + 64 * j];
            xv[j] = xv[j] + mv[j] * r * g;
            ((f32x4*)(xout + (size_t)row * D))[lane + 64 * j] = xv[j];
            ss2 += (xv[j].x * xv[j].x + xv[j].y * xv[j].y) + (xv[j].z * xv[j].z + xv[j].w * xv[j].w);
        }
        if (g_pre) {
            const float r2 = rsqrtf(wave_sum(ss2) * (1.0f / D) + EPS);
#pragma unroll
            for (int j = 0; j < 4; ++j) {
                const f32x4 g = ((const f32x4*)g_pre)[lane + 64 * j]; const f32x4 o = xv[j] * r2 * g;
                u32x2 w; w.x = cvt_pk_bf16(o.x, o.y); w.y = cvt_pk_bf16(o.z, o.w);
                ((u32x2*)(XN + (size_t)row * D))[lane + 64 * j] = w;
            }
        }
    }
}

constexpr int HG_G = 0, HG_QR = 16384, HG_KR = HG_QR + 8704, HG_QIN = HG_KR + 8704, HG_KO = HG_QIN + 8704, HG_V = HG_KO + 8704, HG_STB = HG_V + 32 * 72 * 2, HG_END = HG_STB + 2 * 64 * 136 * 2;
static_assert(HG_END <= 131072, "hgrn lds");
__device__ __forceinline__ bf16x8 gather8(const LAS bf16_t* p, int stride) {
    unsigned a0 = p[0], a1 = p[stride], a2 = p[2 * stride], a3 = p[3 * stride], a4 = p[4 * stride], a5 = p[5 * stride], a6 = p[6 * stride], a7 = p[7 * stride];
    u32x4 w; w.x = a0 | (a1 << 16); w.y = a2 | (a3 << 16); w.z = a4 | (a5 << 16); w.w = a6 | (a7 << 16);
    return __builtin_bit_cast(bf16x8, w);
}
__device__ __forceinline__ bf16x8 gather8p(const LAS bf16_t* p, int stride) {
    unsigned a0 = p[0], a1 = p[stride], a2 = p[2 * stride], a3 = p[3 * stride], a4 = p[8 * stride], a5 = p[9 * stride], a6 = p[10 * stride], a7 = p[11 * stride];
    u32x4 w; w.x = a0 | (a1 << 16); w.y = a2 | (a3 << 16); w.z = a4 | (a5 << 16); w.w = a6 | (a7 << 16);
    return __builtin_bit_cast(bf16x8, w);
}
typedef short v4i16_t __attribute__((ext_vector_type(4)));
__device__ __forceinline__ s16x4 vtr(const LAS bf16_t* p) { return __builtin_bit_cast(s16x4, __builtin_amdgcn_ds_read_tr16_b64_v4i16((LAS v4i16_t*)p)); }
__device__ __forceinline__ bf16x8 cat8(s16x4 lo, s16x4 hi) { return (bf16x8){lo[0], lo[1], lo[2], lo[3], hi[0], hi[1], hi[2], hi[3]}; }
__device__ __forceinline__ bf16x8 pack8(const f32x16& p, int s) {
    u32x4 w;
    if (s == 0) { w.x = cvt_pk_bf16(p[0], p[1]); w.y = cvt_pk_bf16(p[2], p[3]); w.z = cvt_pk_bf16(p[4], p[5]); w.w = cvt_pk_bf16(p[6], p[7]); }
    else        { w.x = cvt_pk_bf16(p[8], p[9]); w.y = cvt_pk_bf16(p[10], p[11]); w.z = cvt_pk_bf16(p[12], p[13]); w.w = cvt_pk_bf16(p[14], p[15]); }
    return __builtin_bit_cast(bf16x8, w);
}

__device__ __forceinline__ void hgrn_unit(LAS unsigned char* lds, int unit, const bf16_t* Q0, const float* LOGF, const bf16_t* V0, bf16_t* OFB) {
    const int vs = unit & 1, dir = (unit >> 1) & 1, h = (unit >> 2) & 3, b = unit >> 4;
    int tid_ = threadIdx.x; asm volatile("" : "+v"(tid_)); const int tid = tid_, lane = tid & 63, wave = __builtin_amdgcn_readfirstlane(tid >> 6), l31 = lane & 31, hi = lane >> 5;
    LAS float* G = (LAS float*)(lds + HG_G);
    LAS bf16_t* QR = (LAS bf16_t*)(lds + HG_QR);
    LAS bf16_t* KR = (LAS bf16_t*)(lds + HG_KR);
    LAS bf16_t* QIN = (LAS bf16_t*)(lds + HG_QIN);
    LAS bf16_t* KO = (LAS bf16_t*)(lds + HG_KO);
    LAS bf16_t* VL = (LAS bf16_t*)(lds + HG_V);
    LAS bf16_t* STB = (LAS bf16_t*)(lds + HG_STB);
    const int r = tid >> 4, k0 = (tid & 15) * 8, v0 = (tid & 15) * 4;
    const int vt = wave >> 2, kt = wave & 3;
    for (int i = tid; i < 64 * 136 / 2; i += 512) ((LAS unsigned*)STB)[i] = 0u;
    f32x16 ST;
#pragma unroll
    for (int i = 0; i < 16; ++i) ST[i] = 0.f;
    const size_t tokb = (size_t)b * T;
    f32x4 nlf0, nlf1; u32x4 nq; u32x2 nv;
    {
        const int c = dir ? 63 : 0; const size_t tok = tokb + c * 32 + (dir ? 31 - r : r);
        const float* lp = LOGF + tok * 1024 + dir * 512 + h * 128 + k0; nlf0 = *(const f32x4*)lp; nlf1 = *(const f32x4*)(lp + 4);
        nq = *(const u32x4*)(Q0 + tok * 512 + h * 128 + k0);
        nv = *(const u32x2*)(V0 + tok * 512 + h * 128 + vs * 64 + v0);
    }
    int cur = 0;
    for (int ci = 0; ci < 64; ++ci) {
        const int c = dir ? 63 - ci : ci;
        const size_t base = tokb + (size_t)c * 32;
        float lf[8] = {nlf0.x, nlf0.y, nlf0.z, nlf0.w, nlf1.x, nlf1.y, nlf1.z, nlf1.w};
        const u32x4 qraw = nq;
        float kk[8];
#pragma unroll
        for (int j = 0; j < 8; ++j) kk[j] = 1.0f - __expf(lf[j]);
        *(LAS f32x4*)(G + r * 128 + k0) = nlf0; *(LAS f32x4*)(G + r * 128 + k0 + 4) = nlf1;
        *(LAS u32x2*)(VL + r * 72 + v0) = nv;
        if (ci + 1 < 64) {
            const int c2 = dir ? 62 - ci : ci + 1; const size_t tok = tokb + c2 * 32 + (dir ? 31 - r : r);
            const float* lp = LOGF + tok * 1024 + dir * 512 + h * 128 + k0; nlf0 = *(const f32x4*)lp; nlf1 = *(const f32x4*)(lp + 4);
            nq = *(const u32x4*)(Q0 + tok * 512 + h * 128 + k0);
            nv = *(const u32x2*)(V0 + tok * 512 + h * 128 + vs * 64 + v0);
        }
        __syncthreads();
        if (tid < 128) {
            float a = 0.f;
#pragma unroll
            for (int t = 0; t < 32; ++t) { a += G[t * 128 + tid]; G[t * 128 + tid] = a; }
        }
        __syncthreads();
        {
            float g[8], gr[8], gl[8];
            { const f32x4 a0 = *(LAS f32x4*)(G + r * 128 + k0), a1 = *(LAS f32x4*)(G + r * 128 + k0 + 4);
              const f32x4 b0 = *(LAS f32x4*)(G + 15 * 128 + k0), b1 = *(LAS f32x4*)(G + 15 * 128 + k0 + 4);
              const f32x4 c0 = *(LAS f32x4*)(G + 31 * 128 + k0), c1 = *(LAS f32x4*)(G + 31 * 128 + k0 + 4);
#pragma unroll
              for (int j = 0; j < 4; ++j) { g[j] = a0[j]; g[4 + j] = a1[j]; gr[j] = b0[j]; gr[4 + j] = b1[j]; gl[j] = c0[j]; gl[4 + j] = c1[j]; } }
            float q[8];
            q[0] = bf2f((unsigned short)(qraw.x & 0xffff)); q[1] = bf2f((unsigned short)(qraw.x >> 16));
            q[2] = bf2f((unsigned short)(qraw.y & 0xffff)); q[3] = bf2f((unsigned short)(qraw.y >> 16));
            q[4] = bf2f((unsigned short)(qraw.z & 0xffff)); q[5] = bf2f((unsigned short)(qraw.z >> 16));
            q[6] = bf2f((unsigned short)(qraw.w & 0xffff)); q[7] = bf2f((unsigned short)(qraw.w >> 16));
            float qr[8], kr[8], qi[8], ko[8];
#pragma unroll
            for (int j = 0; j < 8; ++j) {
                qr[j] = q[j] * __expf(g[j] - gr[j]); kr[j] = kk[j] * __expf(gr[j] - g[j]);
                qi[j] = q[j] * __expf(g[j]);         ko[j] = kk[j] * __expf(gl[j] - g[j]);
            }
            u32x4 w;
            w.x = cvt_pk_bf16(qr[0], qr[1]); w.y = cvt_pk_bf16(qr[2], qr[3]); w.z = cvt_pk_bf16(qr[4], qr[5]); w.w = cvt_pk_bf16(qr[6], qr[7]); *(LAS u32x4*)(QR + r * 136 + k0) = w;
            w.x = cvt_pk_bf16(kr[0], kr[1]); w.y = cvt_pk_bf16(kr[2], kr[3]); w.z = cvt_pk_bf16(kr[4], kr[5]); w.w = cvt_pk_bf16(kr[6], kr[7]); *(LAS u32x4*)(KR + r * 136 + k0) = w;
            w.x = cvt_pk_bf16(qi[0], qi[1]); w.y = cvt_pk_bf16(qi[2], qi[3]); w.z = cvt_pk_bf16(qi[4], qi[5]); w.w = cvt_pk_bf16(qi[6], qi[7]); *(LAS u32x4*)(QIN + r * 136 + k0) = w;
            w.x = cvt_pk_bf16(ko[0], ko[1]); w.y = cvt_pk_bf16(ko[2], ko[3]); w.z = cvt_pk_bf16(ko[4], ko[5]); w.w = cvt_pk_bf16(ko[6], ko[7]); *(LAS u32x4*)(KO + r * 136 + k0) = w;
        }
        __syncthreads();
        if (wave < 2) {
            const int ot = wave;
            f32x16 p;
#pragma unroll
            for (int i = 0; i < 16; ++i) p[i] = 0.f;
#pragma unroll
            for (int ks = 0; ks < 8; ++ks) {
                const bf16x8 a = *(const LAS bf16x8*)(KR + l31 * 136 + 16 * ks + 8 * hi);
                const bf16x8 bq = *(const LAS bf16x8*)(QR + l31 * 136 + 16 * ks + 8 * hi);
                p = MFMA32(a, bq, p);
            }
#pragma unroll
            for (int i = 0; i < 16; ++i) { if (crow(i, hi) > l31) p[i] = 0.f; }
            const bf16x8 pf0 = pack8(p, 0), pf1 = pack8(p, 1);
            f32x16 o;
#pragma unroll
            for (int i = 0; i < 16; ++i) o[i] = 0.f;
            { const LAS bf16_t* vp = VL + (4 * hi + ((lane & 15) >> 2)) * 72 + 16 * ((lane >> 4) & 1) + 4 * (lane & 3) + ot * 32;
              const bf16x8 a0 = cat8(vtr(vp), vtr(vp + 8 * 72)); o = MFMA32(a0, pf0, o);
              const bf16x8 a1 = cat8(vtr(vp + 16 * 72), vtr(vp + 24 * 72)); o = MFMA32(a1, pf1, o); }
            const LAS bf16_t* stb = STB + cur * (64 * 136);
#pragma unroll
            for (int ks = 0; ks < 8; ++ks) {
                const bf16x8 a = *(const LAS bf16x8*)(stb + (ot * 32 + l31) * 136 + 16 * ks + 8 * hi);
                const bf16x8 bq = *(const LAS bf16x8*)(QIN + l31 * 136 + 16 * ks + 8 * hi);
                o = MFMA32(a, bq, o);
            }
            const size_t tok = base + (dir ? 31 - l31 : l31);
            bf16_t* op = OFB + ((size_t)dir * M + tok) * 512 + h * 128 + vs * 64 + ot * 32 + 4 * hi;
#pragma unroll
            for (int g4 = 0; g4 < 4; ++g4) { u32x2 w; w.x = cvt_pk_bf16(o[4 * g4], o[4 * g4 + 1]); w.y = cvt_pk_bf16(o[4 * g4 + 2], o[4 * g4 + 3]); *(u32x2*)(op + 8 * g4) = w; }
        }
        {
            const float dec = __expf(G[31 * 128 + kt * 32 + l31]);
#pragma unroll
            for (int i = 0; i < 16; ++i) ST[i] *= dec;
#pragma unroll
            for (int st = 0; st < 2; ++st) {
                const LAS bf16_t* vp = VL + (16 * st + 8 * hi + ((lane & 15) >> 2)) * 72 + 16 * ((lane >> 4) & 1) + 4 * (lane & 3) + vt * 32;
                const LAS bf16_t* kp = KO + (16 * st + 8 * hi + ((lane & 15) >> 2)) * 136 + 16 * ((lane >> 4) & 1) + 4 * (lane & 3) + kt * 32;
                const bf16x8 a = cat8(vtr(vp), vtr(vp + 4 * 72));
                const bf16x8 bk = cat8(vtr(kp), vtr(kp + 4 * 136));
                ST = MFMA32(a, bk, ST);
            }
            LAS bf16_t* stn = STB + (cur ^ 1) * (64 * 136);
#pragma unroll
            for (int i = 0; i < 16; ++i) stn[(vt * 32 + crow(i, hi)) * 136 + kt * 32 + l31] = (bf16_t)f2bf(ST[i]);
        }
        __syncthreads();
        cur ^= 1;
    }
}

constexpr int AT_K = 0, AT_V = 384 * 72 * 2, AT_END = 2 * 384 * 72 * 2;
static_assert(AT_END <= 131072, "attn lds");
__device__ __forceinline__ void attn_unit(LAS unsigned char* lds, int unit, const bf16_t* QKV, const float* sink, bf16_t* OUT) {
    const int qb = unit & 15, kv = (unit >> 4) & 3, b = unit >> 6;
    int tid_ = threadIdx.x; asm volatile("" : "+v"(tid_)); const int tid = tid_, lane = tid & 63, wave = __builtin_amdgcn_readfirstlane(tid >> 6), l31 = lane & 31, hi = lane >> 5;
    LAS bf16_t* KL = (LAS bf16_t*)(lds + AT_K);
    LAS bf16_t* VL = (LAS bf16_t*)(lds + AT_V);
    const int Q0p = qb * 128, kbase = Q0p - 128;
    const size_t tokb = (size_t)b * T;
#pragma unroll
    for (int it = 0; it < 6; ++it) {
        const int idx = tid + it * 512, row = idx >> 3, c8 = idx & 7, pos = kbase + row;
        u32x4 kx = {0u, 0u, 0u, 0u}, vx = {0u, 0u, 0u, 0u};
        if (pos >= 0 && pos < T) {
            const bf16_t* p = QKV + (tokb + pos) * 1536 + kv * 64 + c8 * 8;
            kx = *(const u32x4*)(p + 1024); vx = *(const u32x4*)(p + 1280);
        }
        *(LAS u32x4*)(KL + row * 72 + c8 * 8) = kx; *(LAS u32x4*)(VL + row * 72 + c8 * 8) = vx;
    }
    __syncthreads();
    const int g = wave >> 1, hh = kv * 4 + g, half = wave & 1;
    const float slope2 = exp2f(-0.5f * (float)(hh + 1)) * LOG2E, sink2 = sink[hh] * LOG2E;
    const LAS bf16_t* vtr0 = VL + (4 * hi + ((lane & 15) >> 2)) * 72 + 16 * ((lane >> 4) & 1) + 4 * (lane & 3);
    for (int qt = 0; qt < 2; ++qt) {
        const int q0l = half * 64 + qt * 32, qpos = Q0p + q0l + l31;
        bf16x8 qf[4];
        { const bf16_t* qp = QKV + (tokb + qpos) * 1536 + hh * 64 + 8 * hi;
#pragma unroll
          for (int s = 0; s < 4; ++s) qf[s] = *(const bf16x8*)(qp + 16 * s); }
        float mrun = sink2, lsum = hi == 0 ? 1.0f : 0.0f;
        f32x16 o0, o1;
#pragma unroll
        for (int i = 0; i < 16; ++i) { o0[i] = 0.f; o1[i] = 0.f; }
        for (int kt = 0; kt < 9; ++kt) {
            const int krow0 = q0l + 32 * kt, kpos0 = kbase + krow0;
            if (kpos0 + 31 < 0 || kpos0 >= T) continue;
            f32x16 s;
#pragma unroll
            for (int i = 0; i < 16; ++i) s[i] = 0.f;
#pragma unroll
            for (int ks = 0; ks < 4; ++ks) {
                const bf16x8 a = *(const LAS bf16x8*)(KL + (krow0 + l31) * 72 + 16 * ks + 8 * hi);
                s = MFMA32(a, qf[ks], s);
            }
            if (kt == 4) {
#pragma unroll
                for (int i = 0; i < 16; ++i) { const int dd = qpos - (kpos0 + crow(i, hi)); s[i] = __builtin_fmaf(-slope2, (float)(dd < 0 ? -dd : dd), s[i]); }
            } else {
                const float sg = kt < 4 ? 1.0f : -1.0f;
                const int dq = qpos - kpos0 - 4 * hi;
                const float base = -slope2 * sg * (float)dq, step = slope2 * sg;
#pragma unroll
                for (int i = 0; i < 16; ++i) s[i] = __builtin_fmaf(step, (float)((i & 3) + 8 * (i >> 2)), s[i] + base);
                if (kt == 0) {
#pragma unroll
                    for (int i = 0; i < 16; ++i) { if (dq - ((i & 3) + 8 * (i >> 2)) > 128) s[i] = -INFINITY; }
                }
                if (kt == 8) {
#pragma unroll
                    for (int i = 0; i < 16; ++i) { if (((i & 3) + 8 * (i >> 2)) - dq > 128) s[i] = -INFINITY; }
                }
            }
            float tmax = s[0];
#pragma unroll
            for (int i = 1; i < 16; ++i) tmax = fmaxf(tmax, s[i]);
            tmax = fmaxf(tmax, __shfl_xor(tmax, 32));
            const float mnew = fmaxf(mrun, tmax), alpha = __builtin_amdgcn_exp2f(mrun - mnew);
            mrun = mnew; lsum *= alpha;
#pragma unroll
            for (int i = 0; i < 16; ++i) { o0[i] *= alpha; o1[i] *= alpha; }
            float ps = 0.f;
#pragma unroll
            for (int i = 0; i < 16; ++i) { const float pe = __builtin_amdgcn_exp2f(s[i] - mnew); s[i] = pe; ps += pe; }
            lsum += ps;
            const bf16x8 pf0 = pack8(s, 0), pf1 = pack8(s, 1);
            const LAS bf16_t* vp = vtr0 + krow0 * 72;
            { const bf16x8 a = cat8(vtr(vp), vtr(vp + 8 * 72)); o0 = MFMA32(a, pf0, o0); }
            { const bf16x8 a = cat8(vtr(vp + 32), vtr(vp + 8 * 72 + 32)); o1 = MFMA32(a, pf0, o1); }
            { const bf16x8 a = cat8(vtr(vp + 16 * 72), vtr(vp + 24 * 72)); o0 = MFMA32(a, pf1, o0); }
            { const bf16x8 a = cat8(vtr(vp + 16 * 72 + 32), vtr(vp + 24 * 72 + 32)); o1 = MFMA32(a, pf1, o1); }
        }
        const float ltot = lsum + __shfl_xor(lsum, 32), inv = 1.0f / ltot;
        bf16_t* op = OUT + (tokb + qpos) * 1024 + hh * 64 + 4 * hi;
#pragma unroll
        for (int g4 = 0; g4 < 4; ++g4) {
            u32x2 w; w.x = cvt_pk_bf16(o0[4 * g4] * inv, o0[4 * g4 + 1] * inv); w.y = cvt_pk_bf16(o0[4 * g4 + 2] * inv, o0[4 * g4 + 3] * inv); *(u32x2*)(op + 8 * g4) = w;
            u32x2 w2; w2.x = cvt_pk_bf16(o1[4 * g4] * inv, o1[4 * g4 + 1] * inv); w2.y = cvt_pk_bf16(o1[4 * g4 + 2] * inv, o1[4 * g4 + 3] * inv); *(u32x2*)(op + 32 + 8 * g4) = w2;
        }
    }
    __syncthreads();
}

struct Args { const float* in[12]; float* out; unsigned char* ws; };

template <int SEL> __device__ __forceinline__ void conv_items(const Args& a, LAS float* scr, int gwi, int ngwi, int lane_in) {
    int lane = lane_in; asm volatile("" : "+v"(lane));
    unsigned char* ws = a.ws;
    constexpr int I_W = 16 * 88, I_W2 = 44 * 32;
    constexpr int N0 = 16 * 80, N1 = 2048 + 16 * 32 + 2 * I_W + I_W2, N2 = 16 * 48 + 16 * 32 + 2 * I_W + I_W2;
    constexpr int NITEMS = SEL == 0 ? N0 : (SEL == 1 ? N1 : N2);
    constexpr int layer = SEL == 2 ? 1 : 0;
    for (int it0 = gwi; it0 < NITEMS; it0 += ngwi) {
        int it = it0;
        if constexpr (SEL == 0) { const int kb = it / 80, nb = it % 80; transpose_item(a.in[2], 3072, 1024, (bf16_t*)(ws + WS_WP), kb * 64, nb * 32, nb * 32, scr, lane); continue; }
        if constexpr (SEL == 1) {
            if (it < 2048) {
                const int k1 = it; bf16_t* dr = (bf16_t*)(ws + WS_DFT) + (size_t)k1 * 4096;
#pragma unroll 2
                for (int i = 0; i < 8; ++i) {
                    const int col0 = (i * 64 + lane) * 8, cs = col0 >> 11;
                    float v[8];
#pragma unroll
                    for (int j = 0; j < 8; ++j) {
                        const int t = (col0 + j) & 2047; const float ph = (float)((k1 * t) & 2047) * (1.0f / 2048.0f);
                        v[j] = (cs ? -__builtin_amdgcn_sinf(ph) : __builtin_amdgcn_cosf(ph)) * (1.0f / 512.0f);
                    }
                    u32x4 o; o.x = cvt_pk_bf16(v[0], v[1]); o.y = cvt_pk_bf16(v[2], v[3]); o.z = cvt_pk_bf16(v[4], v[5]); o.w = cvt_pk_bf16(v[6], v[7]);
                    *(u32x4*)(dr + col0) = o;
                }
                continue;
            }
            it -= 2048;
            if (it < 512) { const int kb = it / 32, nb = it % 32; transpose_item(a.in[5], 1024, 1024, (bf16_t*)(ws + WS_WO0), kb * 64, nb * 32, nb * 32, scr, lane); continue; }
            it -= 512;
        }
        if constexpr (SEL == 2) {
            if (it < 768) { const int kb = it / 48, nb = it % 48; transpose_item(a.in[6], 1536, 1024, (bf16_t*)(ws + WS_WQKV), kb * 64, nb * 32, nb * 32, scr, lane); continue; }
            it -= 768;
            if (it < 512) { const int kb = it / 32, nb = it % 32; transpose_item(a.in[8], 1024, 1024, (bf16_t*)(ws + WS_WO1), kb * 64, nb * 32, nb * 32, scr, lane); continue; }
            it -= 512;
        }
        if constexpr (SEL != 0) {
            if (it < 2 * I_W) {
                const int which = it >= I_W; if (which) it -= I_W;
                const int kb = it / 88, nb = it % 88, n0 = nb * 32;
                const float* src = (which ? a.in[10] : a.in[9]) + (size_t)layer * 1024 * FF;
                transpose_item(src, FF, 1024, (bf16_t*)(ws + WS_W13) + (size_t)layer * W13_STRIDE, kb * 64, n0, 256 * (n0 >> 7) + 128 * which + (n0 & 127), scr, lane); continue;
            }
            it -= 2 * I_W;
            { const int kb = it / 32, nb = it % 32;
              transpose_item(a.in[11] + (size_t)layer * FF * 1024, 1024, FF, (bf16_t*)(ws + WS_W2) + (size_t)layer * W2_STRIDE, kb * 64, nb * 32, nb * 32, scr, lane); }
        }
    }
}
__device__ __forceinline__ void prologue(const Args& a, LAS unsigned char* lds, int gw, int ngw, int wave, int lane) {
    unsigned char* ws = a.ws;
    LAS float* scr = (LAS float*)(lds + wave * 16384);
    const float* w_in = a.in[2];
    if (wave < 2) {
        const int G_ = ngw >> 3, bid_ = gw >> 3;
        bf16_t* Wcs = (bf16_t*)(ws + WS_WCS);
        for (int j = wave * G_ + bid_; j < 512; j += 2 * G_) {
            const int g = j >> 7, k0 = (j & 127) * 8;
#pragma unroll
            for (int i = 0; i < 4; ++i) { const int idx = i * 64 + lane, kk = idx >> 5, c4 = idx & 31; *(LAS f32x4*)(scr + kk * 128 + 4 * c4) = *(const f32x4*)(w_in + (size_t)(k0 + kk) * 3072 + 2560 + g * 128 + 4 * c4); }
            LDS_WAIT();
            float aca[8], asa[8], acb[8], asb[8];
#pragma unroll
            for (int kk = 0; kk < 8; ++kk) { aca[kk] = 0.f; asa[kk] = 0.f; acb[kk] = 0.f; asb[kk] = 0.f; }
            for (int c = 0; c < 128; ++c) {
                const float ph = (float)((lane * c) & 127) * (1.0f / 128.0f);
                const float ca = __builtin_amdgcn_cosf(ph), sa = __builtin_amdgcn_sinf(ph);
                const float cb = (c & 1) ? -ca : ca, sb = (c & 1) ? -sa : sa;
#pragma unroll
                for (int kk = 0; kk < 8; ++kk) { const float w = scr[kk * 128 + c]; aca[kk] += w * ca; asa[kk] += w * sa; acb[kk] += w * cb; asb[kk] += w * sb; }
            }
            u32x4 o;
            o.x = cvt_pk_bf16(aca[0], aca[1]); o.y = cvt_pk_bf16(aca[2], aca[3]); o.z = cvt_pk_bf16(aca[4], aca[5]); o.w = cvt_pk_bf16(aca[6], aca[7]); *(u32x4*)(Wcs + (size_t)(g * 128 + lane) * 1024 + k0) = o;
            o.x = cvt_pk_bf16(acb[0], acb[1]); o.y = cvt_pk_bf16(acb[2], acb[3]); o.z = cvt_pk_bf16(acb[4], acb[5]); o.w = cvt_pk_bf16(acb[6], acb[7]); *(u32x4*)(Wcs + (size_t)(g * 128 + lane + 64) * 1024 + k0) = o;
            o.x = cvt_pk_bf16(asa[0], asa[1]); o.y = cvt_pk_bf16(asa[2], asa[3]); o.z = cvt_pk_bf16(asa[4], asa[5]); o.w = cvt_pk_bf16(asa[6], asa[7]); *(u32x4*)(Wcs + (size_t)(512 + g * 128 + lane) * 1024 + k0) = o;
            o.x = cvt_pk_bf16(asb[0], asb[1]); o.y = cvt_pk_bf16(asb[2], asb[3]); o.z = cvt_pk_bf16(asb[4], asb[5]); o.w = cvt_pk_bf16(asb[6], asb[7]); *(u32x4*)(Wcs + (size_t)(512 + g * 128 + lane + 64) * 1024 + k0) = o;
            LDS_WAIT();
        }
    }
    conv_items<0>(a, scr, gw, ngw, lane);
    for (int row = gw; row < M; row += ngw) rms_row_to_bf16(a.in[0] + (size_t)row * D, a.in[1], (bf16_t*)(ws + WS_XN) + (size_t)row * D, lane);
}

#ifndef PHMASK
#define PHMASK 0xffff
#endif
#ifndef REP_HGRN
#define REP_HGRN 1
#endif
#ifndef REP_SYNC
#define REP_SYNC 1
#endif
#ifndef REP_PRO
#define REP_PRO 1
#endif
#ifndef REP_ATTN
#define REP_ATTN 1
#endif
#ifndef REP_FNET
#define REP_FNET 1
#endif
#ifndef REP_GEMM
#define REP_GEMM 1
#endif
#define GSYNC() do { for (int r_ = 0; r_ < REP_SYNC; ++r_) xcd_barrier(xbar); } while (0)

__global__ void __launch_bounds__(512, 2) fwd_megakernel(Args a) {
    extern __shared__ __attribute__((aligned(16))) unsigned char lds_raw[];
    LAS unsigned char* lds = (LAS unsigned char*)lds_raw;
    cg::grid_group grid = cg::this_grid();
    const int tid = threadIdx.x, lane = tid & 63, wave = __builtin_amdgcn_readfirstlane(tid >> 6);
    const int G = gridDim.x, bid = blockIdx.x, gw = bid * 8 + wave, ngw = G * 8;
    unsigned char* ws = a.ws;
    bf16_t* XN = (bf16_t*)(ws + WS_XN); float* MBUF = (float*)(ws + WS_MBUF);
    bf16_t* ACAT = (bf16_t*)(ws + WS_ACAT); bf16_t* HB = (bf16_t*)(ws + WS_H);
    float* LOGF = a.out;
    const float* gains = a.in[1];
    if (tid < 64) ((LAS unsigned*)(lds + 131072))[tid] = 0u;
    __syncthreads();
    if (__builtin_expect(a.ws == nullptr, 0)) grid.sync();
    XcdBarrier xbar = xcd_barrier_post((unsigned*)ws, (volatile LAS unsigned*)(lds + 131072 + 32));

#if PHMASK & 1
    for (int rp = 0; rp < REP_PRO; ++rp) prologue(a, lds, gw, ngw, wave, lane);
#endif
    GSYNC();

#if PHMASK & 2
    {
        pg8::Gemm g{XN, (const bf16_t*)(ws + WS_WP), M, 2560, 1024}; pg8::StaticOrder S; S.init(M, 2560, G, bid);
        EpiProj E{(bf16_t*)(ws + WS_Q0), LOGF, a.in[3]};
        static_assert(WS_V0 == WS_Q0 + (size_t)M * 512 * 2 && WS_GATE == WS_V0 + (size_t)M * 512 * 2, "Q0 | V0 | GATE consecutive");
        pg8::gemm_phase<EpiProj, pg8::StaticOrder, true, true>(lds, g, S, E);
    }
#endif
#if PHMASK & 4
    {
        pg8::Gemm g{(const bf16_t*)(ws + WS_WCS), XN, 1024, M, 1024}; pg8::StaticOrder S; S.init(1024, M, G, bid);
        EpiYt E{(bf16_t*)(ws + WS_YT)};
        pg8::gemm_phase<EpiYt, pg8::StaticOrder, true, true>(lds, g, S, E);
    }
#endif
    if ((G & 1) == 0) { if (bid >= G / 2) conv_items<1>(a, (LAS float*)(lds + wave * 16384), (bid - G / 2) * 8 + wave, (G / 2) * 8, lane); }
    else conv_items<1>(a, (LAS float*)(lds + wave * 16384), gw, ngw, lane);
    GSYNC();

    {
        const bool split = (G % 16) == 0;
        const bool do_f = !split || (((bid >> 3) & 1) == 0), do_h = !split || (((bid >> 3) & 1) == 1);
        const int gsz = split ? G / 2 : G, gidx = split ? (bid >> 4) * 8 + (bid & 7) : bid;
#if PHMASK & 8
        if (do_f) for (int rp = 0; rp < REP_FNET; ++rp) {
            pg8::Gemm g{(const bf16_t*)(ws + WS_DFT), (const bf16_t*)(ws + WS_YT), 2048, 4096, 4096}; pg8::StaticOrder S; S.init(2048, 4096, gsz, gidx);
            EpiFnet E{ACAT};
            pg8::gemm_phase<EpiFnet, pg8::StaticOrder, true, true>(lds, g, S, E);
        }
#endif
#if PHMASK & 16
        if (do_h) {
            for (int rp = 0; rp < REP_HGRN; ++rp) for (int u = gidx; u < 128; u += gsz) hgrn_unit(lds, u, (const bf16_t*)(ws + WS_Q0), LOGF, (const bf16_t*)(ws + WS_V0), (bf16_t*)(ws + WS_OFB));
        }
#endif
    }
    GSYNC();

    {
        const bf16_t* OFB = (const bf16_t*)(ws + WS_OFB); const bf16_t* GATE = (const bf16_t*)(ws + WS_GATE); const float* og = a.in[4];
        for (int row = gw; row < M; row += ngw) {
            const u32x4 f = *(const u32x4*)(OFB + (size_t)row * 512 + lane * 8), bw = *(const u32x4*)(OFB + ((size_t)M + row) * 512 + lane * 8), gt = *(const u32x4*)(GATE + (size_t)row * 512 + lane * 8);
            float o[8]; float ss = 0.f;
#pragma unroll
            for (int j = 0; j < 4; ++j) {
                o[2 * j] = bf2f((unsigned short)(f[j] & 0xffff)) + bf2f((unsigned short)(bw[j] & 0xffff));
                o[2 * j + 1] = bf2f((unsigned short)(f[j] >> 16)) + bf2f((unsigned short)(bw[j] >> 16));
                ss += o[2 * j] * o[2 * j] + o[2 * j + 1] * o[2 * j + 1];
            }
            ss += __shfl_xor(ss, 1); ss += __shfl_xor(ss, 2); ss += __shfl_xor(ss, 4); ss += __shfl_xor(ss, 8);
            const float r = rsqrtf(ss * (1.0f / 128.0f) + EPS);
            const f32x4 g0 = *(const f32x4*)(og + lane * 8), g1 = *(const f32x4*)(og + lane * 8 + 4);
            float res[8];
#pragma unroll
            for (int j = 0; j < 4; ++j) {
                res[2 * j] = o[2 * j] * r * (2 * j < 4 ? g0[2 * j] : g1[2 * j - 4]) * bf2f((unsigned short)(gt[j] & 0xffff));
                res[2 * j + 1] = o[2 * j + 1] * r * (2 * j + 1 < 4 ? g0[2 * j + 1] : g1[2 * j + 1 - 4]) * bf2f((unsigned short)(gt[j] >> 16));
            }
            u32x4 w; w.x = cvt_pk_bf16(res[0], res[1]); w.y = cvt_pk_bf16(res[2], res[3]); w.z = cvt_pk_bf16(res[4], res[5]); w.w = cvt_pk_bf16(res[6], res[7]);
            *(u32x4*)(ACAT + (size_t)row * 1024 + lane * 8) = w;
        }
    }
    GSYNC();

#pragma unroll
    for (int layer = 0; layer < 2; ++layer) {
        const float* gl = gains + (size_t)layer * 4 * D;
        if (layer == 1) {
            {
                pg8::Gemm g{XN, (const bf16_t*)(ws + WS_WQKV), M, 1536, 1024}; pg8::StaticOrder S; S.init(M, 1536, G, bid);
                EpiQKV E{(bf16_t*)(ws + WS_QKV1)};
                pg8::gemm_phase<EpiQKV, pg8::StaticOrder, true, true>(lds, g, S, E);
            }
            GSYNC();
#if PHMASK & 32
            for (int rp = 0; rp < REP_ATTN; ++rp) for (int u = bid; u < 512; u += G) attn_unit(lds, u, (const bf16_t*)(ws + WS_QKV1), a.in[7], ACAT);
#endif
            GSYNC();
        }
        {
            pg8::Gemm g{ACAT, (const bf16_t*)(ws + (layer == 0 ? WS_WO0 : WS_WO1)), M, 1024, 1024}; pg8::StaticOrder S; S.init(M, 1024, G, bid);
            if (layer == 0) { typedef EpiRmsRes<0, 1 * D, 2 * D, true, false> EP; EP E{a.in[0], a.out, ws, gains}; pg8::gemm_phase<EP, pg8::StaticOrder, false, true>(lds, g, S, E); }
            else            { typedef EpiRmsRes<4, 5 * D, 6 * D, false, false> EP; EP E{a.out, a.out, ws, gains}; pg8::gemm_phase<EP, pg8::StaticOrder, false, true>(lds, g, S, E); }
        }
        GSYNC();
        {
            pg8::Gemm g{XN, (const bf16_t*)(ws + WS_W13) + (size_t)layer * W13_STRIDE, M, 5632, 1024}; pg8::StaticOrder S; S.init(M, 5632, G, bid);
            EpiSwiglu E{HB};
            pg8::gemm_phase<EpiSwiglu, pg8::StaticOrder, true, true>(lds, g, S, E);
        }
        if (layer == 0) {
            if ((G & 1) == 0) { if (bid >= G / 2) conv_items<2>(a, (LAS float*)(lds + wave * 16384), (bid - G / 2) * 8 + wave, (G / 2) * 8, lane); }
            else conv_items<2>(a, (LAS float*)(lds + wave * 16384), gw, ngw, lane);
        }
        GSYNC();
        {
            pg8::Gemm g{HB, (const bf16_t*)(ws + WS_W2) + (size_t)layer * W2_STRIDE, M, 1024, FF}; pg8::StaticOrder S; S.init(M, 1024, G, bid);
            if (layer == 0) { typedef EpiRmsRes<2, 3 * D, 4 * D, false, false> EP; EP E{a.out, a.out, ws, gains}; pg8::gemm_phase<EP, pg8::StaticOrder, false, true>(lds, g, S, E); }
            else            { typedef EpiRmsRes<6, 7 * D, -1, false, true> EP; EP E{a.out, a.out, ws, gains}; pg8::gemm_phase<EP, pg8::StaticOrder, false, true>(lds, g, S, E); }
        }
        if (layer == 0) GSYNC();
    }
}

extern "C" void kernel_launch(void* const* d_in, const int* in_sizes, int n_in, void* d_out, int out_size, void* d_ws, size_t ws_size, hipStream_t stream) {
    static int grid = 0;
    if (grid == 0) {
        if (n_in != 12 || out_size != M * D || ws_size < WS_END) { fprintf(stderr, "kernel_launch: unexpected shapes (n_in %d out %d ws %zu)\n", n_in, out_size, ws_size); grid = -1; return; }
        int dev = 0, cus = 0, per_cu = 0;
        hipGetDevice(&dev); hipDeviceGetAttribute(&cus, hipDeviceAttributeMultiprocessorCount, dev);
        if (hipFuncSetAttribute((const void*)fwd_megakernel, hipFuncAttributeMaxDynamicSharedMemorySize, LDS_BYTES) != hipSuccess) { fprintf(stderr, "kernel_launch: hipFuncSetAttribute failed\n"); grid = -1; return; }
        if (hipOccupancyMaxActiveBlocksPerMultiprocessor(&per_cu, (const void*)fwd_megakernel, 512, LDS_BYTES) != hipSuccess || per_cu < 1) { fprintf(stderr, "kernel_launch: occupancy query gave %d\n", per_cu); per_cu = 1; }
        (void)hipGetLastError();
        grid = cus;
    }
    if (grid < 0) return;
    Args a{};
    for (int i = 0; i < 12; ++i) a.in[i] = (const float*)d_in[i];
    a.out = (float*)d_out; a.ws = (unsigned char*)d_ws;
    if (hipMemsetAsync(d_ws, 0, 65536 + 8 * 16384, stream) != hipSuccess) { fprintf(stderr, "kernel_launch: memset failed\n"); return; }
    void* args[] = {&a};
    hipError_t e = hipLaunchCooperativeKernel((const void*)fwd_megakernel, dim3(grid), dim3(512), args, LDS_BYTES, stream);
    if (e != hipSuccess) fprintf(stderr, "cooperative launch failed: %s (grid %d)\n", hipGetErrorString(e), grid);
}
```

```cpp
#include <hip/hip_runtime.h>
#include <hip/hip_cooperative_groups.h>
#include <cstdio>
#include <cstdint>
namespace cg = cooperative_groups;
namespace pg8 {
#define PG8_LAS __attribute__((address_space(3)))
typedef unsigned short bf16_t;
typedef short bf16x8 __attribute__((ext_vector_type(8)));
typedef float f32x4 __attribute__((ext_vector_type(4)));
typedef unsigned u32x4 __attribute__((ext_vector_type(4)));
constexpr int BM = 256, BK = 64, HALF = 128, HTB = HALF * BK * 2  , STAGE_BYTES = 8 * HTB, NXCD = 8, WGM = 8;

__host__ __device__ __forceinline__ int lds_byte(int r, int c) { const int st = (r >> 4) * 2 + (c >> 5), rr = r & 15, cc = c & 31, ob = rr * 64 + cc * 2; return st * 1024 + (ob ^ (((ob >> 9) & 1) << 5)); }
__host__ __device__ __forceinline__ void stage_rc(int b, int& R, int& C) { const int st = b / 1024, sb = b % 1024, swz = sb ^ (((sb >> 9) & 1) << 5); R = (st >> 1) * 16 + swz / 64; C = (st & 1) * 32 + (swz % 64) / 2; }
__host__ __device__ __forceinline__ int perm32(int rho) { const int n = rho >> 4, i = rho & 15; return 8 * (i >> 2) + 4 * n + (i & 3); }

struct Unit { int pm, pn; };
struct Gemm { const bf16_t* A; const bf16_t* Bt; int M, N, K; };

struct StaticOrder {
    int nM, nN, nwg, G, c;
    __host__ __device__ void init(int M, int N, int G_, int c_) { nM = M / BM; nN = N / BM; nwg = nM * nN; G = G_; c = c_; }
    __host__ __device__ bool next(int i, Unit& u) const {
        const long L = (long)i * G + c; if (L >= nwg) return false;
        int wgid = (int)L; { const int q = nwg / NXCD, r = nwg % NXCD, xcd = wgid % NXCD, off = wgid / NXCD; wgid = (xcd < r ? xcd * (q + 1) : r * (q + 1) + (xcd - r) * q) + off; }
        const int nig = WGM * nN, gid = wgid / nig, fm = gid * WGM, gsz = (nM - fm) < WGM ? (nM - fm) : WGM;
        u.pm = fm + ((wgid % nig) % gsz); u.pn = (wgid % nig) / gsz; return true;
    }
    __device__ __forceinline__ void a_ready(const Unit&) const {}
    __device__ __forceinline__ void done(const Unit&) const {}
};

typedef float f32x2_t __attribute__((ext_vector_type(2))); typedef __bf16 bf16x2_t __attribute__((ext_vector_type(2)));
__device__ __forceinline__ unsigned cvt_pk_bf16(float lo, float hi) { f32x2_t v = {lo, hi}; bf16x2_t b = __builtin_convertvector(v, bf16x2_t); return __builtin_bit_cast(unsigned, b); }
template <class Epi, class Sched, bool ALIGN_EPI = false, bool SP2 = false>
__device__ __forceinline__ void gemm_phase(PG8_LAS unsigned char* lds, const Gemm g, const Sched& S, const Epi& E) {
    int tid_ = threadIdx.x; asm volatile("" : "+v"(tid_));
    const int tid = tid_, wid = __builtin_amdgcn_readfirstlane(tid >> 6), lane = tid & 63, wr = wid >> 2, wc = wid & 3, fr = lane & 15, fq = lane >> 4;
    const int K = g.K, nt = K / BK;
    unsigned voffA[2], voffB[2];
#pragma unroll
    for (int i = 0; i < 2; ++i) { int R, C; stage_rc(tid * 16 + i * 8192, R, C); const int Rb = Epi::PERM ? ((R & ~31) + perm32(R & 31)) : R;
        voffA[i] = (unsigned)(R * K + C) * 2u; voffB[i] = (unsigned)(Rb * K + C) * 2u; }
    const size_t kstep = (size_t)(BK * 2);
    const size_t hstep = (size_t)HALF * K * 2;
    const size_t tstep = 2 * hstep;
    const unsigned ldsw = (unsigned)wid * 1024u;
    const int aoff = lds_byte(wr * 64 + fr, fq * 8), boff = lds_byte(wc * 32 + fr, fq * 8);
#define PG8_SA(b, h) (((b) * 2 + (h)) * HTB)
#define PG8_SB(b, h) ((4 + (b) * 2 + (h)) * HTB)
#define PG8_STAGE(bufoff, gbase, voff) do { _Pragma("unroll") for (int _i = 0; _i < 2; ++_i) \
        __builtin_amdgcn_global_load_lds((const unsigned*)((const char*)(gbase) + (voff)[_i]), (PG8_LAS unsigned*)(lds + (bufoff) + ldsw + _i * 8192), 16, 0, 0); } while (0)
#define PG8_LDA(dst, b, h) do { _Pragma("unroll") for (int m = 0; m < 4; ++m) _Pragma("unroll") for (int k = 0; k < 2; ++k) dst[m][k] = *(const PG8_LAS bf16x8*)(lds + PG8_SA(b, h) + aoff + m * 2048 + k * 1024); } while (0)
#define PG8_LDB(dst, b, h) do { _Pragma("unroll") for (int n = 0; n < 2; ++n) _Pragma("unroll") for (int k = 0; k < 2; ++k) dst[n][k] = *(const PG8_LAS bf16x8*)(lds + PG8_SB(b, h) + boff + n * 2048 + k * 1024); } while (0)
#define PG8_MMA(ai, bj, At, Bt) do { __builtin_amdgcn_s_setprio(1); _Pragma("unroll") for (int m = 0; m < 4; ++m) _Pragma("unroll") for (int n = 0; n < 2; ++n) _Pragma("unroll") for (int k = 0; k < 2; ++k) \
        acc[ai][bj][m][n] = __builtin_amdgcn_mfma_f32_16x16x32_bf16(Bt[n][k], At[m][k], acc[ai][bj][m][n], 0, 0, 0); __builtin_amdgcn_s_setprio(0); } while (0)
#define PG8_WAIT_V(n) asm volatile("s_waitcnt vmcnt(" #n ")" ::: "memory")
#define PG8_WAIT_L(n) asm volatile("s_waitcnt lgkmcnt(" #n ")" ::: "memory")
#define PG8_BAR __builtin_amdgcn_s_barrier()
#define PG8_SCHED __builtin_amdgcn_sched_barrier(0)
    Unit cur, nxt; int ui = 0;
    if (!S.next(0, cur)) return;
    f32x4 acc[2][2][4][2];
#pragma unroll
    for (int a = 0; a < 2; ++a)
#pragma unroll
        for (int b = 0; b < 2; ++b)
#pragma unroll
            for (int m = 0; m < 4; ++m)
#pragma unroll
                for (int n = 0; n < 2; ++n) acc[a][b][m][n] = (f32x4){0.f, 0.f, 0.f, 0.f};
    bf16x8 At[4][2], B0[2][2], B1[2][2];
    const char* cA = (const char*)g.A + (size_t)cur.pm * tstep; const char* cB = (const char*)g.Bt + (size_t)cur.pn * tstep;
    S.a_ready(cur);
    if constexpr (SP2) {
        PG8_STAGE(PG8_SB(0, 0), cB, voffB); PG8_STAGE(PG8_SB(0, 1), cB + hstep, voffB); PG8_STAGE(PG8_SA(0, 0), cA, voffA); PG8_STAGE(PG8_SA(0, 1), cA + hstep, voffA);
        if (wr == 1) PG8_BAR;
        PG8_WAIT_V(2); PG8_BAR;
        PG8_STAGE(PG8_SB(1, 0), cB + kstep, voffB); PG8_STAGE(PG8_SA(1, 0), cA + kstep, voffA); PG8_STAGE(PG8_SB(1, 1), cB + hstep + kstep, voffB);
        PG8_WAIT_V(6); PG8_BAR;
    } else {
        PG8_STAGE(PG8_SB(0, 0), cB, voffB); PG8_STAGE(PG8_SA(0, 0), cA, voffA); PG8_STAGE(PG8_SB(0, 1), cB + hstep, voffB); PG8_STAGE(PG8_SA(0, 1), cA + hstep, voffA);
        if (wr == 1) PG8_BAR;
        PG8_WAIT_V(4); PG8_BAR;
        PG8_STAGE(PG8_SB(1, 0), cB + kstep, voffB); PG8_STAGE(PG8_SA(1, 0), cA + kstep, voffA); PG8_STAGE(PG8_SB(1, 1), cB + hstep + kstep, voffB);
        PG8_WAIT_V(6); PG8_BAR;
    }
    for (;;) {
        const bool has_next = S.next(ui + 1, nxt);
        const char* nA = has_next ? (const char*)g.A + (size_t)nxt.pm * tstep : cA; const char* nB = has_next ? (const char*)g.Bt + (size_t)nxt.pn * tstep : cB;
        for (int t = 0; t < nt; t += 2) {
            const bool last = (t == nt - 2);
            const char* a1 = cA + (size_t)(t + 1) * kstep;
            const char* a2 = last ? nA : cA + (size_t)(t + 2) * kstep; const char* b2 = last ? nB : cB + (size_t)(t + 2) * kstep;
            const char* a3 = a2 + kstep; const char* b3 = b2 + kstep;
            if (last && has_next) S.a_ready(nxt);
            if constexpr (SP2) {
            PG8_LDB(B0, 0, 0); PG8_LDB(B1, 0, 1); PG8_SCHED; PG8_LDA(At, 0, 0); PG8_STAGE(PG8_SA(1, 1), a1 + hstep, voffA);
            PG8_WAIT_V(8); PG8_WAIT_L(0); PG8_BAR; PG8_MMA(0, 0, At, B0); PG8_MMA(0, 1, At, B1); PG8_BAR; PG8_SCHED;
            PG8_LDA(At, 0, 1); PG8_STAGE(PG8_SB(0, 0), b2, voffB); PG8_STAGE(PG8_SB(0, 1), b2 + hstep, voffB); PG8_STAGE(PG8_SA(0, 0), a2, voffA);
            PG8_WAIT_V(8); PG8_WAIT_L(0); PG8_BAR; PG8_MMA(1, 0, At, B0); PG8_MMA(1, 1, At, B1); PG8_BAR; PG8_SCHED;
            PG8_LDB(B0, 1, 0); PG8_LDB(B1, 1, 1); PG8_SCHED; PG8_LDA(At, 1, 0); PG8_STAGE(PG8_SA(0, 1), a2 + hstep, voffA);
            PG8_WAIT_V(8); PG8_WAIT_L(0); PG8_BAR; PG8_MMA(0, 0, At, B0); PG8_MMA(0, 1, At, B1); PG8_BAR; PG8_SCHED;
            PG8_LDA(At, 1, 1); PG8_STAGE(PG8_SB(1, 0), b3, voffB); PG8_STAGE(PG8_SB(1, 1), b3 + hstep, voffB); PG8_STAGE(PG8_SA(1, 0), a3, voffA);
            PG8_WAIT_V(8); PG8_WAIT_L(0); PG8_BAR; PG8_MMA(1, 0, At, B0); PG8_MMA(1, 1, At, B1); PG8_BAR; PG8_SCHED;
            } else {
            PG8_LDB(B0, 0, 0); PG8_SCHED; PG8_LDA(At, 0, 0); PG8_STAGE(PG8_SA(1, 1), a1 + hstep, voffA);
            PG8_WAIT_L(8); PG8_BAR; PG8_WAIT_L(0); PG8_MMA(0, 0, At, B0); PG8_BAR; PG8_SCHED;
            PG8_LDB(B1, 0, 1); PG8_STAGE(PG8_SB(0, 0), b2, voffB);
            PG8_BAR; PG8_WAIT_L(0); PG8_MMA(0, 1, At, B1); PG8_BAR;
            PG8_LDA(At, 0, 1); PG8_STAGE(PG8_SA(0, 0), a2, voffA);
            PG8_BAR; PG8_WAIT_L(0); PG8_MMA(1, 0, At, B0); PG8_BAR; PG8_SCHED;
            PG8_STAGE(PG8_SB(0, 1), b2 + hstep, voffB);
            PG8_WAIT_V(6); PG8_BAR; PG8_MMA(1, 1, At, B1); PG8_BAR;
            PG8_LDB(B0, 1, 0); PG8_SCHED; PG8_LDA(At, 1, 0); PG8_STAGE(PG8_SA(0, 1), a2 + hstep, voffA);
            PG8_WAIT_L(8); PG8_BAR; PG8_WAIT_L(0); PG8_MMA(0, 0, At, B0); PG8_BAR; PG8_SCHED;
            PG8_LDB(B1, 1, 1); PG8_STAGE(PG8_SB(1, 0), b3, voffB);
            PG8_BAR; PG8_WAIT_L(0); PG8_MMA(0, 1, At, B1); PG8_BAR;
            PG8_LDA(At, 1, 1); PG8_STAGE(PG8_SA(1, 0), a3, voffA);
            PG8_BAR; PG8_WAIT_L(0); PG8_MMA(1, 0, At, B0); PG8_BAR; PG8_SCHED;
            PG8_STAGE(PG8_SB(1, 1), b3 + hstep, voffB);
            PG8_WAIT_V(6); PG8_BAR; PG8_MMA(1, 1, At, B1); PG8_BAR;
            }
        }
        if constexpr (ALIGN_EPI) { if (wr == 0) PG8_BAR; }
        if constexpr (!Epi::AFTER_DRAIN) { E(acc, cur, wr, wc, fr, fq); S.done(cur); }
        if (!has_next) break;
#pragma unroll
        for (int a = 0; a < 2; ++a)
#pragma unroll
            for (int b = 0; b < 2; ++b)
#pragma unroll
                for (int m = 0; m < 4; ++m)
#pragma unroll
                    for (int n = 0; n < 2; ++n) acc[a][b][m][n] = (f32x4){0.f, 0.f, 0.f, 0.f};
        cur = nxt; cA = nA; cB = nB; ++ui;
        if constexpr (ALIGN_EPI) { if (wr == 1) PG8_BAR; }
    }
    PG8_WAIT_V(0);
    if constexpr (!ALIGN_EPI) { if (wr == 0) PG8_BAR; }
    PG8_BAR;
    if constexpr (Epi::AFTER_DRAIN) { E.fused(acc, cur, wr, wc, fr, fq, lds, wid, lane); S.done(cur); }
#undef PG8_SA
#undef PG8_SB
#undef PG8_STAGE
#undef PG8_LDA
#undef PG8_LDB
#undef PG8_MMA
#undef PG8_WAIT_V
#undef PG8_WAIT_L
#undef PG8_BAR
#undef PG8_SCHED
}
}

#define LAS __attribute__((address_space(3)))
#ifndef PROBE_K
#define PROBE_K -1
#endif
#ifndef PROBE_H
#define PROBE_H -1
#endif
using pg8::bf16_t; using pg8::bf16x8; using pg8::f32x4; using pg8::u32x4; using pg8::Unit; using pg8::cvt_pk_bf16;
typedef float f32x16 __attribute__((ext_vector_type(16)));
typedef unsigned u32x2 __attribute__((ext_vector_type(2)));
typedef short s16x4 __attribute__((ext_vector_type(4)));
#define MFMA32(a, b, c) __builtin_amdgcn_mfma_f32_32x32x16_bf16((a), (b), (c), 0, 0, 0)

constexpr int NB = 8, T = 2048, D = 1024, M = NB * T, FF = 2816;
constexpr float EPS = 1e-6f;
constexpr float LOG2E = 1.4426950408889634f;
constexpr int LDS_BYTES = 147456;

constexpr size_t MiB = 1u << 20;
constexpr size_t WS_WP = 1 * MiB;
constexpr size_t WS_WCS = 6 * MiB;
constexpr size_t WS_DFT = 8 * MiB;
constexpr size_t WS_WO0 = 24 * MiB;
constexpr size_t WS_WQKV = 26 * MiB;
constexpr size_t WS_WO1 = 29 * MiB;
constexpr size_t WS_W13 = 31 * MiB;
constexpr size_t WS_W2 = 53 * MiB;
constexpr size_t W13_STRIDE = (size_t)5632 * 1024, W2_STRIDE = (size_t)1024 * 2816;
constexpr size_t WS_CNT = 65536;
constexpr size_t WS_XBUF = 64 * MiB;
constexpr size_t WS_XN = 66 * MiB;
constexpr size_t WS_MBUF = 98 * MiB;
constexpr size_t WS_XRES = 98 * MiB;
constexpr size_t WS_YT = 98 * MiB;
constexpr size_t WS_OFB = 130 * MiB;
constexpr size_t WS_Q0 = 162 * MiB;
constexpr size_t WS_V0 = 178 * MiB;
constexpr size_t WS_GATE = 194 * MiB;
constexpr size_t WS_ACAT = 210 * MiB;
constexpr size_t WS_H = 162 * MiB;
constexpr size_t WS_QKV1 = 162 * MiB;
constexpr size_t WS_HC = 242 * MiB;
constexpr size_t WS_CCTR = 49152;
constexpr size_t WS_HFLAG = 32768;
constexpr size_t WS_SSQ = 250 * MiB;
constexpr size_t WS_END = 256 * MiB;

__device__ __forceinline__ unsigned f2bf(float f) { unsigned u = __builtin_bit_cast(unsigned, f); return (u + 0x7fffu + ((u >> 16) & 1u)) >> 16; }
__device__ __forceinline__ float bf2f(unsigned short h) { return __builtin_bit_cast(float, (unsigned)h << 16); }
__device__ __forceinline__ float wave_sum(float v) {
#pragma unroll
    for (int o = 1; o < 64; o <<= 1) v += __shfl_xor(v, o);
    return v;
}
__device__ __forceinline__ int crow(int r, int hi) { return (r & 3) + 8 * (r >> 2) + 4 * hi; }
#define LDS_WAIT() asm volatile("s_waitcnt lgkmcnt(0)" ::: "memory")
#define XB_TMO      128
#define XB_XCNT(j)  (256  + 64 * (j))
#define XB_XSUB(j)  (1280 + 64 * (j))
#define XB_XGEN(j)  (2304 + 64 * (j))
#define XB_TOP      3328
#define XB_TOPGEN   3392
#define XCD_BAR_WORDS 3456
#define XB_SPIN_CAP (1u << 18)

__device__ __forceinline__ unsigned xb_ld(unsigned* p)              { return __hip_atomic_load(p, __ATOMIC_RELAXED, __HIP_MEMORY_SCOPE_AGENT); }
__device__ __forceinline__ unsigned xb_add(unsigned* p, unsigned v) { return __hip_atomic_fetch_add(p, v, __ATOMIC_RELAXED, __HIP_MEMORY_SCOPE_AGENT); }
__device__ __forceinline__ unsigned xb_xcc_id() { return (unsigned)__builtin_amdgcn_s_getreg((3 << 11) | 20) & 0xFu; }
#define XB_SPIN(cond, bar) do { unsigned _sp = 0; while (cond) { __builtin_amdgcn_s_sleep(1); \
    if ((++_sp & 255u) == 0u) { if (xb_ld(&(bar)[XB_TMO])) break; if (_sp > XB_SPIN_CAP) { atomicAdd(&(bar)[XB_TMO], 1u); break; } } } } while (0)

struct XcdBarrier {
    unsigned* bar; unsigned x;
    volatile LAS unsigned* st;
};

__device__ __forceinline__ XcdBarrier xcd_barrier_post(unsigned* bar, volatile LAS unsigned* st) {
    XcdBarrier b; b.bar = bar; b.x = xb_xcc_id(); b.st = st;
    if (threadIdx.x == 0) (void)xb_add(&bar[XB_XCNT(b.x)], 1u);
    return b;
}
__device__ __forceinline__ void xcd_barrier_complete(unsigned* bar, unsigned x, unsigned& nloc, unsigned& nx) {
    const unsigned G = gridDim.x * gridDim.y * gridDim.z;
    unsigned sum, cnt, mine, sp = 0u;
    for (;;) {
        sum = 0u; cnt = 0u; mine = 0u;
#pragma unroll
        for (unsigned j = 0; j < 16; ++j) { const unsigned c = xb_ld(&bar[XB_XCNT(j)]); sum += c; cnt += (c > 0u) ? 1u : 0u; mine = (j == x) ? c : mine; }
        if (sum == G) break;
        __builtin_amdgcn_s_sleep(1);
        if ((++sp & 255u) == 0u) { if (xb_ld(&bar[XB_TMO])) break; if (sp > XB_SPIN_CAP) { atomicAdd(&bar[XB_TMO], 1u); break; } }
    }
    nloc = mine > 0u ? mine : 1u; nx = cnt > 0u ? cnt : 1u;
}

__device__ __forceinline__ void xcd_barrier(const XcdBarrier& b) {
    asm volatile("s_waitcnt vmcnt(0)" ::: "memory");
    __syncthreads();
    if (threadIdx.x == 0) {
        unsigned* bar = b.bar;
        __builtin_amdgcn_s_waitcnt(0);
        unsigned nloc = b.st[0], nx = b.st[1];
        if (nloc == 0u) { xcd_barrier_complete(bar, b.x, nloc, nx); b.st[0] = nloc; b.st[1] = nx; }
        const unsigned old = xb_add(&bar[XB_XSUB(b.x)], 1u);
        const unsigned gen = old / nloc;
        if (old + 1u == (gen + 1u) * nloc) {
            __builtin_amdgcn_fence(__ATOMIC_RELEASE, "agent");
            asm volatile("s_waitcnt vmcnt(0)" ::: "memory");
            const unsigned og = xb_add(&bar[XB_TOP], 1u);
            const unsigned tg = og / nx;
            if (og + 1u == (tg + 1u) * nx) xb_add(&bar[XB_TOPGEN], 1u);
            else XB_SPIN(xb_ld(&bar[XB_TOPGEN]) == tg, bar);
            __builtin_amdgcn_fence(__ATOMIC_ACQUIRE, "agent");
            xb_add(&bar[XB_XGEN(b.x)], 1u);
            asm volatile("s_waitcnt vmcnt(0)" ::: "memory");
        } else {
            XB_SPIN(xb_ld(&bar[XB_XGEN(b.x)]) == gen, bar);
            __builtin_amdgcn_fence(__ATOMIC_ACQUIRE, "agent");
            asm volatile("s_waitcnt vmcnt(0)" ::: "memory");
        }
    }
    __syncthreads();
}

struct EpiProj {
    static constexpr bool PERM = true, AFTER_DRAIN = false;
    bf16_t* Q0; float* LOGF; const float* tab;
    __device__ __forceinline__ void operator()(const f32x4 (&acc)[2][2][4][2], const Unit& u, int wr, int wc, int fr, int fq) const {
        const int slot = u.pn >> 1, seg = slot == 2 ? 3 : (slot == 3 ? 2 : slot);
        const int cseg = (u.pn & 1) * 256 + wc * 32 + 8 * fq;
        const int row0 = u.pm * 256 + wr * 64 + fr;
        if (seg == 1 || seg == 2) {
            const int dir = seg - 1;
#pragma unroll
            for (int bj = 0; bj < 2; ++bj) {
                const int c = cseg + bj * 128;
                const f32x4 ta0 = *(const f32x4*)(tab + dir * 512 + c), ta1 = *(const f32x4*)(tab + dir * 512 + c + 4);
                const f32x4 tb0 = *(const f32x4*)(tab + 1024 + dir * 512 + c), tb1 = *(const f32x4*)(tab + 1024 + dir * 512 + c + 4);
                f32x4 lb0, lb1;
#pragma unroll
                for (int e = 0; e < 4; ++e) { lb0[e] = __builtin_amdgcn_rcpf(1.0f + __expf(tb0[e] - ta0[e])); lb1[e] = __builtin_amdgcn_rcpf(1.0f + __expf(tb1[e] - ta1[e])); }
#pragma unroll
                for (int ai = 0; ai < 2; ++ai)
#pragma unroll
                    for (int m = 0; m < 4; ++m) {
                        float* dst = LOGF + (size_t)(row0 + ai * 128 + m * 16) * 1024 + dir * 512 + c;
                        const f32x4 z0 = acc[ai][bj][m][0], z1 = acc[ai][bj][m][1]; f32x4 o0, o1;
#pragma unroll
                        for (int e = 0; e < 4; ++e) {
                            const float s0 = __builtin_amdgcn_rcpf(1.0f + __expf(-z0[e])), s1 = __builtin_amdgcn_rcpf(1.0f + __expf(-z1[e]));
                            o0[e] = __builtin_amdgcn_logf(lb0[e] + (1.0f - lb0[e]) * s0) * 0.6931471805599453f; o1[e] = __builtin_amdgcn_logf(lb1[e] + (1.0f - lb1[e]) * s1) * 0.6931471805599453f;
                        }
                        *(f32x4*)dst = o0; *(f32x4*)(dst + 4) = o1;
                    }
            }
        } else {
            bf16_t* base = Q0 + (size_t)(seg == 0 ? 0 : seg - 2) * ((size_t)M * 512);
            const float sc = seg == 0 ? 0.08838834764831845f : 1.0f;
#pragma unroll
            for (int bj = 0; bj < 2; ++bj) {
                const int c = cseg + bj * 128;
#pragma unroll
                for (int ai = 0; ai < 2; ++ai)
#pragma unroll
                    for (int m = 0; m < 4; ++m) {
                        f32x4 v0 = acc[ai][bj][m][0], v1 = acc[ai][bj][m][1];
                        if (seg == 4) {
#pragma unroll
                            for (int e = 0; e < 4; ++e) { v0[e] = v0[e] * __builtin_amdgcn_rcpf(1.0f + __expf(-v0[e])); v1[e] = v1[e] * __builtin_amdgcn_rcpf(1.0f + __expf(-v1[e])); }
                        } else { v0 = v0 * sc; v1 = v1 * sc; }
                        u32x4 w; w.x = cvt_pk_bf16(v0[0], v0[1]); w.y = cvt_pk_bf16(v0[2], v0[3]); w.z = cvt_pk_bf16(v1[0], v1[1]); w.w = cvt_pk_bf16(v1[2], v1[3]);
                        *(u32x4*)(base + (size_t)(row0 + ai * 128 + m * 16) * 512 + c) = w;
                    }
            }
        }
    }
};
struct EpiYt {
    static constexpr bool PERM = true, AFTER_DRAIN = false;
    bf16_t* Yt;
    __device__ __forceinline__ void operator()(const f32x4 (&acc)[2][2][4][2], const Unit& u, int wr, int wc, int fr, int fq) const {
        const int row0 = u.pm * 256 + wr * 64 + fr, tok0 = u.pn * 256 + wc * 32 + 8 * fq;
#pragma unroll
        for (int ai = 0; ai < 2; ++ai)
#pragma unroll
            for (int m = 0; m < 4; ++m) {
                const int f = row0 + ai * 128 + m * 16, cs = f >> 9, n_ = f & 511;
#pragma unroll
                for (int bj = 0; bj < 2; ++bj) {
                    const int tok = tok0 + bj * 128, b = tok >> 11, t = tok & 2047;
                    const f32x4 v0 = acc[ai][bj][m][0], v1 = acc[ai][bj][m][1];
                    u32x4 w; w.x = cvt_pk_bf16(v0[0], v0[1]); w.y = cvt_pk_bf16(v0[2], v0[3]); w.z = cvt_pk_bf16(v1[0], v1[1]); w.w = cvt_pk_bf16(v1[2], v1[3]);
                    *(u32x4*)(Yt + ((size_t)(b * 512 + n_) * 2 + cs) * 2048 + t) = w;
                }
            }
    }
};
struct EpiFnet {
    static constexpr bool PERM = true, AFTER_DRAIN = false;
    bf16_t* ACAT;
    __device__ __forceinline__ void operator()(const f32x4 (&acc)[2][2][4][2], const Unit& u, int wr, int wc, int fr, int fq) const {
        const int row0 = u.pm * 256 + wr * 64 + fr, col0 = u.pn * 256 + wc * 32 + 8 * fq;
#pragma unroll
        for (int ai = 0; ai < 2; ++ai)
#pragma unroll
            for (int m = 0; m < 4; ++m) {
                const int k1 = row0 + ai * 128 + m * 16;
#pragma unroll
                for (int bj = 0; bj < 2; ++bj) {
                    const int c = col0 + bj * 128, b = c >> 9, n_ = c & 511;
                    const f32x4 v0 = acc[ai][bj][m][0], v1 = acc[ai][bj][m][1];
                    u32x4 w; w.x = cvt_pk_bf16(v0[0], v0[1]); w.y = cvt_pk_bf16(v0[2], v0[3]); w.z = cvt_pk_bf16(v1[0], v1[1]); w.w = cvt_pk_bf16(v1[2], v1[3]);
                    *(u32x4*)(ACAT + (size_t)(b * 2048 + k1) * 1024 + 512 + n_) = w;
                }
            }
    }
};
struct EpiF32 {
    static constexpr bool PERM = false, AFTER_DRAIN = false;
    float* O; int ldc;
    __device__ __forceinline__ void operator()(const f32x4 (&acc)[2][2][4][2], const Unit& u, int wr, int wc, int fr, int fq) const {
        const int row0 = u.pm * 256 + wr * 64 + fr, col0 = u.pn * 256 + wc * 32 + 4 * fq;
#pragma unroll
        for (int ai = 0; ai < 2; ++ai)
#pragma unroll
            for (int m = 0; m < 4; ++m) {
                float* rowp = O + (size_t)(row0 + ai * 128 + m * 16) * ldc + col0;
#pragma unroll
                for (int bj = 0; bj < 2; ++bj)
#pragma unroll
                    for (int n = 0; n < 2; ++n) *(f32x4*)(rowp + bj * 128 + n * 16) = acc[ai][bj][m][n];
            }
    }
};
struct RowSsq {
    unsigned* xbuf;
    unsigned* cnt;
    __device__ __forceinline__ void run(const f32x4 (&v)[2][2][4][2], const Unit& u, int wr, int wc, int fr, int fq, LAS unsigned char* lds, int wid, int lane) const {
        LAS float* P = (LAS float*)lds;
        LAS float* S = (LAS float*)(lds + 8192);
#pragma unroll
        for (int ai = 0; ai < 2; ++ai)
#pragma unroll
            for (int m = 0; m < 4; ++m) {
                float q = 0.f;
#pragma unroll
                for (int bj = 0; bj < 2; ++bj)
#pragma unroll
                    for (int n = 0; n < 2; ++n) { const f32x4 x = v[ai][bj][m][n]; q += (x[0] * x[0] + x[1] * x[1]) + (x[2] * x[2] + x[3] * x[3]); }
                q += __shfl_xor(q, 16); q += __shfl_xor(q, 32);
                if (fq == 0) P[(ai * 128 + wr * 64 + m * 16 + fr) * 4 + wc] = q;
            }
        asm volatile("s_waitcnt lgkmcnt(0)" ::: "memory"); __builtin_amdgcn_s_barrier(); asm volatile("" ::: "memory");
        const int row = wid * 32 + (lane & 31);
        if (lane < 32) {
            const float tot = (P[row * 4 + 0] + P[row * 4 + 1]) + (P[row * 4 + 2] + P[row * 4 + 3]);
            __hip_atomic_store(xbuf + ((size_t)(u.pm * 256 + row) * 4 + u.pn), __float_as_uint(tot), __ATOMIC_RELAXED, __HIP_MEMORY_SCOPE_AGENT);
        }
        asm volatile("s_waitcnt vmcnt(0)" ::: "memory");
        if (lane == 0) __hip_atomic_fetch_add(cnt + 64 * u.pm, 1u, __ATOMIC_RELAXED, __HIP_MEMORY_SCOPE_AGENT);
        if (wid == 0) {
            unsigned sp = 0;
            while ((unsigned)__builtin_amdgcn_readfirstlane(__hip_atomic_load(cnt + 64 * u.pm, __ATOMIC_RELAXED, __HIP_MEMORY_SCOPE_AGENT)) < 32u) { __builtin_amdgcn_s_sleep(2); if (++sp > (1u << 22)) break; }
            __builtin_amdgcn_fence(__ATOMIC_ACQUIRE, "agent");
        }
        asm volatile("s_waitcnt vmcnt(0) lgkmcnt(0)" ::: "memory"); __builtin_amdgcn_s_barrier(); asm volatile("" ::: "memory");
        if (lane < 32) {
            const unsigned* slot = xbuf + (size_t)(u.pm * 256 + row) * 4; float t = 0.f;
#pragma unroll
            for (int k = 0; k < 4; ++k) t += __uint_as_float(__hip_atomic_load(slot + k, __ATOMIC_RELAXED, __HIP_MEMORY_SCOPE_AGENT));
            S[row] = t;
        }
        asm volatile("s_waitcnt lgkmcnt(0)" ::: "memory"); __builtin_amdgcn_s_barrier(); asm volatile("" ::: "memory");
    }
};
__device__ __forceinline__ void row_ssq_partial(const f32x4 (&v)[2][2][4][2], const Unit& u, int wr, int wc, int fr, int fq, LAS unsigned char* lds, int wid, int lane, float* ssq) {
    LAS float* P = (LAS float*)lds;
#pragma unroll
    for (int ai = 0; ai < 2; ++ai)
#pragma unroll
        for (int m = 0; m < 4; ++m) {
            float q = 0.f;
#pragma unroll
            for (int bj = 0; bj < 2; ++bj)
#pragma unroll
                for (int n = 0; n < 2; ++n) { const f32x4 x = v[ai][bj][m][n]; q += (x[0] * x[0] + x[1] * x[1]) + (x[2] * x[2] + x[3] * x[3]); }
            q += __shfl_xor(q, 16); q += __shfl_xor(q, 32);
            if (fq == 0) P[(ai * 128 + wr * 64 + m * 16 + fr) * 4 + wc] = q;
        }
    asm volatile("s_waitcnt lgkmcnt(0)" ::: "memory"); __builtin_amdgcn_s_barrier(); asm volatile("" ::: "memory");
    const int row = wid * 32 + (lane & 31);
    if (lane < 32) ssq[(size_t)(u.pm * 256 + row) * 4 + u.pn] = (P[row * 4 + 0] + P[row * 4 + 1]) + (P[row * 4 + 2] + P[row * 4 + 3]);
    asm volatile("s_waitcnt lgkmcnt(0)" ::: "memory"); __builtin_amdgcn_s_barrier(); asm volatile("" ::: "memory");
}
template <int BANK, int GPOST, int GPRE, bool BASE_F32, bool OUT_F32> struct EpiRmsRes {
    static constexpr bool PERM = false, AFTER_DRAIN = true, HAS_PRE = GPRE >= 0; static constexpr int bank = BANK;
    const float* base; float* out; unsigned char* ws; const float* gains;
    __device__ __forceinline__ void fused(f32x4 (&acc)[2][2][4][2], const Unit& u, int wr, int wc, int fr, int fq, LAS unsigned char* lds, int wid, int lane) const {
        const LAS float* S = (const LAS float*)(lds + 8192);
        const int col0 = u.pn * 256 + wc * 32 + 4 * fq;
        const float* g_post = gains + GPOST;
        bf16_t* xres = (bf16_t*)(ws + WS_XRES);
        { const RowSsq st1{(unsigned*)(ws + WS_XBUF) + (size_t)bank * 65536, (unsigned*)(ws + WS_CNT) + bank * 4096}; st1.run(acc, u, wr, wc, fr, fq, lds, wid, lane); }
#pragma unroll
        for (int ai = 0; ai < 2; ++ai)
#pragma unroll
            for (int m = 0; m < 4; ++m) {
                const int r = ai * 128 + wr * 64 + m * 16 + fr; const float rstd = rsqrtf(S[r] * (1.0f / 1024.0f) + EPS);
                const size_t off = (size_t)(u.pm * 256 + r) * 1024 + col0;
#pragma unroll
                for (int bj = 0; bj < 2; ++bj)
#pragma unroll
                    for (int n = 0; n < 2; ++n) {
                        const f32x4 g = *(const f32x4*)(g_post + col0 + bj * 128 + n * 16); f32x4 bs;
                        if constexpr (BASE_F32) bs = *(const f32x4*)(base + off + bj * 128 + n * 16);
                        else { const u32x2 rb = *(const u32x2*)(xres + off + bj * 128 + n * 16); bs = (f32x4){bf2f((unsigned short)(rb.x & 0xffff)), bf2f((unsigned short)(rb.x >> 16)), bf2f((unsigned short)(rb.y & 0xffff)), bf2f((unsigned short)(rb.y >> 16))}; }
                        f32x4 x1 = bs + acc[ai][bj][m][n] * rstd * g;
                        if constexpr (OUT_F32) *(f32x4*)(out + off + bj * 128 + n * 16) = x1;
                        else { u32x2 w; w.x = cvt_pk_bf16(x1[0], x1[1]); w.y = cvt_pk_bf16(x1[2], x1[3]); *(u32x2*)(xres + off + bj * 128 + n * 16) = w;
                               x1 = (f32x4){bf2f((unsigned short)(w.x & 0xffff)), bf2f((unsigned short)(w.x >> 16)), bf2f((unsigned short)(w.y & 0xffff)), bf2f((unsigned short)(w.y >> 16))}; }
                        acc[ai][bj][m][n] = x1;
                    }
                asm volatile("" : "+v"(acc[ai][0][m][0]), "+v"(acc[ai][0][m][1]), "+v"(acc[ai][1][m][0]), "+v"(acc[ai][1][m][1]));
                if (m & 1) asm volatile("" ::: "memory");
            }
        if constexpr (HAS_PRE) row_ssq_partial(acc, u, wr, wc, fr, fq, lds, wid, lane, (float*)(ws + WS_SSQ) + (size_t)(BANK / 2) * ((size_t)M * 4));
    }
};
__device__ __forceinline__ float row_rstd(const float* ssq, int row) { const f32x4 q = *(const f32x4*)(ssq + (size_t)row * 4); return rsqrtf(((q[0] + q[1]) + (q[2] + q[3])) * (1.0f / 1024.0f) + EPS); }
constexpr int RSTD_OFF = 131072 + 4096;
__device__ __forceinline__ int stage_rstd(LAS unsigned char* lds, const float* ssq, const pg8::StaticOrder& S) {
    Unit u0; int pm0 = -1; if (S.next(0, u0)) pm0 = u0.pm;
    int t = threadIdx.x; asm volatile("" : "+v"(t));
    if (pm0 >= 0 && t < 256) ((LAS float*)(lds + RSTD_OFF))[t] = row_rstd(ssq, pm0 * 256 + t);
    __syncthreads();
    return pm0;
}
struct EpiSwiglu {
    static constexpr bool PERM = true, AFTER_DRAIN = false;
    bf16_t* H; const LAS float* rt;
    __device__ __forceinline__ void operator()(const f32x4 (&acc)[2][2][4][2], const Unit& u, int wr, int wc, int fr, int fq) const {
        const int row0 = u.pm * 256 + wr * 64 + fr, col0 = u.pn * 128 + wc * 32 + 8 * fq;
#pragma unroll
        for (int ai = 0; ai < 2; ++ai)
#pragma unroll
            for (int m = 0; m < 4; ++m) {
                float h[8]; const float rs = rt[ai * 128 + wr * 64 + m * 16 + fr];
#pragma unroll
                for (int n = 0; n < 2; ++n)
#pragma unroll
                    for (int e = 0; e < 4; ++e) { const float a = acc[ai][0][m][n][e] * rs, b = acc[ai][1][m][n][e] * rs; h[4 * n + e] = a * __builtin_amdgcn_rcpf(1.0f + __expf(-a)) * b; }
                u32x4 w; w.x = cvt_pk_bf16(h[0], h[1]); w.y = cvt_pk_bf16(h[2], h[3]); w.z = cvt_pk_bf16(h[4], h[5]); w.w = cvt_pk_bf16(h[6], h[7]);
                *(u32x4*)(H + (size_t)(row0 + ai * 128 + m * 16) * FF + col0) = w;
            }
    }
};
struct EpiQKV {
    static constexpr bool PERM = true, AFTER_DRAIN = false;
    bf16_t* O; const LAS float* rt;
    __device__ __forceinline__ void operator()(const f32x4 (&acc)[2][2][4][2], const Unit& u, int wr, int wc, int fr, int fq) const {
        const int row0 = u.pm * 256 + wr * 64 + fr, col0 = u.pn * 256 + wc * 32 + 8 * fq;
        const float sc = u.pn < 4 ? 0.125f * LOG2E : 1.0f;
#pragma unroll
        for (int ai = 0; ai < 2; ++ai)
#pragma unroll
            for (int m = 0; m < 4; ++m) {
                const float rs = sc * rt[ai * 128 + wr * 64 + m * 16 + fr];
#pragma unroll
                for (int bj = 0; bj < 2; ++bj) {
                    const f32x4 v0 = acc[ai][bj][m][0] * rs, v1 = acc[ai][bj][m][1] * rs;
                    u32x4 w; w.x = cvt_pk_bf16(v0[0], v0[1]); w.y = cvt_pk_bf16(v0[2], v0[3]); w.z = cvt_pk_bf16(v1[0], v1[1]); w.w = cvt_pk_bf16(v1[2], v1[3]);
                    *(u32x4*)(O + (size_t)(row0 + ai * 128 + m * 16) * 1536 + col0 + bj * 128) = w;
                }
            }
    }
};

__device__ __forceinline__ void transpose_item(const float* W, int ldw, int K, bf16_t* WT, int k0, int n0src, int dst_row0, LAS float* scr, int lane, const float* gk = nullptr) {
#pragma unroll
    for (int i = 0; i < 8; ++i) {
        const int kk = i * 8 + (lane >> 3), q4 = lane & 7;
        f32x4 v = *(const f32x4*)(W + (size_t)(k0 + kk) * ldw + n0src + 4 * q4);
        if (gk) v = v * gk[k0 + kk];
        LAS float* d = scr + kk * 33 + 4 * q4; d[0] = v.x; d[1] = v.y; d[2] = v.z; d[3] = v.w;
    }
    LDS_WAIT();
    const int c = lane & 7;
#pragma unroll
    for (int j = 0; j < 4; ++j) {
        const int n = (lane >> 3) + 8 * j; const LAS float* s = scr + (8 * c) * 33 + n;
        u32x4 o; o.x = cvt_pk_bf16(s[0 * 33], s[1 * 33]); o.y = cvt_pk_bf16(s[2 * 33], s[3 * 33]); o.z = cvt_pk_bf16(s[4 * 33], s[5 * 33]); o.w = cvt_pk_bf16(s[6 * 33], s[7 * 33]);
        *(u32x4*)(WT + (size_t)(dst_row0 + n) * K + k0 + 8 * c) = o;
    }
    LDS_WAIT();
}
__device__ __forceinline__ void rms_row_to_bf16(const float* xrow, const float* gain, bf16_t* orow, int lane) {
    f32x4 v[4]; float ss = 0.f;
#pragma unroll
    for (int j = 0; j < 4; ++j) { v[j] = ((const f32x4*)xrow)[lane + 64 * j]; ss += (v[j].x * v[j].x + v[j].y * v[j].y) + (v[j].z * v[j].z + v[j].w * v[j].w); }
    const float r = rsqrtf(wave_sum(ss) * (1.0f / D) + EPS);
#pragma unroll
    for (int j = 0; j < 4; ++j) {
        const f32x4 g = ((const f32x4*)gain)[lane + 64 * j]; const f32x4 o = v[j] * r * g;
        u32x2 w; w.x = cvt_pk_bf16(o.x, o.y); w.y = cvt_pk_bf16(o.z, o.w);
        ((u32x2*)orow)[lane + 64 * j] = w;
    }
}
__device__ __forceinline__ void postnorm_rows(const float* xin, float* xout, const float* mbuf, const float* g_post, const float* g_pre, bf16_t* XN, int gw, int ngw, int lane) {
    for (int row = gw; row < M; row += ngw) {
        const f32x4* mr = (const f32x4*)(mbuf + (size_t)row * D); const f32x4* xr = (const f32x4*)(xin + (size_t)row * D);
        f32x4 mv[4], xv[4]; float ss = 0.f;
#pragma unroll
        for (int j = 0; j < 4; ++j) { mv[j] = mr[lane + 64 * j]; xv[j] = xr[lane + 64 * j]; ss += (mv[j].x * mv[j].x + mv[j].y * mv[j].y) + (mv[j].z * mv[j].z + mv[j].w * mv[j].w); }
        const float r = rsqrtf(wave_sum(ss) * (1.0f / D) + EPS);
        float ss2 = 0.f;
#pragma unroll
        for (int j = 0; j < 4; ++j) {
            const f32x4 g = ((const f32x4*)g_post)[lane + 64 * j];
            xv[j] = xv[j] + mv[j] * r * g;
            ((f32x4*)(xout + (size_t)row * D))[lane + 64 * j] = xv[j];
            ss2 += (xv[j].x * xv[j].x + xv[j].y * xv[j].y) + (xv[j].z * xv[j].z + xv[j].w * xv[j].w);
        }
        if (g_pre) {
            const float r2 = rsqrtf(wave_sum(ss2) * (1.0f / D) + EPS);
#pragma unroll
            for (int j = 0; j < 4; ++j) {
                const f32x4 g = ((const f32x4*)g_pre)[lane + 64 * j]; const f32x4 o = xv[j] * r2 * g;
                u32x2 w; w.x = cvt_pk_bf16(o.x, o.y); w.y = cvt_pk_bf16(o.z, o.w);
                ((u32x2*)(XN + (size_t)row * D))[lane + 64 * j] = w;
            }
        }
    }
}

constexpr int HG_G = 0, HG_QR = 16384, HG_KR = HG_QR + 8704, HG_V = HG_KR + 8704, HG_STB = HG_V + 32 * 72 * 2, HG_SET = 2 * 8704 + 32 * 72 * 2 + 64 * 136 * 2  , HG_XO = HG_QR + 2 * HG_SET, HG_END = HG_XO + 2 * 2 * 1024 * 4;
static_assert(HG_END <= 131072, "hgrn lds");
__device__ __forceinline__ bf16x8 gather8(const LAS bf16_t* p, int stride) {
    unsigned a0 = p[0], a1 = p[stride], a2 = p[2 * stride], a3 = p[3 * stride], a4 = p[4 * stride], a5 = p[5 * stride], a6 = p[6 * stride], a7 = p[7 * stride];
    u32x4 w; w.x = a0 | (a1 << 16); w.y = a2 | (a3 << 16); w.z = a4 | (a5 << 16); w.w = a6 | (a7 << 16);
    return __builtin_bit_cast(bf16x8, w);
}
__device__ __forceinline__ bf16x8 gather8p(const LAS bf16_t* p, int stride) {
    unsigned a0 = p[0], a1 = p[stride], a2 = p[2 * stride], a3 = p[3 * stride], a4 = p[8 * stride], a5 = p[9 * stride], a6 = p[10 * stride], a7 = p[11 * stride];
    u32x4 w; w.x = a0 | (a1 << 16); w.y = a2 | (a3 << 16); w.z = a4 | (a5 << 16); w.w = a6 | (a7 << 16);
    return __builtin_bit_cast(bf16x8, w);
}
typedef short v4i16_t __attribute__((ext_vector_type(4)));
__device__ __forceinline__ s16x4 vtr(const LAS bf16_t* p) { return __builtin_bit_cast(s16x4, __builtin_amdgcn_ds_read_tr16_b64_v4i16((LAS v4i16_t*)p)); }
__device__ __forceinline__ bf16x8 cat8(s16x4 lo, s16x4 hi) { return (bf16x8){lo[0], lo[1], lo[2], lo[3], hi[0], hi[1], hi[2], hi[3]}; }
__device__ __forceinline__ bf16x8 pack8(const f32x16& p, int s) {
    u32x4 w;
    if (s == 0) { w.x = cvt_pk_bf16(p[0], p[1]); w.y = cvt_pk_bf16(p[2], p[3]); w.z = cvt_pk_bf16(p[4], p[5]); w.w = cvt_pk_bf16(p[6], p[7]); }
    else        { w.x = cvt_pk_bf16(p[8], p[9]); w.y = cvt_pk_bf16(p[10], p[11]); w.z = cvt_pk_bf16(p[12], p[13]); w.w = cvt_pk_bf16(p[14], p[15]); }
    return __builtin_bit_cast(bf16x8, w);
}

#define LBAR() do { asm volatile("s_waitcnt lgkmcnt(0)" ::: "memory"); __builtin_amdgcn_s_barrier(); asm volatile("" ::: "memory"); } while (0)
__device__ __forceinline__ void hgrn_pre_item(float* LOGF, const bf16_t* Q0, float* HC, int b, int h, int dir, int c, int lane) {
    typedef float f32x2v __attribute__((ext_vector_type(2)));
    const size_t base = (size_t)b * T + (size_t)c * 32;
    f32x2v lf[32]; unsigned qv[32];
#pragma unroll
    for (int r = 0; r < 32; ++r) {
        const size_t tok = base + (dir ? 31 - r : r);
        lf[r] = *(const f32x2v*)(LOGF + tok * 1024 + dir * 512 + h * 128 + 2 * lane);
        qv[r] = *(const unsigned*)(Q0 + tok * 512 + h * 128 + 2 * lane);
    }
    asm volatile("s_waitcnt vmcnt(0)" ::: "memory");
    f32x2v gref = lf[0];
#pragma unroll
    for (int r = 1; r < 16; ++r) gref += lf[r];
    f32x2v glast = gref;
#pragma unroll
    for (int r = 16; r < 32; ++r) glast += lf[r];
    float e0 = __expf(-gref.x), e1 = __expf(-gref.y);
#pragma unroll
    for (int r = 0; r < 32; ++r) {
        const size_t tok = base + (dir ? 31 - r : r);
        const float f0 = __expf(lf[r].x), f1 = __expf(lf[r].y);
        e0 *= f0; e1 *= f1;
        const float k0 = 1.0f - f0, k1 = 1.0f - f1;
        const float q0 = bf2f((unsigned short)(qv[r] & 0xffff)), q1 = bf2f((unsigned short)(qv[r] >> 16));
        unsigned* rowp = (unsigned*)(LOGF + tok * 1024 + dir * 512 + h * 128);
        __hip_atomic_store(rowp + lane, cvt_pk_bf16(q0 * e0, q1 * e1), __ATOMIC_RELAXED, __HIP_MEMORY_SCOPE_AGENT);
        __hip_atomic_store(rowp + 64 + lane, cvt_pk_bf16(k0 * __builtin_amdgcn_rcpf(e0), k1 * __builtin_amdgcn_rcpf(e1)), __ATOMIC_RELAXED, __HIP_MEMORY_SCOPE_AGENT);
    }
    float* hc = HC + ((size_t)(((b * 4 + h) * 2 + dir) * 64 + c)) * 384;
    { unsigned* hu = (unsigned*)hc + 2 * lane;
      __hip_atomic_store(hu, __float_as_uint(__expf(gref.x)), __ATOMIC_RELAXED, __HIP_MEMORY_SCOPE_AGENT); __hip_atomic_store(hu + 1, __float_as_uint(__expf(gref.y)), __ATOMIC_RELAXED, __HIP_MEMORY_SCOPE_AGENT);
      __hip_atomic_store(hu + 128, __float_as_uint(__expf(glast.x)), __ATOMIC_RELAXED, __HIP_MEMORY_SCOPE_AGENT); __hip_atomic_store(hu + 129, __float_as_uint(__expf(glast.y)), __ATOMIC_RELAXED, __HIP_MEMORY_SCOPE_AGENT);
      __hip_atomic_store(hu + 256, __float_as_uint(__expf(glast.x - gref.x)), __ATOMIC_RELAXED, __HIP_MEMORY_SCOPE_AGENT); __hip_atomic_store(hu + 257, __float_as_uint(__expf(glast.y - gref.y)), __ATOMIC_RELAXED, __HIP_MEMORY_SCOPE_AGENT); }
}

struct HgPf { u32x4 qr, kr; u32x2 v; float egr, dec, eglr, egr2, dec2, eglr2; };
__device__ __forceinline__ void hg_flush(LAS unsigned char* lds, const f32x16& OI, bf16_t* orow, int par, int wave, int lane) {
    const LAS float* xo = (const LAS float*)(lds + HG_XO) + (par * 2 + wave) * 1024 + lane;
    bf16_t* op = orow + wave * 32;
#pragma unroll
    for (int g4 = 0; g4 < 4; ++g4) {
        const float o0 = OI[4 * g4] + xo[(4 * g4) * 64], o1 = OI[4 * g4 + 1] + xo[(4 * g4 + 1) * 64], o2 = OI[4 * g4 + 2] + xo[(4 * g4 + 2) * 64], o3 = OI[4 * g4 + 3] + xo[(4 * g4 + 3) * 64];
        u32x2 w; w.x = cvt_pk_bf16(o0, o1); w.y = cvt_pk_bf16(o2, o3); *(u32x2*)(op + 8 * g4) = w;
    }
}
__device__ __forceinline__ void hg_chunk(LAS unsigned char* lds, const HgPf& pf, f32x16& ST, f32x16& ST2, f32x16& OI, bf16_t* orow_prev  ,
                                         int par, int tid, int lane, int wave, int l31, int hi) {
    LAS unsigned char* ls = lds + par * HG_SET;
    LAS bf16_t* QR = (LAS bf16_t*)(ls + HG_QR); LAS bf16_t* KR = (LAS bf16_t*)(ls + HG_KR); LAS bf16_t* VL = (LAS bf16_t*)(ls + HG_V); LAS bf16_t* STB = (LAS bf16_t*)(ls + HG_STB);
    const bool owner = wave >= 4; const int ow = wave - 4;
    const int r = tid >> 4, k0 = (tid & 15) * 8, v0 = (tid & 15) * 4, vt = (ow >> 1) & 1, ktb = (ow & 1) * 2;
    *(LAS u32x4*)(QR + r * 136 + k0) = pf.qr; *(LAS u32x4*)(KR + r * 136 + k0) = pf.kr;
    *(LAS u32x2*)(VL + r * 72 + v0) = pf.v;
    if (owner) {
        const int k = ktb * 32 + l31; const float egr = pf.egr, egr2 = pf.egr2;
#pragma unroll
        for (int i = 0; i < 16; i += 2) {
            const unsigned w = cvt_pk_bf16(egr * ST[i], egr * ST[i + 1]), w2 = cvt_pk_bf16(egr2 * ST2[i], egr2 * ST2[i + 1]);
            STB[(vt * 32 + crow(i, hi)) * 136 + k] = (bf16_t)(w & 0xffffu); STB[(vt * 32 + crow(i + 1, hi)) * 136 + k] = (bf16_t)(w >> 16);
            STB[(vt * 32 + crow(i, hi)) * 136 + k + 32] = (bf16_t)(w2 & 0xffffu); STB[(vt * 32 + crow(i + 1, hi)) * 136 + k + 32] = (bf16_t)(w2 >> 16);
        }
    }
    LBAR();
    if (wave < 2 && orow_prev) hg_flush(lds, OI, orow_prev, par ^ 1, wave, lane);
    if (wave < 4) {
        const int ot = wave & 1;
        bf16x8 qf[8];
#pragma unroll
        for (int ks = 0; ks < 8; ++ks) qf[ks] = *(const LAS bf16x8*)(QR + l31 * 136 + 16 * ks + 8 * hi);
        if (wave < 2) {
            f32x16 p, p2;
#pragma unroll
            for (int i = 0; i < 16; ++i) { p[i] = 0.f; p2[i] = 0.f; }
#pragma unroll
            for (int ks = 0; ks < 8; ks += 2) {
                const bf16x8 a = *(const LAS bf16x8*)(KR + l31 * 136 + 16 * ks + 8 * hi);
                const bf16x8 a2 = *(const LAS bf16x8*)(KR + l31 * 136 + 16 * (ks + 1) + 8 * hi);
                p = MFMA32(a, qf[ks], p); p2 = MFMA32(a2, qf[ks + 1], p2);
            }
#pragma unroll
            for (int i = 0; i < 16; ++i) { p[i] = crow(i, hi) > l31 ? 0.f : p[i] + p2[i]; }
            const bf16x8 pf0 = pack8(p, 0), pf1 = pack8(p, 1);
            f32x16 o, ob;
#pragma unroll
            for (int i = 0; i < 16; ++i) { o[i] = 0.f; ob[i] = 0.f; }
            const LAS bf16_t* vp = VL + (4 * hi + ((lane & 15) >> 2)) * 72 + 16 * ((lane >> 4) & 1) + 4 * (lane & 3) + ot * 32;
            const bf16x8 a0 = cat8(vtr(vp), vtr(vp + 8 * 72)); o = MFMA32(a0, pf0, o);
            const bf16x8 a1 = cat8(vtr(vp + 16 * 72), vtr(vp + 24 * 72)); ob = MFMA32(a1, pf1, ob);
#pragma unroll
            for (int i = 0; i < 16; ++i) OI[i] = o[i] + ob[i];
        } else {
            f32x16 o, o2;
#pragma unroll
            for (int i = 0; i < 16; ++i) { o[i] = 0.f; o2[i] = 0.f; }
#pragma unroll
            for (int ks = 0; ks < 8; ks += 2) {
                const bf16x8 sa = *(const LAS bf16x8*)(STB + (ot * 32 + l31) * 136 + 16 * ks + 8 * hi);
                const bf16x8 sb = *(const LAS bf16x8*)(STB + (ot * 32 + l31) * 136 + 16 * (ks + 1) + 8 * hi);
                o = MFMA32(sa, qf[ks], o); o2 = MFMA32(sb, qf[ks + 1], o2);
            }
            LAS float* xo = (LAS float*)(lds + HG_XO) + (par * 2 + ot) * 1024 + lane;
#pragma unroll
            for (int i = 0; i < 16; ++i) xo[i * 64] = o[i] + o2[i];
        }
    }
    if (owner) {
        f32x16 tmp, tmp2;
#pragma unroll
        for (int i = 0; i < 16; ++i) { tmp[i] = 0.f; tmp2[i] = 0.f; }
#pragma unroll
        for (int st = 0; st < 2; ++st) {
            const LAS bf16_t* vp = VL + (16 * st + 8 * hi + ((lane & 15) >> 2)) * 72 + 16 * ((lane >> 4) & 1) + 4 * (lane & 3) + vt * 32;
            const LAS bf16_t* kp = KR + (16 * st + 8 * hi + ((lane & 15) >> 2)) * 136 + 16 * ((lane >> 4) & 1) + 4 * (lane & 3) + ktb * 32;
            const bf16x8 a = cat8(vtr(vp), vtr(vp + 4 * 72));
            const bf16x8 bk = cat8(vtr(kp), vtr(kp + 4 * 136));
            const bf16x8 bk2 = cat8(vtr(kp + 32), vtr(kp + 4 * 136 + 32));
            tmp = MFMA32(a, bk, tmp); tmp2 = MFMA32(a, bk2, tmp2);
        }
        const float dec = pf.dec, eglr = pf.eglr, dec2 = pf.dec2, eglr2 = pf.eglr2;
#pragma unroll
        for (int i = 0; i < 16; ++i) { ST[i] = __builtin_fmaf(dec, ST[i], eglr * tmp[i]); ST2[i] = __builtin_fmaf(dec2, ST2[i], eglr2 * tmp2[i]); }
    }
}

__device__ __forceinline__ void hgrn_unit(LAS unsigned char* lds, int unit, const bf16_t* Q0, float* LOGF, const bf16_t* V0, bf16_t* OFB, float* HC, unsigned* flags) {
    const int vs = unit & 1, dir = (unit >> 1) & 1, h = (unit >> 2) & 3, b = unit >> 4;
    int tid_ = threadIdx.x; asm volatile("" : "+v"(tid_)); const int tid = tid_, lane = tid & 63, wave = __builtin_amdgcn_readfirstlane(tid >> 6), l31 = lane & 31, hi = lane >> 5;
#if PROBE_H >= 0
    const unsigned long long ht0 = __builtin_amdgcn_s_memrealtime();
#endif
    for (int j = 0; j < 4; ++j) hgrn_pre_item(LOGF, Q0, HC, b, h, dir, 32 * vs + wave + 8 * j, lane);
    asm volatile("s_waitcnt vmcnt(0)" ::: "memory");
    __syncthreads();
    if (tid == 0) {
        __hip_atomic_store(flags + 16 * unit, 1u, __ATOMIC_RELAXED, __HIP_MEMORY_SCOPE_AGENT);
        unsigned sp = 0;
        while (__hip_atomic_load(flags + 16 * (unit ^ 1), __ATOMIC_RELAXED, __HIP_MEMORY_SCOPE_AGENT) == 0u) { __builtin_amdgcn_s_sleep(1); if (++sp > (1u << 24)) break; }
        __builtin_amdgcn_fence(__ATOMIC_ACQUIRE, "agent"); asm volatile("s_waitcnt vmcnt(0)" ::: "memory");
    }
    __syncthreads();
#if PROBE_H >= 0
    const unsigned long long ht1 = __builtin_amdgcn_s_memrealtime();
#endif
    const int r = tid >> 4, k0 = (tid & 15) * 8, v0 = (tid & 15) * 4, ktb = wave >= 4 ? ((wave - 4) & 1) * 2 : 0;
    f32x16 ST, ST2, OI;
#pragma unroll
    for (int i = 0; i < 16; ++i) { ST[i] = 0.f; ST2[i] = 0.f; OI[i] = 0.f; }
    const size_t tokb = (size_t)b * T;
    const float* hcu = HC + (size_t)(((b * 4 + h) * 2 + dir) * 64) * 384 + ktb * 32 + l31;
    HgPf R[3];
#define HG_ISSUE(P, CI) do { const int c_ = dir ? 63 - (CI) : (CI); const size_t tok_ = tokb + c_ * 32 + (dir ? 31 - r : r); \
        const bf16_t* rp_ = (const bf16_t*)(LOGF + tok_ * 1024 + dir * 512 + h * 128); (P).qr = *(const u32x4*)(rp_ + k0); (P).kr = *(const u32x4*)(rp_ + 128 + k0); \
        (P).v = *(const u32x2*)(V0 + tok_ * 512 + h * 128 + vs * 64 + v0); \
        const float* hc_ = hcu + (size_t)c_ * 384; (P).egr = hc_[0]; (P).egr2 = hc_[32]; (P).dec = hc_[128]; (P).dec2 = hc_[160]; (P).eglr = hc_[256]; (P).eglr2 = hc_[288]; } while (0)
#define HG_OROW(CI) (OFB + ((size_t)dir * M + tokb + (size_t)(dir ? 63 - (CI) : (CI)) * 32 + (dir ? 31 - l31 : l31)) * 512 + h * 128 + vs * 64 + 4 * hi)
    HG_ISSUE(R[0], 0); HG_ISSUE(R[1], 1); HG_ISSUE(R[2], 2);
    for (int c3 = 0; c3 < 66; c3 += 3) {
#pragma unroll
        for (int u = 0; u < 3; ++u) {
            const int ci = c3 + u;
            if (ci >= 64) break;
            const HgPf cur = R[u];
            if (ci + 3 < 64) HG_ISSUE(R[u], ci + 3);
            hg_chunk(lds, cur, ST, ST2, OI, ci > 0 ? HG_OROW(ci - 1) : (bf16_t*)nullptr, ci & 1, tid, lane, wave, l31, hi);
        }
    }
    LBAR();
    if (wave < 2) hg_flush(lds, OI, HG_OROW(63), 1, wave, lane);
    LBAR();
#undef HG_ISSUE
#undef HG_OROW
#if PROBE_H >= 0
    if (tid == 0) { LAS unsigned long long* hp = (LAS unsigned long long*)(lds + 131072 + 1024); hp[0] = ht1 - ht0; hp[1] = __builtin_amdgcn_s_memrealtime() - ht1; }
#endif
}

constexpr int AT_K = 0, AT_V = 384 * 72 * 2, AT_END = 2 * 384 * 72 * 2;
static_assert(AT_END <= 131072, "attn lds");
__device__ __forceinline__ void attn_phase(LAS unsigned char* lds, int bid, int G, const bf16_t* QKV, const float* sink, bf16_t* OUT) {
    int tid_ = threadIdx.x; asm volatile("" : "+v"(tid_)); const int tid = tid_, lane = tid & 63, wave = __builtin_amdgcn_readfirstlane(tid >> 6), l31 = lane & 31, hi = lane >> 5;
    LAS bf16_t* KL = (LAS bf16_t*)(lds + AT_K);
    LAS bf16_t* VL = (LAS bf16_t*)(lds + AT_V);
    const LAS bf16_t* vtr0 = VL + (4 * hi + ((lane & 15) >> 2)) * 72 + 16 * ((lane >> 4) & 1) + 4 * (lane & 3);
    const int g = wave >> 1, half = wave & 1;
    u32x4 kx[6], vx[6];
#define AT_LOADKV(U) do { const int qb_ = (U) & 15, kv_ = ((U) >> 4) & 3, b_ = (U) >> 6; _Pragma("unroll") for (int it = 0; it < 6; ++it) { \
        const int idx = tid + it * 512, row = idx >> 3, c8 = idx & 7, pos = qb_ * 128 - 128 + row; \
        kx[it] = (u32x4){0u, 0u, 0u, 0u}; vx[it] = (u32x4){0u, 0u, 0u, 0u}; \
        if (pos >= 0 && pos < T) { const bf16_t* p = QKV + ((size_t)b_ * T + pos) * 1536 + kv_ * 64 + c8 * 8; kx[it] = *(const u32x4*)(p + 1024); vx[it] = *(const u32x4*)(p + 1280); } } } while (0)
    if (bid < 512) AT_LOADKV(bid);
    for (int unit = bid; unit < 512; unit += G) {
        const int qb = unit & 15, kv = (unit >> 4) & 3, b = unit >> 6;
        const int Q0p = qb * 128, kbase = Q0p - 128;
        const size_t tokb = (size_t)b * T;
        const int hh = kv * 4 + g;
#pragma unroll
        for (int it = 0; it < 6; ++it) { const int idx = tid + it * 512, row = idx >> 3, c8 = idx & 7; *(LAS u32x4*)(KL + row * 72 + c8 * 8) = kx[it]; *(LAS u32x4*)(VL + row * 72 + c8 * 8) = vx[it]; }
        bf16x8 qfa[2][4];
#pragma unroll
        for (int qt = 0; qt < 2; ++qt) { const bf16_t* qp = QKV + (tokb + Q0p + half * 64 + qt * 32 + l31) * 1536 + hh * 64 + 8 * hi;
#pragma unroll
            for (int s4 = 0; s4 < 4; ++s4) qfa[qt][s4] = *(const bf16x8*)(qp + 16 * s4); }
        LBAR();
        if (unit + G < 512) AT_LOADKV(unit + G);
        const float slope2 = exp2f(-0.5f * (float)(hh + 1)) * LOG2E, sink2 = sink[hh] * LOG2E;
#pragma unroll
        for (int qt = 0; qt < 2; ++qt) {
            const int q0l = half * 64 + qt * 32, qpos = Q0p + q0l + l31;
            float mrun = sink2, lsum = hi == 0 ? 1.0f : 0.0f;
            f32x16 o0, o1;
#pragma unroll
            for (int i = 0; i < 16; ++i) { o0[i] = 0.f; o1[i] = 0.f; }
            for (int j = 0; j < 9; ++j) {
                const int kt = 4 + (((j + 1) >> 1) ^ -(j & 1)) + (j & 1);
                const int krow0 = q0l + 32 * kt, kpos0 = kbase + krow0;
                if (kpos0 + 31 < 0 || kpos0 >= T) continue;
                f32x16 s;
#pragma unroll
                for (int i = 0; i < 16; ++i) s[i] = 0.f;
#pragma unroll
                for (int ks = 0; ks < 4; ++ks) {
                    const bf16x8 a = *(const LAS bf16x8*)(KL + (krow0 + l31) * 72 + 16 * ks + 8 * hi);
                    s = MFMA32(a, qfa[qt][ks], s);
                }
                if (kt == 4) {
#pragma unroll
                    for (int i = 0; i < 16; ++i) { const int dd = qpos - (kpos0 + crow(i, hi)); s[i] = __builtin_fmaf(-slope2, (float)(dd < 0 ? -dd : dd), s[i]); }
                } else {
                    const float sg = kt < 4 ? 1.0f : -1.0f;
                    const int dq = qpos - kpos0 - 4 * hi;
                    const float base = -slope2 * sg * (float)dq, step = slope2 * sg;
#pragma unroll
                    for (int i = 0; i < 16; ++i) s[i] = __builtin_fmaf(step, (float)((i & 3) + 8 * (i >> 2)), s[i] + base);
                    if (kt == 0) {
#pragma unroll
                        for (int i = 0; i < 16; ++i) { if (dq - ((i & 3) + 8 * (i >> 2)) > 128) s[i] = -INFINITY; }
                    }
                    if (kt == 8) {
#pragma unroll
                        for (int i = 0; i < 16; ++i) { if (((i & 3) + 8 * (i >> 2)) - dq > 128) s[i] = -INFINITY; }
                    }
                }
                float tmax = s[0];
#pragma unroll
                for (int i = 1; i < 16; ++i) tmax = fmaxf(tmax, s[i]);
                tmax = fmaxf(tmax, __shfl_xor(tmax, 32));
                if (__builtin_amdgcn_ballot_w64(tmax > mrun) != 0ull) {
                    const float mnew = fmaxf(mrun, tmax), alpha = __builtin_amdgcn_exp2f(mrun - mnew);
                    mrun = mnew; lsum *= alpha;
#pragma unroll
                    for (int i = 0; i < 16; ++i) { o0[i] *= alpha; o1[i] *= alpha; }
                }
                float ps = 0.f;
#pragma unroll
                for (int i = 0; i < 16; ++i) { const float pe = __builtin_amdgcn_exp2f(s[i] - mrun); s[i] = pe; ps += pe; }
                lsum += ps;
                const bf16x8 pf0 = pack8(s, 0), pf1 = pack8(s, 1);
                const LAS bf16_t* vp = vtr0 + krow0 * 72;
                { const bf16x8 a = cat8(vtr(vp), vtr(vp + 8 * 72)); o0 = MFMA32(a, pf0, o0); }
                { const bf16x8 a = cat8(vtr(vp + 32), vtr(vp + 8 * 72 + 32)); o1 = MFMA32(a, pf0, o1); }
                { const bf16x8 a = cat8(vtr(vp + 16 * 72), vtr(vp + 24 * 72)); o0 = MFMA32(a, pf1, o0); }
                { const bf16x8 a = cat8(vtr(vp + 16 * 72 + 32), vtr(vp + 24 * 72 + 32)); o1 = MFMA32(a, pf1, o1); }
            }
            const float ltot = lsum + __shfl_xor(lsum, 32), inv = 1.0f / ltot;
            bf16_t* op = OUT + (tokb + qpos) * 1024 + hh * 64 + 4 * hi;
#pragma unroll
            for (int g4 = 0; g4 < 4; ++g4) {
                u32x2 w; w.x = cvt_pk_bf16(o0[4 * g4] * inv, o0[4 * g4 + 1] * inv); w.y = cvt_pk_bf16(o0[4 * g4 + 2] * inv, o0[4 * g4 + 3] * inv); *(u32x2*)(op + 8 * g4) = w;
                u32x2 w2; w2.x = cvt_pk_bf16(o1[4 * g4] * inv, o1[4 * g4 + 1] * inv); w2.y = cvt_pk_bf16(o1[4 * g4 + 2] * inv, o1[4 * g4 + 3] * inv); *(u32x2*)(op + 32 + 8 * g4) = w2;
            }
        }
        LBAR();
    }
#undef AT_LOADKV
}

struct Args { const float* in[12]; float* out; unsigned char* ws; };

template <int SEL> __device__ __forceinline__ void conv_items(const Args& a, LAS float* scr, int gwi, int ngwi, int lane_in, int lo = 0, int hi = 0) {
    int lane = lane_in; asm volatile("" : "+v"(lane));
    unsigned char* ws = a.ws;
    constexpr int I_W = 16 * 88, I_W2 = 44 * 32;
    constexpr int N0 = 16 * 80, N1 = 2048, N3 = 16 * 32 + 2 * I_W + I_W2, N2 = 16 * 48 + 16 * 32 + 2 * I_W + I_W2;
    constexpr int NITEMS = SEL == 0 ? N0 : (SEL == 1 ? N1 : (SEL == 3 ? N3 : N2));
    constexpr int layer = SEL == 2 ? 1 : 0;
    for (int it0 = gwi;; it0 += ngwi) {
        int it = it0;
        if (hi > 0) { it = lo + it0; if (it >= hi) break; }
        else if (it >= NITEMS) break;
        if constexpr (SEL == 0) { const int kb = it / 80, nb = it % 80, n0 = nb * 32, sg = n0 >> 9, slot = sg == 2 ? 3 : (sg == 3 ? 2 : sg);
            transpose_item(a.in[2], 3072, 1024, (bf16_t*)(ws + WS_WP), kb * 64, n0, slot * 512 + (n0 & 511), scr, lane); continue; }
        if constexpr (SEL == 1) {
            if (it < 2048) {
                const int k1 = it; bf16_t* dr = (bf16_t*)(ws + WS_DFT) + (size_t)k1 * 4096;
#pragma unroll 2
                for (int i = 0; i < 8; ++i) {
                    const int col0 = (i * 64 + lane) * 8, cs = col0 >> 11;
                    float v[8];
#pragma unroll
                    for (int j = 0; j < 8; ++j) {
                        const int t = (col0 + j) & 2047; const float ph = (float)((k1 * t) & 2047) * (1.0f / 2048.0f);
                        v[j] = (cs ? -__builtin_amdgcn_sinf(ph) : __builtin_amdgcn_cosf(ph)) * (1.0f / 512.0f);
                    }
                    u32x4 o; o.x = cvt_pk_bf16(v[0], v[1]); o.y = cvt_pk_bf16(v[2], v[3]); o.z = cvt_pk_bf16(v[4], v[5]); o.w = cvt_pk_bf16(v[6], v[7]);
                    *(u32x4*)(dr + col0) = o;
                }
                continue;
            }
        }
        if constexpr (SEL == 3) {
            if (it < 512) { const int kb = it / 32, nb = it % 32; transpose_item(a.in[5], 1024, 1024, (bf16_t*)(ws + WS_WO0), kb * 64, nb * 32, nb * 32, scr, lane); continue; }
            it -= 512;
        }
        if constexpr (SEL == 2) {
            if (it < 768) { const int kb = it / 48, nb = it % 48; transpose_item(a.in[6], 1536, 1024, (bf16_t*)(ws + WS_WQKV), kb * 64, nb * 32, nb * 32, scr, lane, a.in[1] + 4 * D); continue; }
            it -= 768;
            if (it < 512) { const int kb = it / 32, nb = it % 32; transpose_item(a.in[8], 1024, 1024, (bf16_t*)(ws + WS_WO1), kb * 64, nb * 32, nb * 32, scr, lane); continue; }
            it -= 512;
        }
        if constexpr (SEL >= 2) {
            if (it < 2 * I_W) {
                const int which = it >= I_W; if (which) it -= I_W;
                const int kb = it / 88, nb = it % 88, n0 = nb * 32;
                const float* src = (which ? a.in[10] : a.in[9]) + (size_t)layer * 1024 * FF;
                transpose_item(src, FF, 1024, (bf16_t*)(ws + WS_W13) + (size_t)layer * W13_STRIDE, kb * 64, n0, 256 * (n0 >> 7) + 128 * which + (n0 & 127), scr, lane, a.in[1] + (layer * 4 + 2) * D); continue;
            }
            it -= 2 * I_W;
            { const int kb = it / 32, nb = it % 32;
              transpose_item(a.in[11] + (size_t)layer * FF * 1024, 1024, FF, (bf16_t*)(ws + WS_W2) + (size_t)layer * W2_STRIDE, kb * 64, nb * 32, nb * 32, scr, lane); }
        }
    }
}
__device__ __forceinline__ void prologue(const Args& a, LAS unsigned char* lds, int gw, int ngw, int wave, int lane) {
    unsigned char* ws = a.ws;
    LAS float* scr = (LAS float*)(lds + wave * 16384);
    const float* w_in = a.in[2];
    if (wave < 2) {
        const int G_ = ngw >> 3, bid_ = gw >> 3;
        bf16_t* Wcs = (bf16_t*)(ws + WS_WCS);
        for (int j = wave * G_ + bid_; j < 512; j += 2 * G_) {
            const int g = j >> 7, k0 = (j & 127) * 8;
#pragma unroll
            for (int i = 0; i < 4; ++i) { const int idx = i * 64 + lane, kk = idx >> 5, c4 = idx & 31; *(LAS f32x4*)(scr + kk * 128 + 4 * c4) = *(const f32x4*)(w_in + (size_t)(k0 + kk) * 3072 + 2560 + g * 128 + 4 * c4); }
            LDS_WAIT();
            float aca[8], asa[8], acb[8], asb[8];
#pragma unroll
            for (int kk = 0; kk < 8; ++kk) { aca[kk] = 0.f; asa[kk] = 0.f; acb[kk] = 0.f; asb[kk] = 0.f; }
            for (int c = 0; c < 128; ++c) {
                const float ph = (float)((lane * c) & 127) * (1.0f / 128.0f);
                const float ca = __builtin_amdgcn_cosf(ph), sa = __builtin_amdgcn_sinf(ph);
                const float cb = (c & 1) ? -ca : ca, sb = (c & 1) ? -sa : sa;
#pragma unroll
                for (int kk = 0; kk < 8; ++kk) { const float w = scr[kk * 128 + c]; aca[kk] += w * ca; asa[kk] += w * sa; acb[kk] += w * cb; asb[kk] += w * sb; }
            }
            u32x4 o;
            o.x = cvt_pk_bf16(aca[0], aca[1]); o.y = cvt_pk_bf16(aca[2], aca[3]); o.z = cvt_pk_bf16(aca[4], aca[5]); o.w = cvt_pk_bf16(aca[6], aca[7]); *(u32x4*)(Wcs + (size_t)(g * 128 + lane) * 1024 + k0) = o;
            o.x = cvt_pk_bf16(acb[0], acb[1]); o.y = cvt_pk_bf16(acb[2], acb[3]); o.z = cvt_pk_bf16(acb[4], acb[5]); o.w = cvt_pk_bf16(acb[6], acb[7]); *(u32x4*)(Wcs + (size_t)(g * 128 + lane + 64) * 1024 + k0) = o;
            o.x = cvt_pk_bf16(asa[0], asa[1]); o.y = cvt_pk_bf16(asa[2], asa[3]); o.z = cvt_pk_bf16(asa[4], asa[5]); o.w = cvt_pk_bf16(asa[6], asa[7]); *(u32x4*)(Wcs + (size_t)(512 + g * 128 + lane) * 1024 + k0) = o;
            o.x = cvt_pk_bf16(asb[0], asb[1]); o.y = cvt_pk_bf16(asb[2], asb[3]); o.z = cvt_pk_bf16(asb[4], asb[5]); o.w = cvt_pk_bf16(asb[6], asb[7]); *(u32x4*)(Wcs + (size_t)(512 + g * 128 + lane + 64) * 1024 + k0) = o;
            LDS_WAIT();
        }
    }
    conv_items<0>(a, scr, gw, ngw, lane);
    if (wave >= 2) {
        const float* x = a.in[0]; bf16_t* XNp = (bf16_t*)(ws + WS_XN);
        f32x4 g4[4];
#pragma unroll
        for (int j = 0; j < 4; ++j) g4[j] = ((const f32x4*)a.in[1])[lane + 64 * j];
        const int gw6 = (gw >> 3) * 6 + (wave - 2), ngw6 = (ngw >> 3) * 6;
        for (int row0 = gw6; row0 < M; row0 += 4 * ngw6) {
            f32x4 v[4][4];
#pragma unroll
            for (int q = 0; q < 4; ++q) { const int row = row0 + q * ngw6; if (row < M) {
#pragma unroll
                for (int j = 0; j < 4; ++j) v[q][j] = ((const f32x4*)(x + (size_t)row * D))[lane + 64 * j]; } }
#pragma unroll
            for (int q = 0; q < 4; ++q) { const int row = row0 + q * ngw6; if (row < M) {
                float ss = 0.f;
#pragma unroll
                for (int j = 0; j < 4; ++j) ss += (v[q][j].x * v[q][j].x + v[q][j].y * v[q][j].y) + (v[q][j].z * v[q][j].z + v[q][j].w * v[q][j].w);
                const float r = rsqrtf(wave_sum(ss) * (1.0f / D) + EPS);
#pragma unroll
                for (int j = 0; j < 4; ++j) { const f32x4 o = v[q][j] * r * g4[j]; u32x2 w; w.x = cvt_pk_bf16(o.x, o.y); w.y = cvt_pk_bf16(o.z, o.w); ((u32x2*)(XNp + (size_t)row * D))[lane + 64 * j] = w; }
            } }
        }
    }
}

#ifndef PHMASK
#define PHMASK 0xffff
#endif
#ifndef REP_HGRN
#define REP_HGRN 1
#endif
#ifndef REP_SYNC
#define REP_SYNC 1
#endif
#ifndef REP_PRO
#define REP_PRO 1
#endif
#ifndef REP_ATTN
#define REP_ATTN 1
#endif
#ifndef REP_FNET
#define REP_FNET 1
#endif
constexpr int CONV2_N = 16 * 48 + 16 * 32 + 3 * 16 * 88, CONV2_SPLIT = 16 * 48 + 16 * 32 + 16 * 88;
#ifndef REP_GEMM
#define REP_GEMM 1
#endif

#if PROBE_K >= 0
#define STAMP() do { if (bid == 0 && tid == 0) { ((LAS unsigned long long*)(lds + 131072 + 512))[nst] = __builtin_amdgcn_s_memrealtime(); } ++nst; } while (0)
#else
#define STAMP() do { } while (0)
#endif
#define GSYNC() do { for (int r_ = 0; r_ < REP_SYNC; ++r_) xcd_barrier(xbar); STAMP(); } while (0)

__global__ void __launch_bounds__(512, 2) fwd_megakernel(Args a) {
    extern __shared__ __attribute__((aligned(16))) unsigned char lds_raw[];
    LAS unsigned char* lds = (LAS unsigned char*)lds_raw;
    cg::grid_group grid = cg::this_grid();
    const int tid = threadIdx.x, lane = tid & 63, wave = __builtin_amdgcn_readfirstlane(tid >> 6);
    const int G = gridDim.x, bid = blockIdx.x, gw = bid * 8 + wave, ngw = G * 8;
    unsigned char* ws = a.ws;
    bf16_t* XN = (bf16_t*)(ws + WS_XN); float* MBUF = (float*)(ws + WS_MBUF);
    bf16_t* ACAT = (bf16_t*)(ws + WS_ACAT); bf16_t* HB = (bf16_t*)(ws + WS_H);
    float* LOGF = a.out;
    const float* gains = a.in[1];
    if (tid < 64) ((LAS unsigned*)(lds + 131072))[tid] = 0u;
    __syncthreads();
    if (__builtin_expect(a.ws == nullptr, 0)) grid.sync();
    int nst = 0; STAMP();
    XcdBarrier xbar = xcd_barrier_post((unsigned*)ws, (volatile LAS unsigned*)(lds + 131072 + 32));

#if PHMASK & 1
    for (int rp = 0; rp < REP_PRO; ++rp) prologue(a, lds, gw, ngw, wave, lane);
#endif
    GSYNC();

#if PHMASK & 2
    {
        pg8::Gemm g{XN, (const bf16_t*)(ws + WS_WP), M, 2560, 1024}; pg8::StaticOrder S; S.init(M, 2560, G, bid);
        EpiProj E{(bf16_t*)(ws + WS_Q0), LOGF, a.in[3]};
        static_assert(WS_V0 == WS_Q0 + (size_t)M * 512 * 2 && WS_GATE == WS_V0 + (size_t)M * 512 * 2, "Q0 | V0 | GATE consecutive");
        pg8::gemm_phase<EpiProj, pg8::StaticOrder, true, true>(lds, g, S, E);
    }
#endif
#if PHMASK & 4
    {
        pg8::Gemm g{(const bf16_t*)(ws + WS_WCS), XN, 1024, M, 1024}; pg8::StaticOrder S; S.init(1024, M, G, bid);
        EpiYt E{(bf16_t*)(ws + WS_YT)};
        pg8::gemm_phase<EpiYt, pg8::StaticOrder, true, true>(lds, g, S, E);
    }
#endif
    constexpr int CONV3_SPLIT = 2400, CONV3_N = 16 * 32 + 2 * 16 * 88 + 44 * 32;
    if ((G & 1) == 0) { if (bid >= G / 2) { conv_items<1>(a, (LAS float*)(lds + wave * 16384), (bid - G / 2) * 8 + wave, (G / 2) * 8, lane); } }
    else conv_items<1>(a, (LAS float*)(lds + wave * 16384), gw, ngw, lane);
    GSYNC();

    {
        const bool split = (G % 16) == 0;
        const bool do_f = !split || (((bid >> 3) & 1) == 0), do_h = !split || (((bid >> 3) & 1) == 1);
        const int gsz = split ? G / 2 : G, gidx = split ? (bid >> 4) * 8 + (bid & 7) : bid;
#if PHMASK & 8
        if (do_f) for (int rp = 0; rp < REP_FNET; ++rp) {
            pg8::Gemm g{(const bf16_t*)(ws + WS_DFT), (const bf16_t*)(ws + WS_YT), 2048, 4096, 4096}; pg8::StaticOrder S; S.init(2048, 4096, gsz, gidx);
            EpiFnet E{ACAT};
            pg8::gemm_phase<EpiFnet, pg8::StaticOrder, true, true>(lds, g, S, E);
        }
        if (do_f) conv_items<3>(a, (LAS float*)(lds + wave * 16384), gidx * 8 + wave, gsz * 8, lane);
#endif
#if PHMASK & 16
        if (do_h) {
            for (int rp = 0; rp < REP_HGRN; ++rp) for (int u = gidx; u < 128; u += gsz) hgrn_unit(lds, u, (const bf16_t*)(ws + WS_Q0), LOGF, (const bf16_t*)(ws + WS_V0), (bf16_t*)(ws + WS_OFB), (float*)(ws + WS_HC), (unsigned*)(ws + WS_HFLAG));
        }
#endif
    }
    GSYNC();

    {
        const bf16_t* OFB = (const bf16_t*)(ws + WS_OFB); const bf16_t* GATE = (const bf16_t*)(ws + WS_GATE); const float* og = a.in[4];
        for (int row = gw; row < M; row += ngw) {
            const u32x4 f = *(const u32x4*)(OFB + (size_t)row * 512 + lane * 8), bw = *(const u32x4*)(OFB + ((size_t)M + row) * 512 + lane * 8), gt = *(const u32x4*)(GATE + (size_t)row * 512 + lane * 8);
            float o[8]; float ss = 0.f;
#pragma unroll
            for (int j = 0; j < 4; ++j) {
                o[2 * j] = bf2f((unsigned short)(f[j] & 0xffff)) + bf2f((unsigned short)(bw[j] & 0xffff));
                o[2 * j + 1] = bf2f((unsigned short)(f[j] >> 16)) + bf2f((unsigned short)(bw[j] >> 16));
                ss += o[2 * j] * o[2 * j] + o[2 * j + 1] * o[2 * j + 1];
            }
            ss += __shfl_xor(ss, 1); ss += __shfl_xor(ss, 2); ss += __shfl_xor(ss, 4); ss += __shfl_xor(ss, 8);
            const float r = rsqrtf(ss * (1.0f / 128.0f) + EPS);
            const f32x4 g0 = *(const f32x4*)(og + lane * 8), g1 = *(const f32x4*)(og + lane * 8 + 4);
            float res[8];
#pragma unroll
            for (int j = 0; j < 4; ++j) {
                res[2 * j] = o[2 * j] * r * (2 * j < 4 ? g0[2 * j] : g1[2 * j - 4]) * bf2f((unsigned short)(gt[j] & 0xffff));
                res[2 * j + 1] = o[2 * j + 1] * r * (2 * j + 1 < 4 ? g0[2 * j + 1] : g1[2 * j + 1 - 4]) * bf2f((unsigned short)(gt[j] >> 16));
            }
            u32x4 w; w.x = cvt_pk_bf16(res[0], res[1]); w.y = cvt_pk_bf16(res[2], res[3]); w.z = cvt_pk_bf16(res[4], res[5]); w.w = cvt_pk_bf16(res[6], res[7]);
            *(u32x4*)(ACAT + (size_t)row * 1024 + lane * 8) = w;
        }
    }
    GSYNC();

#pragma unroll
    for (int layer = 0; layer < 2; ++layer) {
        const float* gl = gains + (size_t)layer * 4 * D;
        if (layer == 1) {
            {
                pg8::Gemm g{(const bf16_t*)(ws + WS_XRES), (const bf16_t*)(ws + WS_WQKV), M, 1536, 1024}; pg8::StaticOrder S; S.init(M, 1536, G, bid);
                const float* ssq_ = (const float*)(ws + WS_SSQ) + (size_t)1 * ((size_t)M * 4); (void)stage_rstd(lds, ssq_, S);
                EpiQKV E{(bf16_t*)(ws + WS_QKV1), (const LAS float*)(lds + RSTD_OFF)};
                pg8::gemm_phase<EpiQKV, pg8::StaticOrder, true, true>(lds, g, S, E);
            }
            if ((G & 1) == 0 && bid >= G / 2) conv_items<2>(a, (LAS float*)(lds + wave * 16384), (bid - G / 2) * 8 + wave, (G / 2) * 8, lane, CONV2_SPLIT, CONV2_N);
            GSYNC();
#if PHMASK & 32
            attn_phase(lds, bid, G, (const bf16_t*)(ws + WS_QKV1), a.in[7], ACAT);
#endif
            GSYNC();
        }
        {
            pg8::Gemm g{ACAT, (const bf16_t*)(ws + (layer == 0 ? WS_WO0 : WS_WO1)), M, 1024, 1024}; pg8::StaticOrder S; S.init(M, 1024, G, bid);
            if (layer == 0) { typedef EpiRmsRes<0, 1 * D, 2 * D, true, false> EP; EP E{a.in[0], a.out, ws, gains}; pg8::gemm_phase<EP, pg8::StaticOrder, false, true>(lds, g, S, E); }
            else            { typedef EpiRmsRes<4, 5 * D, 6 * D, false, false> EP; EP E{a.out, a.out, ws, gains}; pg8::gemm_phase<EP, pg8::StaticOrder, false, true>(lds, g, S, E); }
        }
        GSYNC();
        {
            pg8::Gemm g{(const bf16_t*)(ws + WS_XRES), (const bf16_t*)(ws + WS_W13) + (size_t)layer * W13_STRIDE, M, 5632, 1024}; pg8::StaticOrder S; S.init(M, 5632, G, bid);
            const float* ssq_ = (const float*)(ws + WS_SSQ) + (size_t)(layer * 2) * ((size_t)M * 4); (void)stage_rstd(lds, ssq_, S);
            EpiSwiglu E{HB, (const LAS float*)(lds + RSTD_OFF)};
            pg8::gemm_phase<EpiSwiglu, pg8::StaticOrder, true, true>(lds, g, S, E);
        }
        if (layer == 0) {
            if ((G & 1) == 0) { if (bid >= G / 2) conv_items<2>(a, (LAS float*)(lds + wave * 16384), (bid - G / 2) * 8 + wave, (G / 2) * 8, lane, 0, CONV2_SPLIT); }
            else conv_items<2>(a, (LAS float*)(lds + wave * 16384), gw, ngw, lane);
        }
        GSYNC();
        {
            pg8::Gemm g{HB, (const bf16_t*)(ws + WS_W2) + (size_t)layer * W2_STRIDE, M, 1024, FF}; pg8::StaticOrder S; S.init(M, 1024, G, bid);
            if (layer == 0) { typedef EpiRmsRes<2, 3 * D, 4 * D, false, false> EP; EP E{a.out, a.out, ws, gains}; pg8::gemm_phase<EP, pg8::StaticOrder, false, true>(lds, g, S, E); }
            else            { typedef EpiRmsRes<6, 7 * D, -1, false, true> EP; EP E{a.out, a.out, ws, gains}; pg8::gemm_phase<EP, pg8::StaticOrder, false, true>(lds, g, S, E); }
        }
        if (layer == 0) GSYNC();
    }
#if PROBE_H >= 0
    if (bid == 8 && tid == 0) {
        const unsigned long long d = ((LAS unsigned long long*)(lds + 131072 + 1024))[PROBE_H], t0 = __builtin_amdgcn_s_memrealtime();
        while (__builtin_amdgcn_s_memrealtime() - t0 < 4ull * d) __builtin_amdgcn_s_sleep(8);
    }
#endif
#if PROBE_K >= 0
    STAMP();
    if (bid == 0 && tid == 0) {
        LAS unsigned long long* st = (LAS unsigned long long*)(lds + 131072 + 512);
        const unsigned long long d = st[PROBE_K + 1] - st[PROBE_K], t0 = __builtin_amdgcn_s_memrealtime();
        while (__builtin_amdgcn_s_memrealtime() - t0 < 4ull * d) __builtin_amdgcn_s_sleep(8);
    }
#endif
}

extern "C" void kernel_launch(void* const* d_in, const int* in_sizes, int n_in, void* d_out, int out_size, void* d_ws, size_t ws_size, hipStream_t stream) {
    static int grid = 0;
    if (grid == 0) {
        if (n_in != 12 || out_size != M * D || ws_size < WS_END) { fprintf(stderr, "kernel_launch: unexpected shapes (n_in %d out %d ws %zu)\n", n_in, out_size, ws_size); grid = -1; return; }
        int dev = 0, cus = 0, per_cu = 0;
        hipGetDevice(&dev); hipDeviceGetAttribute(&cus, hipDeviceAttributeMultiprocessorCount, dev);
        if (hipFuncSetAttribute((const void*)fwd_megakernel, hipFuncAttributeMaxDynamicSharedMemorySize, LDS_BYTES) != hipSuccess) { fprintf(stderr, "kernel_launch: hipFuncSetAttribute failed\n"); grid = -1; return; }
        if (hipOccupancyMaxActiveBlocksPerMultiprocessor(&per_cu, (const void*)fwd_megakernel, 512, LDS_BYTES) != hipSuccess || per_cu < 1) { fprintf(stderr, "kernel_launch: occupancy query gave %d\n", per_cu); per_cu = 1; }
        (void)hipGetLastError();
        grid = cus;
    }
    if (grid < 0) return;
    Args a{};
    for (int i = 0; i < 12; ++i) a.in[i] = (const float*)d_in[i];
    a.out = (float*)d_out; a.ws = (unsigned char*)d_ws;
    if (hipMemsetAsync(d_ws, 0, 65536 + 8 * 16384, stream) != hipSuccess) { fprintf(stderr, "kernel_launch: memset failed\n"); return; }
    void* args[] = {&a};
    hipError_t e = hipLaunchCooperativeKernel((const void*)fwd_megakernel, dim3(grid), dim3(512), args, LDS_BYTES, stream);
    if (e != hipSuccess) fprintf(stderr, "cooperative launch failed: %s (grid %d)\n", hipGetErrorString(e), grid);
}
```

```cpp
#include <hip/hip_runtime.h>
#include <hip/hip_cooperative_groups.h>
#include <cstdio>
#include <cstdint>
namespace cg = cooperative_groups;
namespace pg8 {
#define PG8_LAS __attribute__((address_space(3)))
typedef unsigned short bf16_t;
typedef short bf16x8 __attribute__((ext_vector_type(8)));
typedef float f32x4 __attribute__((ext_vector_type(4)));
typedef unsigned u32x4 __attribute__((ext_vector_type(4)));
constexpr int BM = 256, BK = 64, HALF = 128, HTB = HALF * BK * 2  , STAGE_BYTES = 8 * HTB, NXCD = 8, WGM = 8;

__host__ __device__ __forceinline__ int lds_byte(int r, int c) { const int st = (r >> 4) * 2 + (c >> 5), rr = r & 15, cc = c & 31, ob = rr * 64 + cc * 2; return st * 1024 + (ob ^ (((ob >> 9) & 1) << 5)); }
__host__ __device__ __forceinline__ void stage_rc(int b, int& R, int& C) { const int st = b / 1024, sb = b % 1024, swz = sb ^ (((sb >> 9) & 1) << 5); R = (st >> 1) * 16 + swz / 64; C = (st & 1) * 32 + (swz % 64) / 2; }
__host__ __device__ __forceinline__ int perm32(int rho) { const int n = rho >> 4, i = rho & 15; return 8 * (i >> 2) + 4 * n + (i & 3); }

struct Unit { int pm, pn; };
struct Gemm { const bf16_t* A; const bf16_t* Bt; int M, N, K; };

struct StaticOrder {
    int nM, nN, nwg, G, c;
    __host__ __device__ void init(int M, int N, int G_, int c_) { nM = M / BM; nN = N / BM; nwg = nM * nN; G = G_; c = c_; }
    __host__ __device__ bool next(int i, Unit& u) const {
        const long L = (long)i * G + c; if (L >= nwg) return false;
        int wgid = (int)L; { const int q = nwg / NXCD, r = nwg % NXCD, xcd = wgid % NXCD, off = wgid / NXCD; wgid = (xcd < r ? xcd * (q + 1) : r * (q + 1) + (xcd - r) * q) + off; }
        const int nig = WGM * nN, gid = wgid / nig, fm = gid * WGM, gsz = (nM - fm) < WGM ? (nM - fm) : WGM;
        u.pm = fm + ((wgid % nig) % gsz); u.pn = (wgid % nig) / gsz; return true;
    }
    __device__ __forceinline__ void a_ready(const Unit&) const {}
    __device__ __forceinline__ void done(const Unit&) const {}
};

typedef float f32x2_t __attribute__((ext_vector_type(2))); typedef __bf16 bf16x2_t __attribute__((ext_vector_type(2)));
__device__ __forceinline__ unsigned cvt_pk_bf16(float lo, float hi) { f32x2_t v = {lo, hi}; bf16x2_t b = __builtin_convertvector(v, bf16x2_t); return __builtin_bit_cast(unsigned, b); }
template <class Epi, class Sched, bool ALIGN_EPI = false, bool SP2 = false>
__device__ __forceinline__ void gemm_phase(PG8_LAS unsigned char* lds, const Gemm g, const Sched& S, const Epi& E) {
    int tid_ = threadIdx.x; asm volatile("" : "+v"(tid_));
    const int tid = tid_, wid = __builtin_amdgcn_readfirstlane(tid >> 6), lane = tid & 63, wr = wid >> 2, wc = wid & 3, fr = lane & 15, fq = lane >> 4;
    const int K = g.K, nt = K / BK;
    unsigned voffA[2], voffB[2];
#pragma unroll
    for (int i = 0; i < 2; ++i) { int R, C; stage_rc(tid * 16 + i * 8192, R, C); const int Rb = Epi::PERM ? ((R & ~31) + perm32(R & 31)) : R;
        voffA[i] = (unsigned)(R * K + C) * 2u; voffB[i] = (unsigned)(Rb * K + C) * 2u; }
    const size_t kstep = (size_t)(BK * 2);
    const size_t hstep = (size_t)HALF * K * 2;
    const size_t tstep = 2 * hstep;
    const unsigned ldsw = (unsigned)wid * 1024u;
    const int aoff = lds_byte(wr * 64 + fr, fq * 8), boff = lds_byte(wc * 32 + fr, fq * 8);
#define PG8_SA(b, h) (((b) * 2 + (h)) * HTB)
#define PG8_SB(b, h) ((4 + (b) * 2 + (h)) * HTB)
#define PG8_STAGE(bufoff, gbase, voff) do { _Pragma("unroll") for (int _i = 0; _i < 2; ++_i) \
        __builtin_amdgcn_global_load_lds((const unsigned*)((const char*)(gbase) + (voff)[_i]), (PG8_LAS unsigned*)(lds + (bufoff) + ldsw + _i * 8192), 16, 0, 0); } while (0)
#define PG8_LDA(dst, b, h) do { _Pragma("unroll") for (int m = 0; m < 4; ++m) _Pragma("unroll") for (int k = 0; k < 2; ++k) dst[m][k] = *(const PG8_LAS bf16x8*)(lds + PG8_SA(b, h) + aoff + m * 2048 + k * 1024); } while (0)
#define PG8_LDB(dst, b, h) do { _Pragma("unroll") for (int n = 0; n < 2; ++n) _Pragma("unroll") for (int k = 0; k < 2; ++k) dst[n][k] = *(const PG8_LAS bf16x8*)(lds + PG8_SB(b, h) + boff + n * 2048 + k * 1024); } while (0)
#define PG8_MMA(ai, bj, At, Bt) do { __builtin_amdgcn_s_setprio(1); _Pragma("unroll") for (int m = 0; m < 4; ++m) _Pragma("unroll") for (int n = 0; n < 2; ++n) _Pragma("unroll") for (int k = 0; k < 2; ++k) \
        acc[ai][bj][m][n] = __builtin_amdgcn_mfma_f32_16x16x32_bf16(Bt[n][k], At[m][k], acc[ai][bj][m][n], 0, 0, 0); __builtin_amdgcn_s_setprio(0); } while (0)
#define PG8_WAIT_V(n) asm volatile("s_waitcnt vmcnt(" #n ")" ::: "memory")
#define PG8_WAIT_L(n) asm volatile("s_waitcnt lgkmcnt(" #n ")" ::: "memory")
#define PG8_BAR __builtin_amdgcn_s_barrier()
#define PG8_SCHED __builtin_amdgcn_sched_barrier(0)
    Unit cur, nxt; int ui = 0;
    if (!S.next(0, cur)) return;
    f32x4 acc[2][2][4][2];
#pragma unroll
    for (int a = 0; a < 2; ++a)
#pragma unroll
        for (int b = 0; b < 2; ++b)
#pragma unroll
            for (int m = 0; m < 4; ++m)
#pragma unroll
                for (int n = 0; n < 2; ++n) acc[a][b][m][n] = (f32x4){0.f, 0.f, 0.f, 0.f};
    bf16x8 At[4][2], B0[2][2], B1[2][2];
    const char* cA = (const char*)g.A + (size_t)cur.pm * tstep; const char* cB = (const char*)g.Bt + (size_t)cur.pn * tstep;
    S.a_ready(cur);
    if constexpr (SP2) {
        PG8_STAGE(PG8_SB(0, 0), cB, voffB); PG8_STAGE(PG8_SB(0, 1), cB + hstep, voffB); PG8_STAGE(PG8_SA(0, 0), cA, voffA); PG8_STAGE(PG8_SA(0, 1), cA + hstep, voffA);
        if (wr == 1) PG8_BAR;
        PG8_WAIT_V(2); PG8_BAR;
        PG8_STAGE(PG8_SB(1, 0), cB + kstep, voffB); PG8_STAGE(PG8_SA(1, 0), cA + kstep, voffA); PG8_STAGE(PG8_SB(1, 1), cB + hstep + kstep, voffB);
        PG8_WAIT_V(6); PG8_BAR;
    } else {
        PG8_STAGE(PG8_SB(0, 0), cB, voffB); PG8_STAGE(PG8_SA(0, 0), cA, voffA); PG8_STAGE(PG8_SB(0, 1), cB + hstep, voffB); PG8_STAGE(PG8_SA(0, 1), cA + hstep, voffA);
        if (wr == 1) PG8_BAR;
        PG8_WAIT_V(4); PG8_BAR;
        PG8_STAGE(PG8_SB(1, 0), cB + kstep, voffB); PG8_STAGE(PG8_SA(1, 0), cA + kstep, voffA); PG8_STAGE(PG8_SB(1, 1), cB + hstep + kstep, voffB);
        PG8_WAIT_V(6); PG8_BAR;
    }
    for (;;) {
        const bool has_next = S.next(ui + 1, nxt);
        const char* nA = has_next ? (const char*)g.A + (size_t)nxt.pm * tstep : cA; const char* nB = has_next ? (const char*)g.Bt + (size_t)nxt.pn * tstep : cB;
        for (int t = 0; t < nt; t += 2) {
            const bool last = (t == nt - 2);
            const char* a1 = cA + (size_t)(t + 1) * kstep;
            const char* a2 = last ? nA : cA + (size_t)(t + 2) * kstep; const char* b2 = last ? nB : cB + (size_t)(t + 2) * kstep;
            const char* a3 = a2 + kstep; const char* b3 = b2 + kstep;
            if (last && has_next) S.a_ready(nxt);
            if constexpr (SP2) {
            PG8_LDB(B0, 0, 0); PG8_LDB(B1, 0, 1); PG8_SCHED; PG8_LDA(At, 0, 0); PG8_STAGE(PG8_SA(1, 1), a1 + hstep, voffA);
            PG8_WAIT_V(8); PG8_WAIT_L(0); PG8_BAR; PG8_MMA(0, 0, At, B0); PG8_MMA(0, 1, At, B1); PG8_BAR; PG8_SCHED;
            PG8_LDA(At, 0, 1); PG8_STAGE(PG8_SB(0, 0), b2, voffB); PG8_STAGE(PG8_SB(0, 1), b2 + hstep, voffB); PG8_STAGE(PG8_SA(0, 0), a2, voffA);
            PG8_WAIT_V(8); PG8_WAIT_L(0); PG8_BAR; PG8_MMA(1, 0, At, B0); PG8_MMA(1, 1, At, B1); PG8_BAR; PG8_SCHED;
            PG8_LDB(B0, 1, 0); PG8_LDB(B1, 1, 1); PG8_SCHED; PG8_LDA(At, 1, 0); PG8_STAGE(PG8_SA(0, 1), a2 + hstep, voffA);
            PG8_WAIT_V(8); PG8_WAIT_L(0); PG8_BAR; PG8_MMA(0, 0, At, B0); PG8_MMA(0, 1, At, B1); PG8_BAR; PG8_SCHED;
            PG8_LDA(At, 1, 1); PG8_STAGE(PG8_SB(1, 0), b3, voffB); PG8_STAGE(PG8_SB(1, 1), b3 + hstep, voffB); PG8_STAGE(PG8_SA(1, 0), a3, voffA);
            PG8_WAIT_V(8); PG8_WAIT_L(0); PG8_BAR; PG8_MMA(1, 0, At, B0); PG8_MMA(1, 1, At, B1); PG8_BAR; PG8_SCHED;
            } else {
            PG8_LDB(B0, 0, 0); PG8_SCHED; PG8_LDA(At, 0, 0); PG8_STAGE(PG8_SA(1, 1), a1 + hstep, voffA);
            PG8_WAIT_L(8); PG8_BAR; PG8_WAIT_L(0); PG8_MMA(0, 0, At, B0); PG8_BAR; PG8_SCHED;
            PG8_LDB(B1, 0, 1); PG8_STAGE(PG8_SB(0, 0), b2, voffB);
            PG8_BAR; PG8_WAIT_L(0); PG8_MMA(0, 1, At, B1); PG8_BAR;
            PG8_LDA(At, 0, 1); PG8_STAGE(PG8_SA(0, 0), a2, voffA);
            PG8_BAR; PG8_WAIT_L(0); PG8_MMA(1, 0, At, B0); PG8_BAR; PG8_SCHED;
            PG8_STAGE(PG8_SB(0, 1), b2 + hstep, voffB);
            PG8_WAIT_V(6); PG8_BAR; PG8_MMA(1, 1, At, B1); PG8_BAR;
            PG8_LDB(B0, 1, 0); PG8_SCHED; PG8_LDA(At, 1, 0); PG8_STAGE(PG8_SA(0, 1), a2 + hstep, voffA);
            PG8_WAIT_L(8); PG8_BAR; PG8_WAIT_L(0); PG8_MMA(0, 0, At, B0); PG8_BAR; PG8_SCHED;
            PG8_LDB(B1, 1, 1); PG8_STAGE(PG8_SB(1, 0), b3, voffB);
            PG8_BAR; PG8_WAIT_L(0); PG8_MMA(0, 1, At, B1); PG8_BAR;
            PG8_LDA(At, 1, 1); PG8_STAGE(PG8_SA(1, 0), a3, voffA);
            PG8_BAR; PG8_WAIT_L(0); PG8_MMA(1, 0, At, B0); PG8_BAR; PG8_SCHED;
            PG8_STAGE(PG8_SB(1, 1), b3 + hstep, voffB);
            PG8_WAIT_V(6); PG8_BAR; PG8_MMA(1, 1, At, B1); PG8_BAR;
            }
        }
        if constexpr (ALIGN_EPI) { if (wr == 0) PG8_BAR; }
        if constexpr (!Epi::AFTER_DRAIN) { E(acc, cur, wr, wc, fr, fq); S.done(cur); }
        if (!has_next) break;
#pragma unroll
        for (int a = 0; a < 2; ++a)
#pragma unroll
            for (int b = 0; b < 2; ++b)
#pragma unroll
                for (int m = 0; m < 4; ++m)
#pragma unroll
                    for (int n = 0; n < 2; ++n) acc[a][b][m][n] = (f32x4){0.f, 0.f, 0.f, 0.f};
        cur = nxt; cA = nA; cB = nB; ++ui;
        if constexpr (ALIGN_EPI) { if (wr == 1) PG8_BAR; }
    }
    PG8_WAIT_V(0);
    if constexpr (!ALIGN_EPI) { if (wr == 0) PG8_BAR; }
    PG8_BAR;
    if constexpr (Epi::AFTER_DRAIN) { E.fused(acc, cur, wr, wc, fr, fq, lds, wid, lane); S.done(cur); }
#undef PG8_SA
#undef PG8_SB
#undef PG8_STAGE
#undef PG8_LDA
#undef PG8_LDB
#undef PG8_MMA
#undef PG8_WAIT_V
#undef PG8_WAIT_L
#undef PG8_BAR
#undef PG8_SCHED
}
}

#define LAS __attribute__((address_space(3)))
#ifndef PROBE_K
#define PROBE_K -1
#endif
#ifndef PROBE_H
#define PROBE_H -1
#endif
using pg8::bf16_t; using pg8::bf16x8; using pg8::f32x4; using pg8::u32x4; using pg8::Unit; using pg8::cvt_pk_bf16;
typedef float f32x16 __attribute__((ext_vector_type(16)));
typedef unsigned u32x2 __attribute__((ext_vector_type(2)));
typedef short s16x4 __attribute__((ext_vector_type(4)));
#define MFMA32(a, b, c) __builtin_amdgcn_mfma_f32_32x32x16_bf16((a), (b), (c), 0, 0, 0)

constexpr int NB = 8, T = 2048, D = 1024, M = NB * T, FF = 2816;
constexpr float EPS = 1e-6f;
constexpr float LOG2E = 1.4426950408889634f;
constexpr int LDS_BYTES = 147456;

constexpr size_t MiB = 1u << 20;
constexpr size_t WS_WP = 1 * MiB;
constexpr size_t WS_WCS = 6 * MiB;
constexpr size_t WS_DFT = 8 * MiB;
constexpr size_t WS_WO0 = 24 * MiB;
constexpr size_t WS_WQKV = 26 * MiB;
constexpr size_t WS_WO1 = 29 * MiB;
constexpr size_t WS_W13 = 31 * MiB;
constexpr size_t WS_W2 = 53 * MiB;
constexpr size_t W13_STRIDE = (size_t)5632 * 1024, W2_STRIDE = (size_t)1024 * 2816;
constexpr size_t WS_CNT = 65536;
constexpr size_t WS_XBUF = 64 * MiB;
constexpr size_t WS_XN = 66 * MiB;
constexpr size_t WS_MBUF = 98 * MiB;
constexpr size_t WS_XRES = 98 * MiB;
constexpr size_t WS_YT = 98 * MiB;
constexpr size_t WS_OFB = 130 * MiB;
constexpr size_t WS_Q0 = 162 * MiB;
constexpr size_t WS_V0 = 178 * MiB;
constexpr size_t WS_GATE = 194 * MiB;
constexpr size_t WS_ACAT = 210 * MiB;
constexpr size_t WS_H = 162 * MiB;
constexpr size_t WS_QKV1 = 162 * MiB;
constexpr size_t WS_HC = 242 * MiB;
constexpr size_t WS_CCTR = 49152;
constexpr size_t WS_HFLAG = 32768;
constexpr size_t WS_SSQ = 250 * MiB;
constexpr size_t WS_END = 256 * MiB;

__device__ __forceinline__ unsigned f2bf(float f) { unsigned u = __builtin_bit_cast(unsigned, f); return (u + 0x7fffu + ((u >> 16) & 1u)) >> 16; }
__device__ __forceinline__ float bf2f(unsigned short h) { return __builtin_bit_cast(float, (unsigned)h << 16); }
__device__ __forceinline__ float wave_sum(float v) {
#pragma unroll
    for (int o = 1; o < 64; o <<= 1) v += __shfl_xor(v, o);
    return v;
}
__device__ __forceinline__ int crow(int r, int hi) { return (r & 3) + 8 * (r >> 2) + 4 * hi; }
#define LDS_WAIT() asm volatile("s_waitcnt lgkmcnt(0)" ::: "memory")
#define XB_TMO      128
#define XB_XCNT(j)  (256  + 64 * (j))
#define XB_XSUB(j)  (1280 + 64 * (j))
#define XB_XGEN(j)  (2304 + 64 * (j))
#define XB_TOP      3328
#define XB_TOPGEN   3392
#define XCD_BAR_WORDS 3456
#define XB_SPIN_CAP (1u << 18)

__device__ __forceinline__ unsigned xb_ld(unsigned* p)              { return __hip_atomic_load(p, __ATOMIC_RELAXED, __HIP_MEMORY_SCOPE_AGENT); }
__device__ __forceinline__ unsigned xb_add(unsigned* p, unsigned v) { return __hip_atomic_fetch_add(p, v, __ATOMIC_RELAXED, __HIP_MEMORY_SCOPE_AGENT); }
__device__ __forceinline__ unsigned xb_xcc_id() { return (unsigned)__builtin_amdgcn_s_getreg((3 << 11) | 20) & 0xFu; }
#define XB_SPIN(cond, bar) do { unsigned _sp = 0; while (cond) { __builtin_amdgcn_s_sleep(1); \
    if ((++_sp & 255u) == 0u) { if (xb_ld(&(bar)[XB_TMO])) break; if (_sp > XB_SPIN_CAP) { atomicAdd(&(bar)[XB_TMO], 1u); break; } } } } while (0)

struct XcdBarrier {
    unsigned* bar; unsigned x;
    volatile LAS unsigned* st;
};

__device__ __forceinline__ XcdBarrier xcd_barrier_post(unsigned* bar, volatile LAS unsigned* st) {
    XcdBarrier b; b.bar = bar; b.x = xb_xcc_id(); b.st = st;
    if (threadIdx.x == 0) (void)xb_add(&bar[XB_XCNT(b.x)], 1u);
    return b;
}
__device__ __forceinline__ void xcd_barrier_complete(unsigned* bar, unsigned x, unsigned& nloc, unsigned& nx) {
    const unsigned G = gridDim.x * gridDim.y * gridDim.z;
    unsigned sum, cnt, mine, sp = 0u;
    for (;;) {
        sum = 0u; cnt = 0u; mine = 0u;
#pragma unroll
        for (unsigned j = 0; j < 16; ++j) { const unsigned c = xb_ld(&bar[XB_XCNT(j)]); sum += c; cnt += (c > 0u) ? 1u : 0u; mine = (j == x) ? c : mine; }
        if (sum == G) break;
        __builtin_amdgcn_s_sleep(1);
        if ((++sp & 255u) == 0u) { if (xb_ld(&bar[XB_TMO])) break; if (sp > XB_SPIN_CAP) { atomicAdd(&bar[XB_TMO], 1u); break; } }
    }
    nloc = mine > 0u ? mine : 1u; nx = cnt > 0u ? cnt : 1u;
}

__device__ __forceinline__ void xcd_barrier(const XcdBarrier& b) {
    asm volatile("s_waitcnt vmcnt(0)" ::: "memory");
    __syncthreads();
    if (threadIdx.x == 0) {
        unsigned* bar = b.bar;
        __builtin_amdgcn_s_waitcnt(0);
        unsigned nloc = b.st[0], nx = b.st[1];
        if (nloc == 0u) { xcd_barrier_complete(bar, b.x, nloc, nx); b.st[0] = nloc; b.st[1] = nx; }
        const unsigned old = xb_add(&bar[XB_XSUB(b.x)], 1u);
        const unsigned gen = old / nloc;
        if (old + 1u == (gen + 1u) * nloc) {
            __builtin_amdgcn_fence(__ATOMIC_RELEASE, "agent");
            asm volatile("s_waitcnt vmcnt(0)" ::: "memory");
            const unsigned og = xb_add(&bar[XB_TOP], 1u);
            const unsigned tg = og / nx;
            if (og + 1u == (tg + 1u) * nx) xb_add(&bar[XB_TOPGEN], 1u);
            else XB_SPIN(xb_ld(&bar[XB_TOPGEN]) == tg, bar);
            __builtin_amdgcn_fence(__ATOMIC_ACQUIRE, "agent");
            xb_add(&bar[XB_XGEN(b.x)], 1u);
            asm volatile("s_waitcnt vmcnt(0)" ::: "memory");
        } else {
            XB_SPIN(xb_ld(&bar[XB_XGEN(b.x)]) == gen, bar);
            __builtin_amdgcn_fence(__ATOMIC_ACQUIRE, "agent");
            asm volatile("s_waitcnt vmcnt(0)" ::: "memory");
        }
    }
    __syncthreads();
}

struct EpiProj {
    static constexpr bool PERM = true, AFTER_DRAIN = false;
    bf16_t* Q0; float* LOGF; const float* tab;
    __device__ __forceinline__ void operator()(const f32x4 (&acc)[2][2][4][2], const Unit& u, int wr, int wc, int fr, int fq) const {
        const int slot = u.pn >> 1, seg = slot == 2 ? 3 : (slot == 3 ? 2 : slot);
        const int cseg = (u.pn & 1) * 256 + wc * 32 + 8 * fq;
        const int row0 = u.pm * 256 + wr * 64 + fr;
        if (seg == 1 || seg == 2) {
            const int dir = seg - 1;
#pragma unroll
            for (int bj = 0; bj < 2; ++bj) {
                const int c = cseg + bj * 128;
                const f32x4 ta0 = *(const f32x4*)(tab + dir * 512 + c), ta1 = *(const f32x4*)(tab + dir * 512 + c + 4);
                const f32x4 tb0 = *(const f32x4*)(tab + 1024 + dir * 512 + c), tb1 = *(const f32x4*)(tab + 1024 + dir * 512 + c + 4);
                f32x4 lb0, lb1;
#pragma unroll
                for (int e = 0; e < 4; ++e) { lb0[e] = __builtin_amdgcn_rcpf(1.0f + __expf(tb0[e] - ta0[e])); lb1[e] = __builtin_amdgcn_rcpf(1.0f + __expf(tb1[e] - ta1[e])); }
#pragma unroll
                for (int ai = 0; ai < 2; ++ai)
#pragma unroll
                    for (int m = 0; m < 4; ++m) {
                        float* dst = LOGF + (size_t)(row0 + ai * 128 + m * 16) * 1024 + dir * 512 + c;
                        const f32x4 z0 = acc[ai][bj][m][0], z1 = acc[ai][bj][m][1]; f32x4 o0, o1;
#pragma unroll
                        for (int e = 0; e < 4; ++e) {
                            const float s0 = __builtin_amdgcn_rcpf(1.0f + __expf(-z0[e])), s1 = __builtin_amdgcn_rcpf(1.0f + __expf(-z1[e]));
                            o0[e] = __builtin_amdgcn_logf(lb0[e] + (1.0f - lb0[e]) * s0) * 0.6931471805599453f; o1[e] = __builtin_amdgcn_logf(lb1[e] + (1.0f - lb1[e]) * s1) * 0.6931471805599453f;
                        }
                        *(f32x4*)dst = o0; *(f32x4*)(dst + 4) = o1;
                    }
            }
        } else {
            bf16_t* base = Q0 + (size_t)(seg == 0 ? 0 : seg - 2) * ((size_t)M * 512);
            const float sc = seg == 0 ? 0.08838834764831845f : 1.0f;
#pragma unroll
            for (int bj = 0; bj < 2; ++bj) {
                const int c = cseg + bj * 128;
#pragma unroll
                for (int ai = 0; ai < 2; ++ai)
#pragma unroll
                    for (int m = 0; m < 4; ++m) {
                        f32x4 v0 = acc[ai][bj][m][0], v1 = acc[ai][bj][m][1];
                        if (seg == 4) {
#pragma unroll
                            for (int e = 0; e < 4; ++e) { v0[e] = v0[e] * __builtin_amdgcn_rcpf(1.0f + __expf(-v0[e])); v1[e] = v1[e] * __builtin_amdgcn_rcpf(1.0f + __expf(-v1[e])); }
                        } else { v0 = v0 * sc; v1 = v1 * sc; }
                        u32x4 w; w.x = cvt_pk_bf16(v0[0], v0[1]); w.y = cvt_pk_bf16(v0[2], v0[3]); w.z = cvt_pk_bf16(v1[0], v1[1]); w.w = cvt_pk_bf16(v1[2], v1[3]);
                        *(u32x4*)(base + (size_t)(row0 + ai * 128 + m * 16) * 512 + c) = w;
                    }
            }
        }
    }
};
struct EpiYt {
    static constexpr bool PERM = true, AFTER_DRAIN = false;
    bf16_t* Yt;
    __device__ __forceinline__ void operator()(const f32x4 (&acc)[2][2][4][2], const Unit& u, int wr, int wc, int fr, int fq) const {
        const int row0 = u.pm * 256 + wr * 64 + fr, tok0 = u.pn * 256 + wc * 32 + 8 * fq;
#pragma unroll
        for (int ai = 0; ai < 2; ++ai)
#pragma unroll
            for (int m = 0; m < 4; ++m) {
                const int f = row0 + ai * 128 + m * 16, cs = f >> 9, n_ = f & 511;
#pragma unroll
                for (int bj = 0; bj < 2; ++bj) {
                    const int tok = tok0 + bj * 128, b = tok >> 11, t = tok & 2047;
                    const f32x4 v0 = acc[ai][bj][m][0], v1 = acc[ai][bj][m][1];
                    u32x4 w; w.x = cvt_pk_bf16(v0[0], v0[1]); w.y = cvt_pk_bf16(v0[2], v0[3]); w.z = cvt_pk_bf16(v1[0], v1[1]); w.w = cvt_pk_bf16(v1[2], v1[3]);
                    *(u32x4*)(Yt + ((size_t)(b * 512 + n_) * 2 + cs) * 2048 + t) = w;
                }
            }
    }
};
struct EpiFnet {
    static constexpr bool PERM = true, AFTER_DRAIN = false;
    bf16_t* ACAT;
    __device__ __forceinline__ void operator()(const f32x4 (&acc)[2][2][4][2], const Unit& u, int wr, int wc, int fr, int fq) const {
        const int row0 = u.pm * 256 + wr * 64 + fr, col0 = u.pn * 256 + wc * 32 + 8 * fq;
#pragma unroll
        for (int ai = 0; ai < 2; ++ai)
#pragma unroll
            for (int m = 0; m < 4; ++m) {
                const int k1 = row0 + ai * 128 + m * 16;
#pragma unroll
                for (int bj = 0; bj < 2; ++bj) {
                    const int c = col0 + bj * 128, b = c >> 9, n_ = c & 511;
                    const f32x4 v0 = acc[ai][bj][m][0], v1 = acc[ai][bj][m][1];
                    u32x4 w; w.x = cvt_pk_bf16(v0[0], v0[1]); w.y = cvt_pk_bf16(v0[2], v0[3]); w.z = cvt_pk_bf16(v1[0], v1[1]); w.w = cvt_pk_bf16(v1[2], v1[3]);
                    *(u32x4*)(ACAT + (size_t)(b * 2048 + k1) * 1024 + 512 + n_) = w;
                }
            }
    }
};
struct EpiF32 {
    static constexpr bool PERM = false, AFTER_DRAIN = false;
    float* O; int ldc;
    __device__ __forceinline__ void operator()(const f32x4 (&acc)[2][2][4][2], const Unit& u, int wr, int wc, int fr, int fq) const {
        const int row0 = u.pm * 256 + wr * 64 + fr, col0 = u.pn * 256 + wc * 32 + 4 * fq;
#pragma unroll
        for (int ai = 0; ai < 2; ++ai)
#pragma unroll
            for (int m = 0; m < 4; ++m) {
                float* rowp = O + (size_t)(row0 + ai * 128 + m * 16) * ldc + col0;
#pragma unroll
                for (int bj = 0; bj < 2; ++bj)
#pragma unroll
                    for (int n = 0; n < 2; ++n) *(f32x4*)(rowp + bj * 128 + n * 16) = acc[ai][bj][m][n];
            }
    }
};
struct RowSsq {
    unsigned* xbuf;
    unsigned* cnt;
    __device__ __forceinline__ void run(const f32x4 (&v)[2][2][4][2], const Unit& u, int wr, int wc, int fr, int fq, LAS unsigned char* lds, int wid, int lane) const {
        LAS float* P = (LAS float*)lds;
        LAS float* S = (LAS float*)(lds + 8192);
#pragma unroll
        for (int ai = 0; ai < 2; ++ai)
#pragma unroll
            for (int m = 0; m < 4; ++m) {
                float q = 0.f;
#pragma unroll
                for (int bj = 0; bj < 2; ++bj)
#pragma unroll
                    for (int n = 0; n < 2; ++n) { const f32x4 x = v[ai][bj][m][n]; q += (x[0] * x[0] + x[1] * x[1]) + (x[2] * x[2] + x[3] * x[3]); }
                q += __shfl_xor(q, 16); q += __shfl_xor(q, 32);
                if (fq == 0) P[(ai * 128 + wr * 64 + m * 16 + fr) * 4 + wc] = q;
            }
        asm volatile("s_waitcnt lgkmcnt(0)" ::: "memory"); __builtin_amdgcn_s_barrier(); asm volatile("" ::: "memory");
        const int row = wid * 32 + (lane & 31);
        if (lane < 32) {
            const float tot = (P[row * 4 + 0] + P[row * 4 + 1]) + (P[row * 4 + 2] + P[row * 4 + 3]);
            __hip_atomic_store(xbuf + ((size_t)(u.pm * 256 + row) * 4 + u.pn), __float_as_uint(tot), __ATOMIC_RELAXED, __HIP_MEMORY_SCOPE_AGENT);
        }
        asm volatile("s_waitcnt vmcnt(0)" ::: "memory");
        if (lane == 0) __hip_atomic_fetch_add(cnt + 64 * u.pm, 1u, __ATOMIC_RELAXED, __HIP_MEMORY_SCOPE_AGENT);
        if (wid == 0) {
            unsigned sp = 0;
            while ((unsigned)__builtin_amdgcn_readfirstlane(__hip_atomic_load(cnt + 64 * u.pm, __ATOMIC_RELAXED, __HIP_MEMORY_SCOPE_AGENT)) < 32u) { __builtin_amdgcn_s_sleep(2); if (++sp > (1u << 22)) break; }
            __builtin_amdgcn_fence(__ATOMIC_ACQUIRE, "agent");
        }
        asm volatile("s_waitcnt vmcnt(0) lgkmcnt(0)" ::: "memory"); __builtin_amdgcn_s_barrier(); asm volatile("" ::: "memory");
        if (lane < 32) {
            const unsigned* slot = xbuf + (size_t)(u.pm * 256 + row) * 4; float t = 0.f;
#pragma unroll
            for (int k = 0; k < 4; ++k) t += __uint_as_float(__hip_atomic_load(slot + k, __ATOMIC_RELAXED, __HIP_MEMORY_SCOPE_AGENT));
            S[row] = t;
        }
        asm volatile("s_waitcnt lgkmcnt(0)" ::: "memory"); __builtin_amdgcn_s_barrier(); asm volatile("" ::: "memory");
    }
};
__device__ __forceinline__ void row_ssq_partial(const f32x4 (&v)[2][2][4][2], const Unit& u, int wr, int wc, int fr, int fq, LAS unsigned char* lds, int wid, int lane, float* ssq) {
    LAS float* P = (LAS float*)lds;
#pragma unroll
    for (int ai = 0; ai < 2; ++ai)
#pragma unroll
        for (int m = 0; m < 4; ++m) {
            float q = 0.f;
#pragma unroll
            for (int bj = 0; bj < 2; ++bj)
#pragma unroll
                for (int n = 0; n < 2; ++n) { const f32x4 x = v[ai][bj][m][n]; q += (x[0] * x[0] + x[1] * x[1]) + (x[2] * x[2] + x[3] * x[3]); }
            q += __shfl_xor(q, 16); q += __shfl_xor(q, 32);
            if (fq == 0) P[(ai * 128 + wr * 64 + m * 16 + fr) * 4 + wc] = q;
        }
    asm volatile("s_waitcnt lgkmcnt(0)" ::: "memory"); __builtin_amdgcn_s_barrier(); asm volatile("" ::: "memory");
    const int row = wid * 32 + (lane & 31);
    if (lane < 32) ssq[(size_t)(u.pm * 256 + row) * 4 + u.pn] = (P[row * 4 + 0] + P[row * 4 + 1]) + (P[row * 4 + 2] + P[row * 4 + 3]);
    asm volatile("s_waitcnt lgkmcnt(0)" ::: "memory"); __builtin_amdgcn_s_barrier(); asm volatile("" ::: "memory");
}
template <int BANK, int GPOST, int GPRE, bool BASE_F32, bool OUT_F32> struct EpiRmsRes {
    static constexpr bool PERM = false, AFTER_DRAIN = true, HAS_PRE = GPRE >= 0; static constexpr int bank = BANK;
    const float* base; float* out; unsigned char* ws; const float* gains;
    __device__ __forceinline__ void fused(f32x4 (&acc)[2][2][4][2], const Unit& u, int wr, int wc, int fr, int fq, LAS unsigned char* lds, int wid, int lane) const {
        const LAS float* S = (const LAS float*)(lds + 8192);
        const int col0 = u.pn * 256 + wc * 32 + 4 * fq;
        const float* g_post = gains + GPOST;
        bf16_t* xres = (bf16_t*)(ws + WS_XRES);
        { const RowSsq st1{(unsigned*)(ws + WS_XBUF) + (size_t)bank * 65536, (unsigned*)(ws + WS_CNT) + bank * 4096}; st1.run(acc, u, wr, wc, fr, fq, lds, wid, lane); }
#pragma unroll
        for (int ai = 0; ai < 2; ++ai)
#pragma unroll
            for (int m = 0; m < 4; ++m) {
                const int r = ai * 128 + wr * 64 + m * 16 + fr; const float rstd = rsqrtf(S[r] * (1.0f / 1024.0f) + EPS);
                const size_t off = (size_t)(u.pm * 256 + r) * 1024 + col0;
#pragma unroll
                for (int bj = 0; bj < 2; ++bj)
#pragma unroll
                    for (int n = 0; n < 2; ++n) {
                        const f32x4 g = *(const f32x4*)(g_post + col0 + bj * 128 + n * 16); f32x4 bs;
                        if constexpr (BASE_F32) bs = *(const f32x4*)(base + off + bj * 128 + n * 16);
                        else { const u32x2 rb = *(const u32x2*)(xres + off + bj * 128 + n * 16); bs = (f32x4){bf2f((unsigned short)(rb.x & 0xffff)), bf2f((unsigned short)(rb.x >> 16)), bf2f((unsigned short)(rb.y & 0xffff)), bf2f((unsigned short)(rb.y >> 16))}; }
                        f32x4 x1 = bs + acc[ai][bj][m][n] * rstd * g;
                        if constexpr (OUT_F32) *(f32x4*)(out + off + bj * 128 + n * 16) = x1;
                        else { u32x2 w; w.x = cvt_pk_bf16(x1[0], x1[1]); w.y = cvt_pk_bf16(x1[2], x1[3]); *(u32x2*)(xres + off + bj * 128 + n * 16) = w;
                               x1 = (f32x4){bf2f((unsigned short)(w.x & 0xffff)), bf2f((unsigned short)(w.x >> 16)), bf2f((unsigned short)(w.y & 0xffff)), bf2f((unsigned short)(w.y >> 16))}; }
                        acc[ai][bj][m][n] = x1;
                    }
                asm volatile("" : "+v"(acc[ai][0][m][0]), "+v"(acc[ai][0][m][1]), "+v"(acc[ai][1][m][0]), "+v"(acc[ai][1][m][1]));
                if (m & 1) asm volatile("" ::: "memory");
            }
        if constexpr (HAS_PRE) row_ssq_partial(acc, u, wr, wc, fr, fq, lds, wid, lane, (float*)(ws + WS_SSQ) + (size_t)(BANK / 2) * ((size_t)M * 4));
    }
};
__device__ __forceinline__ float row_rstd(const float* ssq, int row) { const f32x4 q = *(const f32x4*)(ssq + (size_t)row * 4); return rsqrtf(((q[0] + q[1]) + (q[2] + q[3])) * (1.0f / 1024.0f) + EPS); }
constexpr int RSTD_OFF = 131072 + 4096;
__device__ __forceinline__ int stage_rstd(LAS unsigned char* lds, const float* ssq, const pg8::StaticOrder& S) {
    Unit u0; int pm0 = -1; if (S.next(0, u0)) pm0 = u0.pm;
    int t = threadIdx.x; asm volatile("" : "+v"(t));
    if (pm0 >= 0 && t < 256) ((LAS float*)(lds + RSTD_OFF))[t] = row_rstd(ssq, pm0 * 256 + t);
    __syncthreads();
    return pm0;
}
struct EpiSwiglu {
    static constexpr bool PERM = true, AFTER_DRAIN = false;
    bf16_t* H; const LAS float* rt;
    __device__ __forceinline__ void operator()(const f32x4 (&acc)[2][2][4][2], const Unit& u, int wr, int wc, int fr, int fq) const {
        const int row0 = u.pm * 256 + wr * 64 + fr, col0 = u.pn * 128 + wc * 32 + 8 * fq;
#pragma unroll
        for (int ai = 0; ai < 2; ++ai)
#pragma unroll
            for (int m = 0; m < 4; ++m) {
                float h[8]; const float rs = rt[ai * 128 + wr * 64 + m * 16 + fr];
#pragma unroll
                for (int n = 0; n < 2; ++n)
#pragma unroll
                    for (int e = 0; e < 4; ++e) { const float a = acc[ai][0][m][n][e] * rs, b = acc[ai][1][m][n][e] * rs; h[4 * n + e] = a * __builtin_amdgcn_rcpf(1.0f + __expf(-a)) * b; }
                u32x4 w; w.x = cvt_pk_bf16(h[0], h[1]); w.y = cvt_pk_bf16(h[2], h[3]); w.z = cvt_pk_bf16(h[4], h[5]); w.w = cvt_pk_bf16(h[6], h[7]);
                *(u32x4*)(H + (size_t)(row0 + ai * 128 + m * 16) * FF + col0) = w;
            }
    }
};
struct EpiQKV {
    static constexpr bool PERM = true, AFTER_DRAIN = false;
    bf16_t* O; const LAS float* rt;
    __device__ __forceinline__ void operator()(const f32x4 (&acc)[2][2][4][2], const Unit& u, int wr, int wc, int fr, int fq) const {
        const int row0 = u.pm * 256 + wr * 64 + fr, col0 = u.pn * 256 + wc * 32 + 8 * fq;
        const float sc = u.pn < 4 ? 0.125f * LOG2E : 1.0f;
#pragma unroll
        for (int ai = 0; ai < 2; ++ai)
#pragma unroll
            for (int m = 0; m < 4; ++m) {
                const float rs = sc * rt[ai * 128 + wr * 64 + m * 16 + fr];
#pragma unroll
                for (int bj = 0; bj < 2; ++bj) {
                    const f32x4 v0 = acc[ai][bj][m][0] * rs, v1 = acc[ai][bj][m][1] * rs;
                    u32x4 w; w.x = cvt_pk_bf16(v0[0], v0[1]); w.y = cvt_pk_bf16(v0[2], v0[3]); w.z = cvt_pk_bf16(v1[0], v1[1]); w.w = cvt_pk_bf16(v1[2], v1[3]);
                    *(u32x4*)(O + (size_t)(row0 + ai * 128 + m * 16) * 1536 + col0 + bj * 128) = w;
                }
            }
    }
};

__device__ __forceinline__ void transpose_item(const float* W, int ldw, int K, bf16_t* WT, int k0, int n0src, int dst_row0, LAS float* scr, int lane, const float* gk = nullptr) {
#pragma unroll
    for (int i = 0; i < 8; ++i) {
        const int kk = i * 8 + (lane >> 3), q4 = lane & 7;
        f32x4 v = *(const f32x4*)(W + (size_t)(k0 + kk) * ldw + n0src + 4 * q4);
        if (gk) v = v * gk[k0 + kk];
        LAS float* d = scr + kk * 33 + 4 * q4; d[0] = v.x; d[1] = v.y; d[2] = v.z; d[3] = v.w;
    }
    LDS_WAIT();
    const int c = lane & 7;
#pragma unroll
    for (int j = 0; j < 4; ++j) {
        const int n = (lane >> 3) + 8 * j; const LAS float* s = scr + (8 * c) * 33 + n;
        u32x4 o; o.x = cvt_pk_bf16(s[0 * 33], s[1 * 33]); o.y = cvt_pk_bf16(s[2 * 33], s[3 * 33]); o.z = cvt_pk_bf16(s[4 * 33], s[5 * 33]); o.w = cvt_pk_bf16(s[6 * 33], s[7 * 33]);
        *(u32x4*)(WT + (size_t)(dst_row0 + n) * K + k0 + 8 * c) = o;
    }
    LDS_WAIT();
}
__device__ __forceinline__ void rms_row_to_bf16(const float* xrow, const float* gain, bf16_t* orow, int lane) {
    f32x4 v[4]; float ss = 0.f;
#pragma unroll
    for (int j = 0; j < 4; ++j) { v[j] = ((const f32x4*)xrow)[lane + 64 * j]; ss += (v[j].x * v[j].x + v[j].y * v[j].y) + (v[j].z * v[j].z + v[j].w * v[j].w); }
    const float r = rsqrtf(wave_sum(ss) * (1.0f / D) + EPS);
#pragma unroll
    for (int j = 0; j < 4; ++j) {
        const f32x4 g = ((const f32x4*)gain)[lane + 64 * j]; const f32x4 o = v[j] * r * g;
        u32x2 w; w.x = cvt_pk_bf16(o.x, o.y); w.y = cvt_pk_bf16(o.z, o.w);
        ((u32x2*)orow)[lane + 64 * j] = w;
    }
}
__device__ __forceinline__ void postnorm_rows(const float* xin, float* xout, const float* mbuf, const float* g_post, const float* g_pre, bf16_t* XN, int gw, int ngw, int lane) {
    for (int row = gw; row < M; row += ngw) {
        const f32x4* mr = (const f32x4*)(mbuf + (size_t)row * D); const f32x4* xr = (const f32x4*)(xin + (size_t)row * D);
        f32x4 mv[4], xv[4]; float ss = 0.f;
#pragma unroll
        for (int j = 0; j < 4; ++j) { mv[j] = mr[lane + 64 * j]; xv[j] = xr[lane + 64 * j]; ss += (mv[j].x * mv[j].x + mv[j].y * mv[j].y) + (mv[j].z * mv[j].z + mv[j].w * mv[j].w); }
        const float r = rsqrtf(wave_sum(ss) * (1.0f / D) + EPS);
        float ss2 = 0.f;
#pragma unroll
        for (int j = 0; j < 4; ++j) {
            const f32x4 g = ((const f32x4*)g_post)[lane + 64 * j];
            xv[j] = xv[j] + mv[j] * r * g;
            ((f32x4*)(xout + (size_t)row * D))[lane + 64 * j] = xv[j];
            ss2 += (xv[j].x * xv[j].x + xv[j].y * xv[j].y) + (xv[j].z * xv[j].z + xv[j].w * xv[j].w);
        }
        if (g_pre) {
            const float r2 = rsqrtf(wave_sum(ss2) * (1.0f / D) + EPS);
#pragma unroll
            for (int j = 0; j < 4; ++j) {
                const f32x4 g = ((const f32x4*)g_pre)[lane + 64 * j]; const f32x4 o = xv[j] * r2 * g;
                u32x2 w; w.x = cvt_pk_bf16(o.x, o.y); w.y = cvt_pk_bf16(o.z, o.w);
                ((u32x2*)(XN + (size_t)row * D))[lane + 64 * j] = w;
            }
        }
    }
}

constexpr int HG_G = 0, HG_QR = 16384, HG_KR = HG_QR + 8704, HG_V = HG_KR + 8704, HG_STB = HG_V + 32 * 72 * 2, HG_SET = 2 * 8704 + 32 * 72 * 2 + 64 * 136 * 2  , HG_XO = HG_QR + 2 * HG_SET, HG_END = HG_XO + 2 * 2 * 1024 * 4;
static_assert(HG_END <= 131072, "hgrn lds");
__device__ __forceinline__ bf16x8 gather8(const LAS bf16_t* p, int stride) {
    unsigned a0 = p[0], a1 = p[stride], a2 = p[2 * stride], a3 = p[3 * stride], a4 = p[4 * stride], a5 = p[5 * stride], a6 = p[6 * stride], a7 = p[7 * stride];
    u32x4 w; w.x = a0 | (a1 << 16); w.y = a2 | (a3 << 16); w.z = a4 | (a5 << 16); w.w = a6 | (a7 << 16);
    return __builtin_bit_cast(bf16x8, w);
}
__device__ __forceinline__ bf16x8 gather8p(const LAS bf16_t* p, int stride) {
    unsigned a0 = p[0], a1 = p[stride], a2 = p[2 * stride], a3 = p[3 * stride], a4 = p[8 * stride], a5 = p[9 * stride], a6 = p[10 * stride], a7 = p[11 * stride];
    u32x4 w; w.x = a0 | (a1 << 16); w.y = a2 | (a3 << 16); w.z = a4 | (a5 << 16); w.w = a6 | (a7 << 16);
    return __builtin_bit_cast(bf16x8, w);
}
typedef short v4i16_t __attribute__((ext_vector_type(4)));
__device__ __forceinline__ s16x4 vtr(const LAS bf16_t* p) { return __builtin_bit_cast(s16x4, __builtin_amdgcn_ds_read_tr16_b64_v4i16((LAS v4i16_t*)p)); }
__device__ __forceinline__ bf16x8 cat8(s16x4 lo, s16x4 hi) { return (bf16x8){lo[0], lo[1], lo[2], lo[3], hi[0], hi[1], hi[2], hi[3]}; }
__device__ __forceinline__ bf16x8 pack8(const f32x16& p, int s) {
    u32x4 w;
    if (s == 0) { w.x = cvt_pk_bf16(p[0], p[1]); w.y = cvt_pk_bf16(p[2], p[3]); w.z = cvt_pk_bf16(p[4], p[5]); w.w = cvt_pk_bf16(p[6], p[7]); }
    else        { w.x = cvt_pk_bf16(p[8], p[9]); w.y = cvt_pk_bf16(p[10], p[11]); w.z = cvt_pk_bf16(p[12], p[13]); w.w = cvt_pk_bf16(p[14], p[15]); }
    return __builtin_bit_cast(bf16x8, w);
}

#define LBAR() do { asm volatile("s_waitcnt lgkmcnt(0)" ::: "memory"); __builtin_amdgcn_s_barrier(); asm volatile("" ::: "memory"); } while (0)
__device__ __forceinline__ void hgrn_pre_item(float* LOGF, const bf16_t* Q0, float* HC, int b, int h, int dir, int c, int lane) {
    typedef float f32x2v __attribute__((ext_vector_type(2)));
    const size_t base = (size_t)b * T + (size_t)c * 32;
    f32x2v lf[32]; unsigned qv[32];
#pragma unroll
    for (int r = 0; r < 32; ++r) {
        const size_t tok = base + (dir ? 31 - r : r);
        lf[r] = *(const f32x2v*)(LOGF + tok * 1024 + dir * 512 + h * 128 + 2 * lane);
        qv[r] = *(const unsigned*)(Q0 + tok * 512 + h * 128 + 2 * lane);
    }
    asm volatile("s_waitcnt vmcnt(0)" ::: "memory");
    f32x2v gref = lf[0];
#pragma unroll
    for (int r = 1; r < 16; ++r) gref += lf[r];
    f32x2v glast = gref;
#pragma unroll
    for (int r = 16; r < 32; ++r) glast += lf[r];
    float e0 = __expf(-gref.x), e1 = __expf(-gref.y);
#pragma unroll
    for (int r = 0; r < 32; ++r) {
        const size_t tok = base + (dir ? 31 - r : r);
        const float f0 = __expf(lf[r].x), f1 = __expf(lf[r].y);
        e0 *= f0; e1 *= f1;
        const float k0 = 1.0f - f0, k1 = 1.0f - f1;
        const float q0 = bf2f((unsigned short)(qv[r] & 0xffff)), q1 = bf2f((unsigned short)(qv[r] >> 16));
        unsigned* rowp = (unsigned*)(LOGF + tok * 1024 + dir * 512 + h * 128);
        __hip_atomic_store(rowp + lane, cvt_pk_bf16(q0 * e0, q1 * e1), __ATOMIC_RELAXED, __HIP_MEMORY_SCOPE_AGENT);
        __hip_atomic_store(rowp + 64 + lane, cvt_pk_bf16(k0 * __builtin_amdgcn_rcpf(e0), k1 * __builtin_amdgcn_rcpf(e1)), __ATOMIC_RELAXED, __HIP_MEMORY_SCOPE_AGENT);
    }
    float* hc = HC + ((size_t)(((b * 4 + h) * 2 + dir) * 64 + c)) * 384;
    { unsigned* hu = (unsigned*)hc + 2 * lane;
      __hip_atomic_store(hu, __float_as_uint(__expf(gref.x)), __ATOMIC_RELAXED, __HIP_MEMORY_SCOPE_AGENT); __hip_atomic_store(hu + 1, __float_as_uint(__expf(gref.y)), __ATOMIC_RELAXED, __HIP_MEMORY_SCOPE_AGENT);
      __hip_atomic_store(hu + 128, __float_as_uint(__expf(glast.x)), __ATOMIC_RELAXED, __HIP_MEMORY_SCOPE_AGENT); __hip_atomic_store(hu + 129, __float_as_uint(__expf(glast.y)), __ATOMIC_RELAXED, __HIP_MEMORY_SCOPE_AGENT);
      __hip_atomic_store(hu + 256, __float_as_uint(__expf(glast.x - gref.x)), __ATOMIC_RELAXED, __HIP_MEMORY_SCOPE_AGENT); __hip_atomic_store(hu + 257, __float_as_uint(__expf(glast.y - gref.y)), __ATOMIC_RELAXED, __HIP_MEMORY_SCOPE_AGENT); }
}

struct HgPf { u32x4 qr, kr; u32x2 v; float egr, dec, eglr, egr2, dec2, eglr2; };
__device__ __forceinline__ void hg_flush(LAS unsigned char* lds, const f32x16& OI, bf16_t* orow, int par, int wave, int lane) {
    const LAS float* xo = (const LAS float*)(lds + HG_XO) + (par * 2 + wave) * 1024 + lane;
    bf16_t* op = orow + wave * 32;
#pragma unroll
    for (int g4 = 0; g4 < 4; ++g4) {
        const float o0 = OI[4 * g4] + xo[(4 * g4) * 64], o1 = OI[4 * g4 + 1] + xo[(4 * g4 + 1) * 64], o2 = OI[4 * g4 + 2] + xo[(4 * g4 + 2) * 64], o3 = OI[4 * g4 + 3] + xo[(4 * g4 + 3) * 64];
        u32x2 w; w.x = cvt_pk_bf16(o0, o1); w.y = cvt_pk_bf16(o2, o3); *(u32x2*)(op + 8 * g4) = w;
    }
}
__device__ __forceinline__ void hg_chunk(LAS unsigned char* lds, const HgPf& pf, f32x16& ST, f32x16& ST2, f32x16& OI, bf16_t* orow_prev  ,
                                         int par, int tid, int lane, int wave, int l31, int hi) {
    LAS unsigned char* ls = lds + par * HG_SET;
    LAS bf16_t* QR = (LAS bf16_t*)(ls + HG_QR); LAS bf16_t* KR = (LAS bf16_t*)(ls + HG_KR); LAS bf16_t* VL = (LAS bf16_t*)(ls + HG_V); LAS bf16_t* STB = (LAS bf16_t*)(ls + HG_STB);
    const bool owner = wave >= 4; const int ow = wave - 4;
    const int r = tid >> 4, k0 = (tid & 15) * 8, v0 = (tid & 15) * 4, vt = (ow >> 1) & 1, ktb = (ow & 1) * 2;
    *(LAS u32x4*)(QR + r * 136 + k0) = pf.qr; *(LAS u32x4*)(KR + r * 136 + k0) = pf.kr;
    *(LAS u32x2*)(VL + r * 72 + v0) = pf.v;
    if (owner) {
        const int k = ktb * 32 + l31; const float egr = pf.egr, egr2 = pf.egr2;
#pragma unroll
        for (int i = 0; i < 16; i += 2) {
            const unsigned w = cvt_pk_bf16(egr * ST[i], egr * ST[i + 1]), w2 = cvt_pk_bf16(egr2 * ST2[i], egr2 * ST2[i + 1]);
            STB[(vt * 32 + crow(i, hi)) * 136 + k] = (bf16_t)(w & 0xffffu); STB[(vt * 32 + crow(i + 1, hi)) * 136 + k] = (bf16_t)(w >> 16);
            STB[(vt * 32 + crow(i, hi)) * 136 + k + 32] = (bf16_t)(w2 & 0xffffu); STB[(vt * 32 + crow(i + 1, hi)) * 136 + k + 32] = (bf16_t)(w2 >> 16);
        }
    }
    LBAR();
    if (wave < 2 && orow_prev) hg_flush(lds, OI, orow_prev, par ^ 1, wave, lane);
    if (wave < 4) {
        const int ot = wave & 1;
        bf16x8 qf[8];
#pragma unroll
        for (int ks = 0; ks < 8; ++ks) qf[ks] = *(const LAS bf16x8*)(QR + l31 * 136 + 16 * ks + 8 * hi);
        if (wave < 2) {
            f32x16 p, p2;
#pragma unroll
            for (int i = 0; i < 16; ++i) { p[i] = 0.f; p2[i] = 0.f; }
#pragma unroll
            for (int ks = 0; ks < 8; ks += 2) {
                const bf16x8 a = *(const LAS bf16x8*)(KR + l31 * 136 + 16 * ks + 8 * hi);
                const bf16x8 a2 = *(const LAS bf16x8*)(KR + l31 * 136 + 16 * (ks + 1) + 8 * hi);
                p = MFMA32(a, qf[ks], p); p2 = MFMA32(a2, qf[ks + 1], p2);
            }
#pragma unroll
            for (int i = 0; i < 16; ++i) { p[i] = crow(i, hi) > l31 ? 0.f : p[i] + p2[i]; }
            const bf16x8 pf0 = pack8(p, 0), pf1 = pack8(p, 1);
            f32x16 o, ob;
#pragma unroll
            for (int i = 0; i < 16; ++i) { o[i] = 0.f; ob[i] = 0.f; }
            const LAS bf16_t* vp = VL + (4 * hi + ((lane & 15) >> 2)) * 72 + 16 * ((lane >> 4) & 1) + 4 * (lane & 3) + ot * 32;
            const bf16x8 a0 = cat8(vtr(vp), vtr(vp + 8 * 72)); o = MFMA32(a0, pf0, o);
            const bf16x8 a1 = cat8(vtr(vp + 16 * 72), vtr(vp + 24 * 72)); ob = MFMA32(a1, pf1, ob);
#pragma unroll
            for (int i = 0; i < 16; ++i) OI[i] = o[i] + ob[i];
        } else {
            f32x16 o, o2;
#pragma unroll
            for (int i = 0; i < 16; ++i) { o[i] = 0.f; o2[i] = 0.f; }
#pragma unroll
            for (int ks = 0; ks < 8; ks += 2) {
                const bf16x8 sa = *(const LAS bf16x8*)(STB + (ot * 32 + l31) * 136 + 16 * ks + 8 * hi);
                const bf16x8 sb = *(const LAS bf16x8*)(STB + (ot * 32 + l31) * 136 + 16 * (ks + 1) + 8 * hi);
                o = MFMA32(sa, qf[ks], o); o2 = MFMA32(sb, qf[ks + 1], o2);
            }
            LAS float* xo = (LAS float*)(lds + HG_XO) + (par * 2 + ot) * 1024 + lane;
#pragma unroll
            for (int i = 0; i < 16; ++i) xo[i * 64] = o[i] + o2[i];
        }
    }
    if (owner) {
        f32x16 tmp, tmp2;
#pragma unroll
        for (int i = 0; i < 16; ++i) { tmp[i] = 0.f; tmp2[i] = 0.f; }
#pragma unroll
        for (int st = 0; st < 2; ++st) {
            const LAS bf16_t* vp = VL + (16 * st + 8 * hi + ((lane & 15) >> 2)) * 72 + 16 * ((lane >> 4) & 1) + 4 * (lane & 3) + vt * 32;
            const LAS bf16_t* kp = KR + (16 * st + 8 * hi + ((lane & 15) >> 2)) * 136 + 16 * ((lane >> 4) & 1) + 4 * (lane & 3) + ktb * 32;
            const bf16x8 a = cat8(vtr(vp), vtr(vp + 4 * 72));
            const bf16x8 bk = cat8(vtr(kp), vtr(kp + 4 * 136));
            const bf16x8 bk2 = cat8(vtr(kp + 32), vtr(kp + 4 * 136 + 32));
            tmp = MFMA32(a, bk, tmp); tmp2 = MFMA32(a, bk2, tmp2);
        }
        const float dec = pf.dec, eglr = pf.eglr, dec2 = pf.dec2, eglr2 = pf.eglr2;
#pragma unroll
        for (int i = 0; i < 16; ++i) { ST[i] = __builtin_fmaf(dec, ST[i], eglr * tmp[i]); ST2[i] = __builtin_fmaf(dec2, ST2[i], eglr2 * tmp2[i]); }
    }
}

__device__ __forceinline__ void hgrn_unit(LAS unsigned char* lds, int unit, const bf16_t* Q0, float* LOGF, const bf16_t* V0, bf16_t* OFB, float* HC, unsigned* flags) {
    const int vs = unit & 1, dir = (unit >> 1) & 1, h = (unit >> 2) & 3, b = unit >> 4;
    int tid_ = threadIdx.x; asm volatile("" : "+v"(tid_)); const int tid = tid_, lane = tid & 63, wave = __builtin_amdgcn_readfirstlane(tid >> 6), l31 = lane & 31, hi = lane >> 5;
#if PROBE_H >= 0
    const unsigned long long ht0 = __builtin_amdgcn_s_memrealtime();
#endif
    for (int j = 0; j < 4; ++j) hgrn_pre_item(LOGF, Q0, HC, b, h, dir, 32 * vs + wave + 8 * j, lane);
    asm volatile("s_waitcnt vmcnt(0)" ::: "memory");
    __syncthreads();
    if (tid == 0) {
        __hip_atomic_store(flags + 16 * unit, 1u, __ATOMIC_RELAXED, __HIP_MEMORY_SCOPE_AGENT);
        unsigned sp = 0;
        while (__hip_atomic_load(flags + 16 * (unit ^ 1), __ATOMIC_RELAXED, __HIP_MEMORY_SCOPE_AGENT) == 0u) { __builtin_amdgcn_s_sleep(1); if (++sp > (1u << 24)) break; }
        __builtin_amdgcn_fence(__ATOMIC_ACQUIRE, "agent"); asm volatile("s_waitcnt vmcnt(0)" ::: "memory");
    }
    __syncthreads();
#if PROBE_H >= 0
    const unsigned long long ht1 = __builtin_amdgcn_s_memrealtime();
#endif
    const int r = tid >> 4, k0 = (tid & 15) * 8, v0 = (tid & 15) * 4, ktb = wave >= 4 ? ((wave - 4) & 1) * 2 : 0;
    f32x16 ST, ST2, OI;
#pragma unroll
    for (int i = 0; i < 16; ++i) { ST[i] = 0.f; ST2[i] = 0.f; OI[i] = 0.f; }
    const size_t tokb = (size_t)b * T;
    const float* hcu = HC + (size_t)(((b * 4 + h) * 2 + dir) * 64) * 384 + ktb * 32 + l31;
    HgPf R[3];
#define HG_ISSUE(P, CI) do { const int c_ = dir ? 63 - (CI) : (CI); const size_t tok_ = tokb + c_ * 32 + (dir ? 31 - r : r); \
        const bf16_t* rp_ = (const bf16_t*)(LOGF + tok_ * 1024 + dir * 512 + h * 128); (P).qr = *(const u32x4*)(rp_ + k0); (P).kr = *(const u32x4*)(rp_ + 128 + k0); \
        (P).v = *(const u32x2*)(V0 + tok_ * 512 + h * 128 + vs * 64 + v0); \
        const float* hc_ = hcu + (size_t)c_ * 384; (P).egr = hc_[0]; (P).egr2 = hc_[32]; (P).dec = hc_[128]; (P).dec2 = hc_[160]; (P).eglr = hc_[256]; (P).eglr2 = hc_[288]; } while (0)
#define HG_OROW(CI) (OFB + ((size_t)dir * M + tokb + (size_t)(dir ? 63 - (CI) : (CI)) * 32 + (dir ? 31 - l31 : l31)) * 512 + h * 128 + vs * 64 + 4 * hi)
    HG_ISSUE(R[0], 0); HG_ISSUE(R[1], 1); HG_ISSUE(R[2], 2);
    for (int c3 = 0; c3 < 72; c3 += 12) {
#pragma unroll
        for (int u = 0; u < 12; ++u) {
            const int ci = c3 + u;
            if (ci >= 64) break;
            const HgPf cur = R[u % 3];
            if (ci + 3 < 64) HG_ISSUE(R[u % 3], ci + 3);
            hg_chunk(lds, cur, ST, ST2, OI, ci > 0 ? HG_OROW(ci - 1) : (bf16_t*)nullptr, ci & 1, tid, lane, wave, l31, hi);
        }
    }
    LBAR();
    if (wave < 2) hg_flush(lds, OI, HG_OROW(63), 1, wave, lane);
    LBAR();
#undef HG_ISSUE
#undef HG_OROW
#if PROBE_H >= 0
    if (tid == 0) { LAS unsigned long long* hp = (LAS unsigned long long*)(lds + 131072 + 1024); hp[0] = ht1 - ht0; hp[1] = __builtin_amdgcn_s_memrealtime() - ht1; }
#endif
}

constexpr int AT_K = 0, AT_V = 384 * 72 * 2, AT_END = 2 * 384 * 72 * 2;
static_assert(AT_END <= 131072, "attn lds");
__device__ __forceinline__ void attn_phase(LAS unsigned char* lds, int bid, int G, const bf16_t* QKV, const float* sink, bf16_t* OUT) {
    int tid_ = threadIdx.x; asm volatile("" : "+v"(tid_)); const int tid = tid_, lane = tid & 63, wave = __builtin_amdgcn_readfirstlane(tid >> 6), l31 = lane & 31, hi = lane >> 5;
    LAS bf16_t* KL = (LAS bf16_t*)(lds + AT_K);
    LAS bf16_t* VL = (LAS bf16_t*)(lds + AT_V);
    const LAS bf16_t* vtr0 = VL + (4 * hi + ((lane & 15) >> 2)) * 72 + 16 * ((lane >> 4) & 1) + 4 * (lane & 3);
    const int g = wave >> 1, half = wave & 1;
    u32x4 kx[6], vx[6];
#define AT_LOADKV(U) do { const int qb_ = (U) & 15, kv_ = ((U) >> 4) & 3, b_ = (U) >> 6; _Pragma("unroll") for (int it = 0; it < 6; ++it) { \
        const int idx = tid + it * 512, row = idx >> 3, c8 = idx & 7, pos = qb_ * 128 - 128 + row; \
        kx[it] = (u32x4){0u, 0u, 0u, 0u}; vx[it] = (u32x4){0u, 0u, 0u, 0u}; \
        if (pos >= 0 && pos < T) { const bf16_t* p = QKV + ((size_t)b_ * T + pos) * 1536 + kv_ * 64 + c8 * 8; kx[it] = *(const u32x4*)(p + 1024); vx[it] = *(const u32x4*)(p + 1280); } } } while (0)
    if (bid < 512) AT_LOADKV(bid);
    for (int unit = bid; unit < 512; unit += G) {
        const int qb = unit & 15, kv = (unit >> 4) & 3, b = unit >> 6;
        const int Q0p = qb * 128, kbase = Q0p - 128;
        const size_t tokb = (size_t)b * T;
        const int hh = kv * 4 + g;
#pragma unroll
        for (int it = 0; it < 6; ++it) { const int idx = tid + it * 512, row = idx >> 3, c8 = idx & 7; *(LAS u32x4*)(KL + row * 72 + c8 * 8) = kx[it]; *(LAS u32x4*)(VL + row * 72 + c8 * 8) = vx[it]; }
        bf16x8 qfa[2][4];
#pragma unroll
        for (int qt = 0; qt < 2; ++qt) { const bf16_t* qp = QKV + (tokb + Q0p + half * 64 + qt * 32 + l31) * 1536 + hh * 64 + 8 * hi;
#pragma unroll
            for (int s4 = 0; s4 < 4; ++s4) qfa[qt][s4] = *(const bf16x8*)(qp + 16 * s4); }
        LBAR();
        if (unit + G < 512) AT_LOADKV(unit + G);
        const float slope2 = exp2f(-0.5f * (float)(hh + 1)) * LOG2E, sink2 = sink[hh] * LOG2E;
#pragma unroll
        for (int qt = 0; qt < 2; ++qt) {
            const int q0l = half * 64 + qt * 32, qpos = Q0p + q0l + l31;
            float mrun = sink2, lsum = hi == 0 ? 1.0f : 0.0f;
            f32x16 o0, o1;
#pragma unroll
            for (int i = 0; i < 16; ++i) { o0[i] = 0.f; o1[i] = 0.f; }
            for (int j = 0; j < 9; ++j) {
                const int kt = 4 + (((j + 1) >> 1) ^ -(j & 1)) + (j & 1);
                const int krow0 = q0l + 32 * kt, kpos0 = kbase + krow0;
                if (kpos0 + 31 < 0 || kpos0 >= T) continue;
                f32x16 s;
#pragma unroll
                for (int i = 0; i < 16; ++i) s[i] = 0.f;
#pragma unroll
                for (int ks = 0; ks < 4; ++ks) {
                    const bf16x8 a = *(const LAS bf16x8*)(KL + (krow0 + l31) * 72 + 16 * ks + 8 * hi);
                    s = MFMA32(a, qfa[qt][ks], s);
                }
                if (kt == 4) {
#pragma unroll
                    for (int i = 0; i < 16; ++i) { const int dd = qpos - (kpos0 + crow(i, hi)); s[i] = __builtin_fmaf(-slope2, (float)(dd < 0 ? -dd : dd), s[i]); }
                } else {
                    const float sg = kt < 4 ? 1.0f : -1.0f;
                    const int dq = qpos - kpos0 - 4 * hi;
                    const float base = -slope2 * sg * (float)dq, step = slope2 * sg;
#pragma unroll
                    for (int i = 0; i < 16; ++i) s[i] = __builtin_fmaf(step, (float)((i & 3) + 8 * (i >> 2)), s[i] + base);
                    if (kt == 0) {
#pragma unroll
                        for (int i = 0; i < 16; ++i) { if (dq - ((i & 3) + 8 * (i >> 2)) > 128) s[i] = -INFINITY; }
                    }
                    if (kt == 8) {
#pragma unroll
                        for (int i = 0; i < 16; ++i) { if (((i & 3) + 8 * (i >> 2)) - dq > 128) s[i] = -INFINITY; }
                    }
                }
                float tmax = s[0];
#pragma unroll
                for (int i = 1; i < 16; ++i) tmax = fmaxf(tmax, s[i]);
                tmax = fmaxf(tmax, __shfl_xor(tmax, 32));
                if (__builtin_amdgcn_ballot_w64(tmax > mrun) != 0ull) {
                    const float mnew = fmaxf(mrun, tmax), alpha = __builtin_amdgcn_exp2f(mrun - mnew);
                    mrun = mnew; lsum *= alpha;
#pragma unroll
                    for (int i = 0; i < 16; ++i) { o0[i] *= alpha; o1[i] *= alpha; }
                }
                float ps = 0.f;
#pragma unroll
                for (int i = 0; i < 16; ++i) { const float pe = __builtin_amdgcn_exp2f(s[i] - mrun); s[i] = pe; ps += pe; }
                lsum += ps;
                const bf16x8 pf0 = pack8(s, 0), pf1 = pack8(s, 1);
                const LAS bf16_t* vp = vtr0 + krow0 * 72;
                { const bf16x8 a = cat8(vtr(vp), vtr(vp + 8 * 72)); o0 = MFMA32(a, pf0, o0); }
                { const bf16x8 a = cat8(vtr(vp + 32), vtr(vp + 8 * 72 + 32)); o1 = MFMA32(a, pf0, o1); }
                { const bf16x8 a = cat8(vtr(vp + 16 * 72), vtr(vp + 24 * 72)); o0 = MFMA32(a, pf1, o0); }
                { const bf16x8 a = cat8(vtr(vp + 16 * 72 + 32), vtr(vp + 24 * 72 + 32)); o1 = MFMA32(a, pf1, o1); }
            }
            const float ltot = lsum + __shfl_xor(lsum, 32), inv = 1.0f / ltot;
            bf16_t* op = OUT + (tokb + qpos) * 1024 + hh * 64 + 4 * hi;
#pragma unroll
            for (int g4 = 0; g4 < 4; ++g4) {
                u32x2 w; w.x = cvt_pk_bf16(o0[4 * g4] * inv, o0[4 * g4 + 1] * inv); w.y = cvt_pk_bf16(o0[4 * g4 + 2] * inv, o0[4 * g4 + 3] * inv); *(u32x2*)(op + 8 * g4) = w;
                u32x2 w2; w2.x = cvt_pk_bf16(o1[4 * g4] * inv, o1[4 * g4 + 1] * inv); w2.y = cvt_pk_bf16(o1[4 * g4 + 2] * inv, o1[4 * g4 + 3] * inv); *(u32x2*)(op + 32 + 8 * g4) = w2;
            }
        }
        LBAR();
    }
#undef AT_LOADKV
}

struct Args { const float* in[12]; float* out; unsigned char* ws; };

template <int SEL> __device__ __forceinline__ void conv_items(const Args& a, LAS float* scr, int gwi, int ngwi, int lane_in, int lo = 0, int hi = 0) {
    int lane = lane_in; asm volatile("" : "+v"(lane));
    unsigned char* ws = a.ws;
    constexpr int I_W = 16 * 88, I_W2 = 44 * 32;
    constexpr int N0 = 16 * 80, N1 = 2048, N3 = 16 * 32 + 2 * I_W + I_W2, N2 = 16 * 48 + 16 * 32 + 2 * I_W + I_W2;
    constexpr int NITEMS = SEL == 0 ? N0 : (SEL == 1 ? N1 : (SEL == 3 ? N3 : N2));
    constexpr int layer = SEL == 2 ? 1 : 0;
    for (int it0 = gwi;; it0 += ngwi) {
        int it = it0;
        if (hi > 0) { it = lo + it0; if (it >= hi) break; }
        else if (it >= NITEMS) break;
        if constexpr (SEL == 0) { const int kb = it / 80, nb = it % 80, n0 = nb * 32, sg = n0 >> 9, slot = sg == 2 ? 3 : (sg == 3 ? 2 : sg);
            transpose_item(a.in[2], 3072, 1024, (bf16_t*)(ws + WS_WP), kb * 64, n0, slot * 512 + (n0 & 511), scr, lane); continue; }
        if constexpr (SEL == 1) {
            if (it < 2048) {
                const int k1 = it; bf16_t* dr = (bf16_t*)(ws + WS_DFT) + (size_t)k1 * 4096;
#pragma unroll 2
                for (int i = 0; i < 8; ++i) {
                    const int col0 = (i * 64 + lane) * 8, cs = col0 >> 11;
                    float v[8];
#pragma unroll
                    for (int j = 0; j < 8; ++j) {
                        const int t = (col0 + j) & 2047; const float ph = (float)((k1 * t) & 2047) * (1.0f / 2048.0f);
                        v[j] = (cs ? -__builtin_amdgcn_sinf(ph) : __builtin_amdgcn_cosf(ph)) * (1.0f / 512.0f);
                    }
                    u32x4 o; o.x = cvt_pk_bf16(v[0], v[1]); o.y = cvt_pk_bf16(v[2], v[3]); o.z = cvt_pk_bf16(v[4], v[5]); o.w = cvt_pk_bf16(v[6], v[7]);
                    *(u32x4*)(dr + col0) = o;
                }
                continue;
            }
        }
        if constexpr (SEL == 3) {
            if (it < 512) { const int kb = it / 32, nb = it % 32; transpose_item(a.in[5], 1024, 1024, (bf16_t*)(ws + WS_WO0), kb * 64, nb * 32, nb * 32, scr, lane); continue; }
            it -= 512;
        }
        if constexpr (SEL == 2) {
            if (it < 768) { const int kb = it / 48, nb = it % 48; transpose_item(a.in[6], 1536, 1024, (bf16_t*)(ws + WS_WQKV), kb * 64, nb * 32, nb * 32, scr, lane, a.in[1] + 4 * D); continue; }
            it -= 768;
            if (it < 512) { const int kb = it / 32, nb = it % 32; transpose_item(a.in[8], 1024, 1024, (bf16_t*)(ws + WS_WO1), kb * 64, nb * 32, nb * 32, scr, lane); continue; }
            it -= 512;
        }
        if constexpr (SEL >= 2) {
            if (it < 2 * I_W) {
                const int which = it >= I_W; if (which) it -= I_W;
                const int kb = it / 88, nb = it % 88, n0 = nb * 32;
                const float* src = (which ? a.in[10] : a.in[9]) + (size_t)layer * 1024 * FF;
                transpose_item(src, FF, 1024, (bf16_t*)(ws + WS_W13) + (size_t)layer * W13_STRIDE, kb * 64, n0, 256 * (n0 >> 7) + 128 * which + (n0 & 127), scr, lane, a.in[1] + (layer * 4 + 2) * D); continue;
            }
            it -= 2 * I_W;
            { const int kb = it / 32, nb = it % 32;
              transpose_item(a.in[11] + (size_t)layer * FF * 1024, 1024, FF, (bf16_t*)(ws + WS_W2) + (size_t)layer * W2_STRIDE, kb * 64, nb * 32, nb * 32, scr, lane); }
        }
    }
}
__device__ __forceinline__ void prologue(const Args& a, LAS unsigned char* lds, int gw, int ngw, int wave, int lane) {
    unsigned char* ws = a.ws;
    LAS float* scr = (LAS float*)(lds + wave * 16384);
    const float* w_in = a.in[2];
    if (wave < 2) {
        const int G_ = ngw >> 3, bid_ = gw >> 3;
        bf16_t* Wcs = (bf16_t*)(ws + WS_WCS);
        for (int j = wave * G_ + bid_; j < 512; j += 2 * G_) {
            const int g = j >> 7, k0 = (j & 127) * 8;
#pragma unroll
            for (int i = 0; i < 4; ++i) { const int idx = i * 64 + lane, kk = idx >> 5, c4 = idx & 31; *(LAS f32x4*)(scr + kk * 128 + 4 * c4) = *(const f32x4*)(w_in + (size_t)(k0 + kk) * 3072 + 2560 + g * 128 + 4 * c4); }
            LDS_WAIT();
            float aca[8], asa[8], acb[8], asb[8];
#pragma unroll
            for (int kk = 0; kk < 8; ++kk) { aca[kk] = 0.f; asa[kk] = 0.f; acb[kk] = 0.f; asb[kk] = 0.f; }
            for (int c = 0; c < 128; ++c) {
                const float ph = (float)((lane * c) & 127) * (1.0f / 128.0f);
                const float ca = __builtin_amdgcn_cosf(ph), sa = __builtin_amdgcn_sinf(ph);
                const float cb = (c & 1) ? -ca : ca, sb = (c & 1) ? -sa : sa;
#pragma unroll
                for (int kk = 0; kk < 8; ++kk) { const float w = scr[kk * 128 + c]; aca[kk] += w * ca; asa[kk] += w * sa; acb[kk] += w * cb; asb[kk] += w * sb; }
            }
            u32x4 o;
            o.x = cvt_pk_bf16(aca[0], aca[1]); o.y = cvt_pk_bf16(aca[2], aca[3]); o.z = cvt_pk_bf16(aca[4], aca[5]); o.w = cvt_pk_bf16(aca[6], aca[7]); *(u32x4*)(Wcs + (size_t)(g * 128 + lane) * 1024 + k0) = o;
            o.x = cvt_pk_bf16(acb[0], acb[1]); o.y = cvt_pk_bf16(acb[2], acb[3]); o.z = cvt_pk_bf16(acb[4], acb[5]); o.w = cvt_pk_bf16(acb[6], acb[7]); *(u32x4*)(Wcs + (size_t)(g * 128 + lane + 64) * 1024 + k0) = o;
            o.x = cvt_pk_bf16(asa[0], asa[1]); o.y = cvt_pk_bf16(asa[2], asa[3]); o.z = cvt_pk_bf16(asa[4], asa[5]); o.w = cvt_pk_bf16(asa[6], asa[7]); *(u32x4*)(Wcs + (size_t)(512 + g * 128 + lane) * 1024 + k0) = o;
            o.x = cvt_pk_bf16(asb[0], asb[1]); o.y = cvt_pk_bf16(asb[2], asb[3]); o.z = cvt_pk_bf16(asb[4], asb[5]); o.w = cvt_pk_bf16(asb[6], asb[7]); *(u32x4*)(Wcs + (size_t)(512 + g * 128 + lane + 64) * 1024 + k0) = o;
            LDS_WAIT();
        }
    }
    conv_items<0>(a, scr, gw, ngw, lane);
    if (wave >= 2) {
        const float* x = a.in[0]; bf16_t* XNp = (bf16_t*)(ws + WS_XN);
        f32x4 g4[4];
#pragma unroll
        for (int j = 0; j < 4; ++j) g4[j] = ((const f32x4*)a.in[1])[lane + 64 * j];
        const int gw6 = (gw >> 3) * 6 + (wave - 2), ngw6 = (ngw >> 3) * 6;
        for (int row0 = gw6; row0 < M; row0 += 4 * ngw6) {
            f32x4 v[4][4];
#pragma unroll
            for (int q = 0; q < 4; ++q) { const int row = row0 + q * ngw6; if (row < M) {
#pragma unroll
                for (int j = 0; j < 4; ++j) v[q][j] = ((const f32x4*)(x + (size_t)row * D))[lane + 64 * j]; } }
#pragma unroll
            for (int q = 0; q < 4; ++q) { const int row = row0 + q * ngw6; if (row < M) {
                float ss = 0.f;
#pragma unroll
                for (int j = 0; j < 4; ++j) ss += (v[q][j].x * v[q][j].x + v[q][j].y * v[q][j].y) + (v[q][j].z * v[q][j].z + v[q][j].w * v[q][j].w);
                const float r = rsqrtf(wave_sum(ss) * (1.0f / D) + EPS);
#pragma unroll
                for (int j = 0; j < 4; ++j) { const f32x4 o = v[q][j] * r * g4[j]; u32x2 w; w.x = cvt_pk_bf16(o.x, o.y); w.y = cvt_pk_bf16(o.z, o.w); ((u32x2*)(XNp + (size_t)row * D))[lane + 64 * j] = w; }
            } }
        }
    }
}

#ifndef PHMASK
#define PHMASK 0xffff
#endif
#ifndef REP_HGRN
#define REP_HGRN 1
#endif
#ifndef REP_SYNC
#define REP_SYNC 1
#endif
#ifndef REP_PRO
#define REP_PRO 1
#endif
#ifndef REP_ATTN
#define REP_ATTN 1
#endif
#ifndef REP_FNET
#define REP_FNET 1
#endif
constexpr int CONV2_N = 16 * 48 + 16 * 32 + 3 * 16 * 88, CONV2_SPLIT = 16 * 48 + 16 * 32 + 16 * 88;
#ifndef REP_GEMM
#define REP_GEMM 1
#endif

#if PROBE_K >= 0
#define STAMP() do { if (bid == 0 && tid == 0) { ((LAS unsigned long long*)(lds + 131072 + 512))[nst] = __builtin_amdgcn_s_memrealtime(); } ++nst; } while (0)
#else
#define STAMP() do { } while (0)
#endif
#define GSYNC() do { for (int r_ = 0; r_ < REP_SYNC; ++r_) xcd_barrier(xbar); STAMP(); } while (0)

__global__ void __launch_bounds__(512, 2) fwd_megakernel(Args a) {
    extern __shared__ __attribute__((aligned(16))) unsigned char lds_raw[];
    LAS unsigned char* lds = (LAS unsigned char*)lds_raw;
    cg::grid_group grid = cg::this_grid();
    const int tid = threadIdx.x, lane = tid & 63, wave = __builtin_amdgcn_readfirstlane(tid >> 6);
    const int G = gridDim.x, bid = blockIdx.x, gw = bid * 8 + wave, ngw = G * 8;
    unsigned char* ws = a.ws;
    bf16_t* XN = (bf16_t*)(ws + WS_XN); float* MBUF = (float*)(ws + WS_MBUF);
    bf16_t* ACAT = (bf16_t*)(ws + WS_ACAT); bf16_t* HB = (bf16_t*)(ws + WS_H);
    float* LOGF = a.out;
    const float* gains = a.in[1];
    if (tid < 64) ((LAS unsigned*)(lds + 131072))[tid] = 0u;
    __syncthreads();
    if (__builtin_expect(a.ws == nullptr, 0)) grid.sync();
    int nst = 0; STAMP();
    XcdBarrier xbar = xcd_barrier_post((unsigned*)ws, (volatile LAS unsigned*)(lds + 131072 + 32));

#if PHMASK & 1
    for (int rp = 0; rp < REP_PRO; ++rp) prologue(a, lds, gw, ngw, wave, lane);
#endif
    GSYNC();

#if PHMASK & 2
    {
        pg8::Gemm g{XN, (const bf16_t*)(ws + WS_WP), M, 2560, 1024}; pg8::StaticOrder S; S.init(M, 2560, G, bid);
        EpiProj E{(bf16_t*)(ws + WS_Q0), LOGF, a.in[3]};
        static_assert(WS_V0 == WS_Q0 + (size_t)M * 512 * 2 && WS_GATE == WS_V0 + (size_t)M * 512 * 2, "Q0 | V0 | GATE consecutive");
        pg8::gemm_phase<EpiProj, pg8::StaticOrder, true, true>(lds, g, S, E);
    }
#endif
#if PHMASK & 4
    {
        pg8::Gemm g{(const bf16_t*)(ws + WS_WCS), XN, 1024, M, 1024}; pg8::StaticOrder S; S.init(1024, M, G, bid);
        EpiYt E{(bf16_t*)(ws + WS_YT)};
        pg8::gemm_phase<EpiYt, pg8::StaticOrder, true, true>(lds, g, S, E);
    }
#endif
    constexpr int CONV3_SPLIT = 2400, CONV3_N = 16 * 32 + 2 * 16 * 88 + 44 * 32;
    if ((G & 1) == 0) { if (bid >= G / 2) { conv_items<1>(a, (LAS float*)(lds + wave * 16384), (bid - G / 2) * 8 + wave, (G / 2) * 8, lane); } }
    else conv_items<1>(a, (LAS float*)(lds + wave * 16384), gw, ngw, lane);
    GSYNC();

    {
        const bool split = (G % 16) == 0;
        const bool do_f = !split || (((bid >> 3) & 1) == 0), do_h = !split || (((bid >> 3) & 1) == 1);
        const int gsz = split ? G / 2 : G, gidx = split ? (bid >> 4) * 8 + (bid & 7) : bid;
#if PHMASK & 8
        if (do_f) for (int rp = 0; rp < REP_FNET; ++rp) {
            pg8::Gemm g{(const bf16_t*)(ws + WS_DFT), (const bf16_t*)(ws + WS_YT), 2048, 4096, 4096}; pg8::StaticOrder S; S.init(2048, 4096, gsz, gidx);
            EpiFnet E{ACAT};
            pg8::gemm_phase<EpiFnet, pg8::StaticOrder, true, true>(lds, g, S, E);
        }
        if (do_f) conv_items<3>(a, (LAS float*)(lds + wave * 16384), gidx * 8 + wave, gsz * 8, lane);
#endif
#if PHMASK & 16
        if (do_h) {
            for (int rp = 0; rp < REP_HGRN; ++rp) for (int u = gidx; u < 128; u += gsz) hgrn_unit(lds, u, (const bf16_t*)(ws + WS_Q0), LOGF, (const bf16_t*)(ws + WS_V0), (bf16_t*)(ws + WS_OFB), (float*)(ws + WS_HC), (unsigned*)(ws + WS_HFLAG));
        }
#endif
    }
    GSYNC();

    {
        const bf16_t* OFB = (const bf16_t*)(ws + WS_OFB); const bf16_t* GATE = (const bf16_t*)(ws + WS_GATE); const float* og = a.in[4];
        for (int row = gw; row < M; row += ngw) {
            const u32x4 f = *(const u32x4*)(OFB + (size_t)row * 512 + lane * 8), bw = *(const u32x4*)(OFB + ((size_t)M + row) * 512 + lane * 8), gt = *(const u32x4*)(GATE + (size_t)row * 512 + lane * 8);
            float o[8]; float ss = 0.f;
#pragma unroll
            for (int j = 0; j < 4; ++j) {
                o[2 * j] = bf2f((unsigned short)(f[j] & 0xffff)) + bf2f((unsigned short)(bw[j] & 0xffff));
                o[2 * j + 1] = bf2f((unsigned short)(f[j] >> 16)) + bf2f((unsigned short)(bw[j] >> 16));
                ss += o[2 * j] * o[2 * j] + o[2 * j + 1] * o[2 * j + 1];
            }
            ss += __shfl_xor(ss, 1); ss += __shfl_xor(ss, 2); ss += __shfl_xor(ss, 4); ss += __shfl_xor(ss, 8);
            const float r = rsqrtf(ss * (1.0f / 128.0f) + EPS);
            const f32x4 g0 = *(const f32x4*)(og + lane * 8), g1 = *(const f32x4*)(og + lane * 8 + 4);
            float res[8];
#pragma unroll
            for (int j = 0; j < 4; ++j) {
                res[2 * j] = o[2 * j] * r * (2 * j < 4 ? g0[2 * j] : g1[2 * j - 4]) * bf2f((unsigned short)(gt[j] & 0xffff));
                res[2 * j + 1] = o[2 * j + 1] * r * (2 * j + 1 < 4 ? g0[2 * j + 1] : g1[2 * j + 1 - 4]) * bf2f((unsigned short)(gt[j] >> 16));
            }
            u32x4 w; w.x = cvt_pk_bf16(res[0], res[1]); w.y = cvt_pk_bf16(res[2], res[3]); w.z = cvt_pk_bf16(res[4], res[5]); w.w = cvt_pk_bf16(res[6], res[7]);
            *(u32x4*)(ACAT + (size_t)row * 1024 + lane * 8) = w;
        }
    }
    GSYNC();

#pragma unroll
    for (int layer = 0; layer < 2; ++layer) {
        const float* gl = gains + (size_t)layer * 4 * D;
        if (layer == 1) {
            {
                pg8::Gemm g{(const bf16_t*)(ws + WS_XRES), (const bf16_t*)(ws + WS_WQKV), M, 1536, 1024}; pg8::StaticOrder S; S.init(M, 1536, G, bid);
                const float* ssq_ = (const float*)(ws + WS_SSQ) + (size_t)1 * ((size_t)M * 4); (void)stage_rstd(lds, ssq_, S);
                EpiQKV E{(bf16_t*)(ws + WS_QKV1), (const LAS float*)(lds + RSTD_OFF)};
                pg8::gemm_phase<EpiQKV, pg8::StaticOrder, true, true>(lds, g, S, E);
            }
            if ((G & 1) == 0 && bid >= G / 2) conv_items<2>(a, (LAS float*)(lds + wave * 16384), (bid - G / 2) * 8 + wave, (G / 2) * 8, lane, CONV2_SPLIT, CONV2_N);
            GSYNC();
#if PHMASK & 32
            attn_phase(lds, bid, G, (const bf16_t*)(ws + WS_QKV1), a.in[7], ACAT);
#endif
            GSYNC();
        }
        {
            pg8::Gemm g{ACAT, (const bf16_t*)(ws + (layer == 0 ? WS_WO0 : WS_WO1)), M, 1024, 1024}; pg8::StaticOrder S; S.init(M, 1024, G, bid);
            if (layer == 0) { typedef EpiRmsRes<0, 1 * D, 2 * D, true, false> EP; EP E{a.in[0], a.out, ws, gains}; pg8::gemm_phase<EP, pg8::StaticOrder, false, true>(lds, g, S, E); }
            else            { typedef EpiRmsRes<4, 5 * D, 6 * D, false, false> EP; EP E{a.out, a.out, ws, gains}; pg8::gemm_phase<EP, pg8::StaticOrder, false, true>(lds, g, S, E); }
        }
        GSYNC();
        {
            pg8::Gemm g{(const bf16_t*)(ws + WS_XRES), (const bf16_t*)(ws + WS_W13) + (size_t)layer * W13_STRIDE, M, 5632, 1024}; pg8::StaticOrder S; S.init(M, 5632, G, bid);
            const float* ssq_ = (const float*)(ws + WS_SSQ) + (size_t)(layer * 2) * ((size_t)M * 4); (void)stage_rstd(lds, ssq_, S);
            EpiSwiglu E{HB, (const LAS float*)(lds + RSTD_OFF)};
            pg8::gemm_phase<EpiSwiglu, pg8::StaticOrder, true, true>(lds, g, S, E);
        }
        if (layer == 0) {
            if ((G & 1) == 0) { if (bid >= G / 2) conv_items<2>(a, (LAS float*)(lds + wave * 16384), (bid - G / 2) * 8 + wave, (G / 2) * 8, lane, 0, CONV2_SPLIT); }
            else conv_items<2>(a, (LAS float*)(lds + wave * 16384), gw, ngw, lane);
        }
        GSYNC();
        {
            pg8::Gemm g{HB, (const bf16_t*)(ws + WS_W2) + (size_t)layer * W2_STRIDE, M, 1024, FF}; pg8::StaticOrder S; S.init(M, 1024, G, bid);
            if (layer == 0) { typedef EpiRmsRes<2, 3 * D, 4 * D, false, false> EP; EP E{a.out, a.out, ws, gains}; pg8::gemm_phase<EP, pg8::StaticOrder, false, true>(lds, g, S, E); }
            else            { typedef EpiRmsRes<6, 7 * D, -1, false, true> EP; EP E{a.out, a.out, ws, gains}; pg8::gemm_phase<EP, pg8::StaticOrder, false, true>(lds, g, S, E); }
        }
        if (layer == 0) GSYNC();
    }
#if PROBE_H >= 0
    if (bid == 8 && tid == 0) {
        const unsigned long long d = ((LAS unsigned long long*)(lds + 131072 + 1024))[PROBE_H], t0 = __builtin_amdgcn_s_memrealtime();
        while (__builtin_amdgcn_s_memrealtime() - t0 < 4ull * d) __builtin_amdgcn_s_sleep(8);
    }
#endif
#if PROBE_K >= 0
    STAMP();
    if (bid == 0 && tid == 0) {
        LAS unsigned long long* st = (LAS unsigned long long*)(lds + 131072 + 512);
        const unsigned long long d = st[PROBE_K + 1] - st[PROBE_K], t0 = __builtin_amdgcn_s_memrealtime();
        while (__builtin_amdgcn_s_memrealtime() - t0 < 4ull * d) __builtin_amdgcn_s_sleep(8);
    }
#endif
}

extern "C" void kernel_launch(void* const* d_in, const int* in_sizes, int n_in, void* d_out, int out_size, void* d_ws, size_t ws_size, hipStream_t stream) {
    static int grid = 0;
    if (grid == 0) {
        if (n_in != 12 || out_size != M * D || ws_size < WS_END) { fprintf(stderr, "kernel_launch: unexpected shapes (n_in %d out %d ws %zu)\n", n_in, out_size, ws_size); grid = -1; return; }
        int dev = 0, cus = 0, per_cu = 0;
        hipGetDevice(&dev); hipDeviceGetAttribute(&cus, hipDeviceAttributeMultiprocessorCount, dev);
        if (hipFuncSetAttribute((const void*)fwd_megakernel, hipFuncAttributeMaxDynamicSharedMemorySize, LDS_BYTES) != hipSuccess) { fprintf(stderr, "kernel_launch: hipFuncSetAttribute failed\n"); grid = -1; return; }
        if (hipOccupancyMaxActiveBlocksPerMultiprocessor(&per_cu, (const void*)fwd_megakernel, 512, LDS_BYTES) != hipSuccess || per_cu < 1) { fprintf(stderr, "kernel_launch: occupancy query gave %d\n", per_cu); per_cu = 1; }
        (void)hipGetLastError();
        grid = cus;
    }
    if (grid < 0) return;
    Args a{};
    for (int i = 0; i < 12; ++i) a.in[i] = (const float*)d_in[i];
    a.out = (float*)d_out; a.ws = (unsigned char*)d_ws;
    if (hipMemsetAsync(d_ws, 0, 65536 + 8 * 16384, stream) != hipSuccess) { fprintf(stderr, "kernel_launch: memset failed\n"); return; }
    void* args[] = {&a};
    hipError_t e = hipLaunchCooperativeKernel((const void*)fwd_megakernel, dim3(grid), dim3(512), args, LDS_BYTES, stream);
    if (e != hipSuccess) fprintf(stderr, "cooperative launch failed: %s (grid %d)\n", hipGetErrorString(e), grid);
}
```
